# Optimizing an MI355X kernel written in HIP

```python
import jax, jax.numpy as jnp
from jax import lax
import numpy as np

D_MODEL = 2048
BATCH = 2
SEQ = 8192
DEPTH = 1
DEC_BATCH = 1
DEC_SEQ = 8192
PAST_LEN = 128

D_RWKV = D_MODEL // 2
D_CONV = D_MODEL - D_RWKV
HEAD_DIM = 64
N_HEADS = D_RWKV // HEAD_DIM
DECAY_LORA = 64
AAA_LORA = 64
GATE_LORA = 160
CONV_WIDTH = 31
CONV_HALF = CONV_WIDTH // 2
D_FF = 4 * D_MODEL
RMS_EPS = 1e-6
LN_EPS = 1e-5
GN_EPS = 64e-5
L2_EPS = 1e-12
RWKV_COLS = 3 * D_RWKV + 2 * DECAY_LORA + 2 * AAA_LORA + GATE_LORA
IN_COLS = RWKV_COLS + 2 * D_CONV

kernel_name = "hymba_rwkv7_conformer_bidir_encoder"


def _rms(x, g):
    xf = x.astype(jnp.float32)
    y = xf * lax.rsqrt(jnp.mean(xf * xf, axis=-1, keepdims=True) + RMS_EPS)
    return (y * g.astype(jnp.float32)).astype(x.dtype)


def _centred_shift(z, mu_prev, mu_next):
    zp = jnp.pad(z, ((0, 0), (1, 0), (0, 0)))[:, :-1]
    zn = jnp.pad(z, ((0, 0), (0, 1), (0, 0)))[:, 1:]
    return z + mu_prev * (zp - z) + mu_next * (zn - z)


def _wkv_scan(r, w, k, v, kk, a, reverse):
    B, T, H, N = r.shape

    def step(S, inp):
        r_t, w_t, k_t, v_t, kk_t, a_t = inp
        sa = jnp.einsum('bhvk,bhk->bhv', S, kk_t)
        S = (S * w_t[:, :, None, :]
             - jnp.einsum('bhv,bhk->bhvk', sa, kk_t * a_t)
             + jnp.einsum('bhv,bhk->bhvk', v_t, k_t))
        y = jnp.einsum('bhvk,bhk->bhv', S, r_t)
        return S, y

    xs = tuple(jnp.swapaxes(t, 0, 1) for t in (r, w, k, v, kk, a))
    S0 = jnp.zeros((B, H, N, N), jnp.float32)
    _, y = lax.scan(step, S0, xs, reverse=reverse)
    return jnp.swapaxes(y, 0, 1)


def _heads(t):
    B, T, _ = t.shape
    return t.reshape(B, T, N_HEADS, HEAD_DIM)


def _rwkv_direction(r, k, v, kk, xw, xa, w0, w2, a0, a2, k_a, reverse):
    w_log = -jax.nn.softplus(-(w0 + jnp.tanh(xw) @ w2)) - 0.5
    w = jnp.exp(-jnp.exp(w_log))
    a = jax.nn.sigmoid(a0 + xa @ a2)
    k_mod = k * (1.0 + (a - 1.0) * k_a)
    return _wkv_scan(_heads(r), _heads(w), _heads(k_mod), _heads(v), kk, _heads(a), reverse)


def _layer(x, g_pre_mix, w_in, mu_prev, mu_next, w0_f, w2_f, w0_b, w2_b,
           a0_f, a2_f, a0_b, a2_b, g2, k_k, k_a, r_k, gn_w, gn_b,
           dw_w, dw_b, cln_w, cln_b, w_out, g_post_mix, g_pre_mlp,
           w_up, w_down, g_post_mlp):
    B, T, _ = x.shape
    h = _rms(x, g_pre_mix)
    z = h @ w_in
    z_rwkv = _centred_shift(z[..., :RWKV_COLS], mu_prev, mu_next).astype(jnp.float32)
    z_conv = z[..., RWKV_COLS:]

    o = 0
    r = z_rwkv[..., o:o + D_RWKV]; o += D_RWKV
    k = z_rwkv[..., o:o + D_RWKV]; o += D_RWKV
    v = z_rwkv[..., o:o + D_RWKV]; o += D_RWKV
    xw_f = z_rwkv[..., o:o + DECAY_LORA]; o += DECAY_LORA
    xw_b = z_rwkv[..., o:o + DECAY_LORA]; o += DECAY_LORA
    xa_f = z_rwkv[..., o:o + AAA_LORA]; o += AAA_LORA
    xa_b = z_rwkv[..., o:o + AAA_LORA]; o += AAA_LORA
    xg = z_rwkv[..., o:o + GATE_LORA]

    f32 = lambda t: t.astype(jnp.float32)
    g = jax.nn.sigmoid(xg) @ f32(g2)
    kk = _heads(k * f32(k_k))
    kk = kk / jnp.maximum(jnp.sqrt(jnp.sum(kk * kk, axis=-1, keepdims=True)), L2_EPS)

    y_f = _rwkv_direction(r, k, v, kk, xw_f, xa_f, f32(w0_f), f32(w2_f), f32(a0_f), f32(a2_f), f32(k_a), False)
    y_b = _rwkv_direction(r, k, v, kk, xw_b, xa_b, f32(w0_b), f32(w2_b), f32(a0_b), f32(a2_b), f32(k_a), True)
    y = y_f + y_b

    mu = jnp.mean(y, axis=-1, keepdims=True)
    var = jnp.mean(jnp.square(y - mu), axis=-1, keepdims=True)
    y = ((y - mu) * lax.rsqrt(var + GN_EPS)).reshape(B, T, D_RWKV) * f32(gn_w) + f32(gn_b)
    rh, kh, vh = _heads(r), _heads(k), _heads(v)
    bonus = (jnp.sum(rh * kh * f32(r_k), axis=-1, keepdims=True) * vh).reshape(B, T, D_RWKV)
    o_rwkv = ((y + bonus) * g).astype(x.dtype)

    u = z_conv[..., :D_CONV] * jax.nn.sigmoid(z_conv[..., D_CONV:])
    c = lax.conv_general_dilated(u, dw_w[:, None, :], window_strides=(1,),
                                 padding=((CONV_HALF, CONV_HALF),),
                                 dimension_numbers=('NWC', 'WIO', 'NWC'),
                                 feature_group_count=D_CONV) + dw_b
    cf = c.astype(jnp.float32)
    cm = jnp.mean(cf, axis=-1, keepdims=True)
    cv = jnp.mean(jnp.square(cf - cm), axis=-1, keepdims=True)
    cf = (cf - cm) * lax.rsqrt(cv + LN_EPS) * f32(cln_w) + f32(cln_b)
    o_conv = jax.nn.silu(cf).astype(x.dtype)

    mix = jnp.concatenate([o_rwkv, o_conv], axis=-1) @ w_out
    x = x + _rms(mix, g_post_mix)

    hm = _rms(x, g_pre_mlp)
    ff = jnp.square(jax.nn.relu(hm @ w_up)) @ w_down
    return x + _rms(ff, g_post_mlp)


def _trunk(x, weights):
    for l in range(DEPTH):
        x = _layer(x, *[p[l] for p in weights])
    return x


def setup_inputs(seed: int = 0) -> dict:
    key = jax.random.key(seed)
    ks = jax.random.split(key, 32)
    nrm = lambda k, shape, s: jax.random.normal(k, shape, jnp.float32) * s
    L = DEPTH
    return {
        "x_prompt": nrm(ks[0], (BATCH, SEQ, D_MODEL), 1.0),
        "x_sample": nrm(ks[1], (DEC_BATCH, DEC_SEQ, D_MODEL), 1.0),
        "g_pre_mix": 1.0 + nrm(ks[2], (L, D_MODEL), 0.02),
        "w_in": nrm(ks[3], (L, D_MODEL, IN_COLS), D_MODEL ** -0.5),
        "mu_prev": jax.random.uniform(ks[4], (L, RWKV_COLS), jnp.float32, 0.0, 0.5),
        "mu_next": jax.random.uniform(ks[5], (L, RWKV_COLS), jnp.float32, 0.0, 0.5),
        "w0_f": jax.random.uniform(ks[6], (L, D_RWKV), jnp.float32, -1.5, 0.5),
        "w2_f": nrm(ks[7], (L, DECAY_LORA, D_RWKV), 0.1 * DECAY_LORA ** -0.5),
        "w0_b": jax.random.uniform(ks[8], (L, D_RWKV), jnp.float32, -1.5, 0.5),
        "w2_b": nrm(ks[9], (L, DECAY_LORA, D_RWKV), 0.1 * DECAY_LORA ** -0.5),
        "a0_f": nrm(ks[10], (L, D_RWKV), 0.1),
        "a2_f": nrm(ks[11], (L, AAA_LORA, D_RWKV), 0.1 * AAA_LORA ** -0.5),
        "a0_b": nrm(ks[12], (L, D_RWKV), 0.1),
        "a2_b": nrm(ks[13], (L, AAA_LORA, D_RWKV), 0.1 * AAA_LORA ** -0.5),
        "g2": nrm(ks[14], (L, GATE_LORA, D_RWKV), GATE_LORA ** -0.5),
        "k_k": 0.85 + nrm(ks[15], (L, D_RWKV), 0.02),
        "k_a": 1.0 + nrm(ks[16], (L, D_RWKV), 0.02),
        "r_k": nrm(ks[17], (L, N_HEADS, HEAD_DIM), 0.1),
        "gn_w": 1.0 + nrm(ks[18], (L, D_RWKV), 0.02),
        "gn_b": nrm(ks[19], (L, D_RWKV), 0.01),
        "dw_w": nrm(ks[20], (L, CONV_WIDTH, D_CONV), CONV_WIDTH ** -0.5),
        "dw_b": nrm(ks[21], (L, D_CONV), 0.01),
        "cln_w": 1.0 + nrm(ks[22], (L, D_CONV), 0.02),
        "cln_b": nrm(ks[23], (L, D_CONV), 0.01),
        "w_out": nrm(ks[24], (L, D_MODEL, D_MODEL), D_MODEL ** -0.5),
        "g_post_mix": 1.0 + nrm(ks[25], (L, D_MODEL), 0.02),
        "g_pre_mlp": 1.0 + nrm(ks[26], (L, D_MODEL), 0.02),
        "w_up": nrm(ks[27], (L, D_MODEL, D_FF), D_MODEL ** -0.5),
        "w_down": nrm(ks[28], (L, D_FF, D_MODEL), D_FF ** -0.5),
        "g_post_mlp": 1.0 + nrm(ks[29], (L, D_MODEL), 0.02),
    }


def reference(x_prompt, x_sample, g_pre_mix, w_in, mu_prev, mu_next, w0_f, w2_f,
              w0_b, w2_b, a0_f, a2_f, a0_b, a2_b, g2, k_k, k_a, r_k, gn_w, gn_b,
              dw_w, dw_b, cln_w, cln_b, w_out, g_post_mix, g_pre_mlp, w_up,
              w_down, g_post_mlp):
    weights = (g_pre_mix, w_in, mu_prev, mu_next, w0_f, w2_f, w0_b, w2_b,
               a0_f, a2_f, a0_b, a2_b, g2, k_k, k_a, r_k, gn_w, gn_b,
               dw_w, dw_b, cln_w, cln_b, w_out, g_post_mix, g_pre_mlp,
               w_up, w_down, g_post_mlp)
    y_prompt = _trunk(x_prompt, weights)
    y_sample = _trunk(x_sample, weights)
    return (y_prompt, y_sample)
```

```cpp
#include <hip/hip_runtime.h>
#include <hip/hip_cooperative_groups.h>
#include <cstdio>
#include <cstdint>
namespace cg = cooperative_groups;
namespace pg8 {
#define PG8_LAS __attribute__((address_space(3)))
typedef unsigned short bf16_t;
typedef short bf16x8 __attribute__((ext_vector_type(8)));
typedef float f32x4 __attribute__((ext_vector_type(4)));
typedef unsigned u32x4 __attribute__((ext_vector_type(4)));
constexpr int BM = 256, BK = 64, HALF = 128, HTB = HALF * BK * 2  , STAGE_BYTES = 8 * HTB, NXCD = 8, WGM = 8;

__host__ __device__ __forceinline__ int lds_byte(int r, int c) { const int st = (r >> 4) * 2 + (c >> 5), rr = r & 15, cc = c & 31, ob = rr * 64 + cc * 2; return st * 1024 + (ob ^ (((ob >> 9) & 1) << 5)); }
__host__ __device__ __forceinline__ void stage_rc(int b, int& R, int& C) { const int st = b / 1024, sb = b % 1024, swz = sb ^ (((sb >> 9) & 1) << 5); R = (st >> 1) * 16 + swz / 64; C = (st & 1) * 32 + (swz % 64) / 2; }
__host__ __device__ __forceinline__ int perm32(int rho) { const int n = rho >> 4, i = rho & 15; return 8 * (i >> 2) + 4 * n + (i & 3); }

struct Unit { int pm, pn; };
struct Gemm { const bf16_t* A; const bf16_t* Bt; int M, N, K; };

struct StaticOrder {
    int nM, nN, nwg, G, c;
    __host__ __device__ void init(int M, int N, int G_, int c_) { nM = M / BM; nN = N / BM; nwg = nM * nN; G = G_; c = c_; }
    __host__ __device__ bool next(int i, Unit& u) const {
        const long L = (long)i * G + c; if (L >= nwg) return false;
        int wgid = (int)L; { const int q = nwg / NXCD, r = nwg % NXCD, xcd = wgid % NXCD, off = wgid / NXCD; wgid = (xcd < r ? xcd * (q + 1) : r * (q + 1) + (xcd - r) * q) + off; }
        const int nig = WGM * nN, gid = wgid / nig, fm = gid * WGM, gsz = (nM - fm) < WGM ? (nM - fm) : WGM;
        u.pm = fm + ((wgid % nig) % gsz); u.pn = (wgid % nig) / gsz; return true;
    }
    __device__ __forceinline__ void a_ready(const Unit&) const {}
    __device__ __forceinline__ void done(const Unit&) const {}
};

__device__ __forceinline__ unsigned cvt_pk_bf16(float lo, float hi) { unsigned r; asm volatile("v_cvt_pk_bf16_f32 %0, %1, %2" : "=v"(r) : "v"(lo), "v"(hi)); return r; }
typedef float f32x2 __attribute__((ext_vector_type(2)));
template <int ACT> struct EpiBf16 {
    static constexpr bool PERM = true, AFTER_DRAIN = false;
    bf16_t* O; int ldc;
    __device__ __forceinline__ void operator()(const f32x4 (&acc)[2][2][4][2], const Unit& u, int wr, int wc, int fr, int fq) const {
        const int row0 = u.pm * BM + wr * 64 + fr; const int col0 = u.pn * BM + wc * 32 + 8 * fq;
#pragma unroll
        for (int ai = 0; ai < 2; ++ai)
#pragma unroll
            for (int m = 0; m < 4; ++m) { bf16_t* rowp = O + (size_t)(row0 + ai * HALF + m * 16) * ldc + col0;
#pragma unroll
                for (int bj = 0; bj < 2; ++bj) { f32x4 v0 = acc[ai][bj][m][0], v1 = acc[ai][bj][m][1];
                    if (ACT == 2) { const f32x4 z = (f32x4){0.f, 0.f, 0.f, 0.f}; v0 = __builtin_elementwise_max(v0, z); v1 = __builtin_elementwise_max(v1, z); v0 = v0 * v0; v1 = v1 * v1; }
                    u32x4 w; w.x = cvt_pk_bf16(v0[0], v0[1]); w.y = cvt_pk_bf16(v0[2], v0[3]); w.z = cvt_pk_bf16(v1[0], v1[1]); w.w = cvt_pk_bf16(v1[2], v1[3]);
                    *(u32x4*)(rowp + bj * HALF) = w; } }
    }
};

template <class Epi, class Sched, bool ALIGN_EPI = false, bool SP2 = false>
__device__ __forceinline__ void gemm_phase(PG8_LAS unsigned char* lds, const Gemm g, const Sched& S, const Epi& E) {
    const int tid = threadIdx.x, wid = __builtin_amdgcn_readfirstlane(tid >> 6), lane = tid & 63, wr = wid >> 2, wc = wid & 3, fr = lane & 15, fq = lane >> 4;
    const int K = g.K, nt = K / BK;
    unsigned voffA[2], voffB[2];
#pragma unroll
    for (int i = 0; i < 2; ++i) { int R, C; stage_rc(tid * 16 + i * 8192, R, C); const int Rb = Epi::PERM ? ((R & ~31) + perm32(R & 31)) : R;
        voffA[i] = (unsigned)(R * K + C) * 2u; voffB[i] = (unsigned)(Rb * K + C) * 2u; }
    const size_t kstep = (size_t)(BK * 2);
    const size_t hstep = (size_t)HALF * K * 2;
    const size_t tstep = 2 * hstep;
    const unsigned ldsw = (unsigned)wid * 1024u;
    const int aoff = lds_byte(wr * 64 + fr, fq * 8), boff = lds_byte(wc * 32 + fr, fq * 8);
#define PG8_SA(b, h) (((b) * 2 + (h)) * HTB)
#define PG8_SB(b, h) ((4 + (b) * 2 + (h)) * HTB)
#define PG8_STAGE(bufoff, gbase, voff) do { _Pragma("unroll") for (int _i = 0; _i < 2; ++_i) \
        __builtin_amdgcn_global_load_lds((const unsigned*)((const char*)(gbase) + (voff)[_i]), (PG8_LAS unsigned*)(lds + (bufoff) + ldsw + _i * 8192), 16, 0, 0); } while (0)
#define PG8_LDA(dst, b, h) do { _Pragma("unroll") for (int m = 0; m < 4; ++m) _Pragma("unroll") for (int k = 0; k < 2; ++k) dst[m][k] = *(const PG8_LAS bf16x8*)(lds + PG8_SA(b, h) + aoff + m * 2048 + k * 1024); } while (0)
#define PG8_LDB(dst, b, h) do { _Pragma("unroll") for (int n = 0; n < 2; ++n) _Pragma("unroll") for (int k = 0; k < 2; ++k) dst[n][k] = *(const PG8_LAS bf16x8*)(lds + PG8_SB(b, h) + boff + n * 2048 + k * 1024); } while (0)
#define PG8_MMA(ai, bj, At, Bt) do { __builtin_amdgcn_s_setprio(1); _Pragma("unroll") for (int m = 0; m < 4; ++m) _Pragma("unroll") for (int n = 0; n < 2; ++n) _Pragma("unroll") for (int k = 0; k < 2; ++k) \
        acc[ai][bj][m][n] = __builtin_amdgcn_mfma_f32_16x16x32_bf16(Bt[n][k], At[m][k], acc[ai][bj][m][n], 0, 0, 0); __builtin_amdgcn_s_setprio(0); } while (0)
#define PG8_WAIT_V(n) asm volatile("s_waitcnt vmcnt(" #n ")" ::: "memory")
#define PG8_WAIT_L(n) asm volatile("s_waitcnt lgkmcnt(" #n ")" ::: "memory")
#define PG8_BAR __builtin_amdgcn_s_barrier()
#define PG8_SCHED __builtin_amdgcn_sched_barrier(0)
    Unit cur, nxt; int ui = 0;
    if (!S.next(0, cur)) return;
    f32x4 acc[2][2][4][2];
#pragma unroll
    for (int a = 0; a < 2; ++a)
#pragma unroll
        for (int b = 0; b < 2; ++b)
#pragma unroll
            for (int m = 0; m < 4; ++m)
#pragma unroll
                for (int n = 0; n < 2; ++n) acc[a][b][m][n] = (f32x4){0.f, 0.f, 0.f, 0.f};
    bf16x8 At[4][2], B0[2][2], B1[2][2];
    const char* cA = (const char*)g.A + (size_t)cur.pm * tstep; const char* cB = (const char*)g.Bt + (size_t)cur.pn * tstep;
    S.a_ready(cur);
    if constexpr (SP2) {
        PG8_STAGE(PG8_SB(0, 0), cB, voffB); PG8_STAGE(PG8_SB(0, 1), cB + hstep, voffB); PG8_STAGE(PG8_SA(0, 0), cA, voffA); PG8_STAGE(PG8_SA(0, 1), cA + hstep, voffA);
        if (wr == 1) PG8_BAR;
        PG8_WAIT_V(2); PG8_BAR;
        PG8_STAGE(PG8_SB(1, 0), cB + kstep, voffB); PG8_STAGE(PG8_SA(1, 0), cA + kstep, voffA); PG8_STAGE(PG8_SB(1, 1), cB + hstep + kstep, voffB);
        PG8_WAIT_V(6); PG8_BAR;
    } else {
        PG8_STAGE(PG8_SB(0, 0), cB, voffB); PG8_STAGE(PG8_SA(0, 0), cA, voffA); PG8_STAGE(PG8_SB(0, 1), cB + hstep, voffB); PG8_STAGE(PG8_SA(0, 1), cA + hstep, voffA);
        if (wr == 1) PG8_BAR;
        PG8_WAIT_V(4); PG8_BAR;
        PG8_STAGE(PG8_SB(1, 0), cB + kstep, voffB); PG8_STAGE(PG8_SA(1, 0), cA + kstep, voffA); PG8_STAGE(PG8_SB(1, 1), cB + hstep + kstep, voffB);
        PG8_WAIT_V(6); PG8_BAR;
    }
    for (;;) {
        const bool has_next = S.next(ui + 1, nxt);
        const char* nA = has_next ? (const char*)g.A + (size_t)nxt.pm * tstep : cA; const char* nB = has_next ? (const char*)g.Bt + (size_t)nxt.pn * tstep : cB;
        for (int t = 0; t < nt; t += 2) {
            const bool last = (t == nt - 2);
            const char* a1 = cA + (size_t)(t + 1) * kstep;
            const char* a2 = last ? nA : cA + (size_t)(t + 2) * kstep; const char* b2 = last ? nB : cB + (size_t)(t + 2) * kstep;
            const char* a3 = a2 + kstep; const char* b3 = b2 + kstep;
            if (last && has_next) S.a_ready(nxt);
            if constexpr (SP2) {
            PG8_LDB(B0, 0, 0); PG8_LDB(B1, 0, 1); PG8_SCHED; PG8_LDA(At, 0, 0); PG8_STAGE(PG8_SA(1, 1), a1 + hstep, voffA);
            PG8_WAIT_V(8); PG8_WAIT_L(0); PG8_BAR; PG8_MMA(0, 0, At, B0); PG8_MMA(0, 1, At, B1); PG8_BAR; PG8_SCHED;
            PG8_LDA(At, 0, 1); PG8_STAGE(PG8_SB(0, 0), b2, voffB); PG8_STAGE(PG8_SB(0, 1), b2 + hstep, voffB); PG8_STAGE(PG8_SA(0, 0), a2, voffA);
            PG8_WAIT_V(8); PG8_WAIT_L(0); PG8_BAR; PG8_MMA(1, 0, At, B0); PG8_MMA(1, 1, At, B1); PG8_BAR; PG8_SCHED;
            PG8_LDB(B0, 1, 0); PG8_LDB(B1, 1, 1); PG8_SCHED; PG8_LDA(At, 1, 0); PG8_STAGE(PG8_SA(0, 1), a2 + hstep, voffA);
            PG8_WAIT_V(8); PG8_WAIT_L(0); PG8_BAR; PG8_MMA(0, 0, At, B0); PG8_MMA(0, 1, At, B1); PG8_BAR; PG8_SCHED;
            PG8_LDA(At, 1, 1); PG8_STAGE(PG8_SB(1, 0), b3, voffB); PG8_STAGE(PG8_SB(1, 1), b3 + hstep, voffB); PG8_STAGE(PG8_SA(1, 0), a3, voffA);
            PG8_WAIT_V(8); PG8_WAIT_L(0); PG8_BAR; PG8_MMA(1, 0, At, B0); PG8_MMA(1, 1, At, B1); PG8_BAR; PG8_SCHED;
            } else {
            PG8_LDB(B0, 0, 0); PG8_SCHED; PG8_LDA(At, 0, 0); PG8_STAGE(PG8_SA(1, 1), a1 + hstep, voffA);
            PG8_WAIT_L(8); PG8_BAR; PG8_WAIT_L(0); PG8_MMA(0, 0, At, B0); PG8_BAR; PG8_SCHED;
            PG8_LDB(B1, 0, 1); PG8_STAGE(PG8_SB(0, 0), b2, voffB);
            PG8_BAR; PG8_WAIT_L(0); PG8_MMA(0, 1, At, B1); PG8_BAR;
            PG8_LDA(At, 0, 1); PG8_STAGE(PG8_SA(0, 0), a2, voffA);
            PG8_BAR; PG8_WAIT_L(0); PG8_MMA(1, 0, At, B0); PG8_BAR; PG8_SCHED;
            PG8_STAGE(PG8_SB(0, 1), b2 + hstep, voffB);
            PG8_WAIT_V(6); PG8_BAR; PG8_MMA(1, 1, At, B1); PG8_BAR;
            PG8_LDB(B0, 1, 0); PG8_SCHED; PG8_LDA(At, 1, 0); PG8_STAGE(PG8_SA(0, 1), a2 + hstep, voffA);
            PG8_WAIT_L(8); PG8_BAR; PG8_WAIT_L(0); PG8_MMA(0, 0, At, B0); PG8_BAR; PG8_SCHED;
            PG8_LDB(B1, 1, 1); PG8_STAGE(PG8_SB(1, 0), b3, voffB);
            PG8_BAR; PG8_WAIT_L(0); PG8_MMA(0, 1, At, B1); PG8_BAR;
            PG8_LDA(At, 1, 1); PG8_STAGE(PG8_SA(1, 0), a3, voffA);
            PG8_BAR; PG8_WAIT_L(0); PG8_MMA(1, 0, At, B0); PG8_BAR; PG8_SCHED;
            PG8_STAGE(PG8_SB(1, 1), b3 + hstep, voffB);
            PG8_WAIT_V(6); PG8_BAR; PG8_MMA(1, 1, At, B1); PG8_BAR;
            }
        }
        if constexpr (ALIGN_EPI) { if (wr == 0) PG8_BAR; }
        if constexpr (!Epi::AFTER_DRAIN) { E(acc, cur, wr, wc, fr, fq); S.done(cur); }
        if (!has_next) break;
#pragma unroll
        for (int a = 0; a < 2; ++a)
#pragma unroll
            for (int b = 0; b < 2; ++b)
#pragma unroll
                for (int m = 0; m < 4; ++m)
#pragma unroll
                    for (int n = 0; n < 2; ++n) acc[a][b][m][n] = (f32x4){0.f, 0.f, 0.f, 0.f};
        cur = nxt; cA = nA; cB = nB; ++ui;
        if constexpr (ALIGN_EPI) { if (wr == 1) PG8_BAR; }
    }
    PG8_WAIT_V(0);
    if constexpr (!ALIGN_EPI) { if (wr == 0) PG8_BAR; }
    PG8_BAR;
    if constexpr (Epi::AFTER_DRAIN) { E.fused(acc, cur, wr, wc, fr, fq, lds, wid, lane); S.done(cur); }
#undef PG8_SA
#undef PG8_SB
#undef PG8_STAGE
#undef PG8_LDA
#undef PG8_LDB
#undef PG8_MMA
#undef PG8_WAIT_V
#undef PG8_WAIT_L
#undef PG8_BAR
#undef PG8_SCHED
}
}

#define GAS __attribute__((address_space(1)))
#define LAS __attribute__((address_space(3)))
typedef unsigned short bf16;
typedef unsigned v4u __attribute__((ext_vector_type(4)));
typedef unsigned v2u __attribute__((ext_vector_type(2)));
typedef float f32x4 __attribute__((ext_vector_type(4)));
typedef float f32x2 __attribute__((ext_vector_type(2)));
typedef short bf16x8 __attribute__((ext_vector_type(8)));
typedef _Float16 h2 __attribute__((ext_vector_type(2)));
#define LDS_WAIT() asm volatile("s_waitcnt lgkmcnt(0)" ::: "memory")

constexpr int NWAVES = 8;
constexpr int NTOK = 24576, SEQ = 8192, DM = 2048, DR = 1024, DFF = 8192;
constexpr int ZLD = 5632, ZC_CA = 3072, ZC_CB = 4096, ZC_L = 5120;
constexpr size_t MiB = 1u << 20;
constexpr size_t WS_WIN = 0, WS_WOUT = 22 * MiB, WS_WUP = 30 * MiB, WS_WDN = 62 * MiB, WS_SMALL = 94 * MiB, WS_XL = 95 * MiB, WS_XG = 107 * MiB,
                 WS_BONUS = 115 * MiB, WS_H = 118 * MiB, WS_Z = 214 * MiB, WS_END = 478 * MiB;
constexpr size_t SM_G2T = 0, SM_W2TF = 384 * 1024, SM_W2TB = 512 * 1024, SM_A2TF = 640 * 1024, SM_A2TB = 768 * 1024;
constexpr size_t WS_YF = WS_Z, WS_YB = WS_Z + 96 * MiB, WS_MIX = WS_Z, WS_U = WS_Z, WS_FF = WS_Z + 128 * MiB;
constexpr size_t OUT_RS = 0, OUT_KS = 48 * MiB, OUT_VS = 96 * MiB, OUT_KK = 144 * MiB;
constexpr int LDS_BYTES = 147456;

struct Args { const float* in[30]; float* out; unsigned char* ws; int ph_lo, ph_hi; };

__device__ __forceinline__ float lo2f(unsigned u) { return __uint_as_float(u << 16); }
__device__ __forceinline__ float hi2f(unsigned u) { return __uint_as_float(u & 0xffff0000u); }
__device__ __forceinline__ unsigned f2bf(float f) { unsigned u = __float_as_uint(f); return (u + 0x7fffu + ((u >> 16) & 1u)) >> 16; }
__device__ __forceinline__ unsigned pk2(float lo, float hi) { unsigned r; asm volatile("v_cvt_pk_bf16_f32 %0, %1, %2" : "=v"(r) : "v"(lo), "v"(hi)); return r; }
__device__ __forceinline__ float fsigmoid(float x) { return __builtin_amdgcn_rcpf(1.f + __builtin_amdgcn_exp2f(-1.44269504f * x)); }
__device__ __forceinline__ float ftanh(float x) { return 1.f - 2.f * __builtin_amdgcn_rcpf(1.f + __builtin_amdgcn_exp2f(2.88539008f * x)); }
__device__ __forceinline__ float wave_sum(float v) {
#pragma unroll
    for (int o = 1; o < 64; o <<= 1) v += __shfl_xor(v, o);
    return v;
}
template <int CTRL> __device__ __forceinline__ float dppf(float x) { return __int_as_float(__builtin_amdgcn_update_dpp(0, __float_as_int(x), CTRL, 0xF, 0xF, true)); }
__device__ __forceinline__ float red8(float x) { x += dppf<0xB1>(x); x += dppf<0x4E>(x); x += dppf<0x141>(x); return x; }
__device__ __forceinline__ const float* xrow(const Args& a, int m) { return m < 16384 ? a.in[0] + (size_t)m * DM : a.in[1] + (size_t)(m - 16384) * DM; }

__device__ __forceinline__ void tr_item(const float* W, int ldw, int k0, int sc0, bf16* WT, int ldt, int dr0, LAS float* scr, int lane) {
#pragma unroll 8
    for (int i = 0; i < 32; ++i) { const int kk = 2 * i + (lane >> 5); scr[kk * 33 + (lane & 31)] = W[(size_t)(k0 + kk) * ldw + sc0 + (lane & 31)]; }
    LDS_WAIT(); asm volatile("" ::: "memory");
    const int c = lane & 7;
#pragma unroll
    for (int j = 0; j < 4; ++j) { const int n = (lane >> 3) + 8 * j; const LAS float* s = scr + (8 * c) * 33 + n;
        v4u o; o.x = pk2(s[0 * 33], s[1 * 33]); o.y = pk2(s[2 * 33], s[3 * 33]); o.z = pk2(s[4 * 33], s[5 * 33]); o.w = pk2(s[6 * 33], s[7 * 33]);
        *(v4u*)(WT + (size_t)(dr0 + n) * ldt + k0 + 8 * c) = o; }
    LDS_WAIT(); asm volatile("" ::: "memory");
}
__device__ __forceinline__ void rms_row_bf16(const float* xr_, const float* g, bf16* orow, int lane) {
    const f32x4* xr = (const f32x4*)xr_ + lane; const f32x4* gr = (const f32x4*)g + lane;
    f32x4 v[8]; float s = 0.f;
#pragma unroll
    for (int j = 0; j < 8; ++j) { v[j] = xr[64 * j]; s += (v[j].x * v[j].x + v[j].y * v[j].y) + (v[j].z * v[j].z + v[j].w * v[j].w); }
    const float rstd = 1.f / sqrtf(wave_sum(s) * (1.f / DM) + 1e-6f);
    v2u* o8 = (v2u*)orow + lane;
#pragma unroll
    for (int j = 0; j < 8; ++j) { const f32x4 gg = gr[64 * j]; v2u o; o.x = pk2(v[j].x * rstd * gg.x, v[j].y * rstd * gg.y); o.y = pk2(v[j].z * rstd * gg.z, v[j].w * rstd * gg.w); o8[64 * j] = o; }
}
__device__ __forceinline__ void p0_prologue(const Args& a, LAS unsigned char* lds, int gw, int NGW, int wave, int lane) {
    unsigned char* ws = a.ws;
    LAS float* scr = (LAS float*)(lds + wave * 16384);
    bf16* WIN = (bf16*)(ws + WS_WIN); bf16* WOUT = (bf16*)(ws + WS_WOUT); bf16* WUP = (bf16*)(ws + WS_WUP); bf16* WDN = (bf16*)(ws + WS_WDN);
    constexpr int I_IN = 32 * 173, I_OUT = 32 * 64, I_UP = 32 * 256, I_DN = 128 * 64, I_S = 32;
    constexpr int NITEMS = I_IN + I_OUT + I_UP + I_DN + 4 * I_S;
    for (int it = gw; it < NITEMS; it += NGW) {
        int r = it;
        if (r < I_IN) { const int kb = r / 173, nb = r % 173, sc0 = nb * 32; const int dr0 = sc0 < 3072 ? sc0 : (sc0 < 3488 ? ZC_L + (sc0 - 3072) : ZC_CA + (sc0 - 3488));
            tr_item(a.in[3], 5536, kb * 64, sc0, WIN, DM, dr0, scr, lane); continue; } r -= I_IN;
        if (r < I_OUT) { tr_item(a.in[24], DM, (r / 64) * 64, (r % 64) * 32, WOUT, DM, (r % 64) * 32, scr, lane); continue; } r -= I_OUT;
        if (r < I_UP) { tr_item(a.in[27], DFF, (r / 256) * 64, (r % 256) * 32, WUP, DM, (r % 256) * 32, scr, lane); continue; } r -= I_UP;
        if (r < I_DN) { tr_item(a.in[28], DM, (r / 64) * 64, (r % 64) * 32, WDN, DFF, (r % 64) * 32, scr, lane); continue; } r -= I_DN;
        { const int which = r / I_S, nb = r % I_S; const float* src = which == 0 ? a.in[7] : which == 1 ? a.in[9] : which == 2 ? a.in[11] : a.in[13];
          bf16* dst = (bf16*)(ws + WS_SMALL + (which == 0 ? SM_W2TF : which == 1 ? SM_W2TB : which == 2 ? SM_A2TF : SM_A2TB));
          tr_item(src, DR, 0, nb * 32, dst, 64, nb * 32, scr, lane); }
    }
    { const int gt = gw * 64 + lane, NGT = NGW * 64;
      v4u zz = {0u, 0u, 0u, 0u}; v4u* zp = (v4u*)(WIN + (size_t)5536 * DM);
      for (int i = gt; i < 96 * DM / 8; i += NGT) zp[i] = zz;
      bf16* G2T = (bf16*)(ws + WS_SMALL + SM_G2T); const float* g2 = a.in[14];
      for (int i = gt; i < 160 * 1024; i += NGT) { const int k = i >> 10, n = i & 1023; G2T[n * 160 + k] = (bf16)f2bf(g2[i]); } }
    bf16* H = (bf16*)(ws + WS_H);
    for (int m = gw; m < NTOK; m += NGW) rms_row_bf16(xrow(a, m), a.in[2], H + (size_t)m * DM, lane);
}

__device__ __forceinline__ void shift_phase(const Args& a, int gw, int NGW, int lane) {
    unsigned char* ws = a.ws;
    const bf16* Z = (const bf16*)(ws + WS_Z);
    bf16* RS = (bf16*)((unsigned char*)a.out + OUT_RS); bf16* KS = (bf16*)((unsigned char*)a.out + OUT_KS);
    bf16* VS = (bf16*)((unsigned char*)a.out + OUT_VS); bf16* KK = (bf16*)((unsigned char*)a.out + OUT_KK);
    bf16* XL = (bf16*)(ws + WS_XL); bf16* XG = (bf16*)(ws + WS_XG); float* BONUS = (float*)(ws + WS_BONUS);
    const float* mup = a.in[4]; const float* mun = a.in[5]; const float* k_k = a.in[15]; const float* r_k = a.in[17];
    const int hp2 = lane >> 5, n2 = (lane & 31) * 2;
    for (int m = gw; m < NTOK; m += NGW) {
        const int t = m & (SEQ - 1); const bool hp = t > 0, hn = t < SEQ - 1;
        const bf16* z0 = Z + (size_t)m * ZLD; const bf16* zp = z0 - ZLD; const bf16* zn = z0 + ZLD;
#pragma unroll 2
        for (int hh = 0; hh < 8; ++hh) {
            const int c = (hh * 2 + hp2) * 64 + n2;
            float s[3][2];
#pragma unroll
            for (int ar = 0; ar < 3; ++ar) { const int col = ar * 1024 + c;
                const unsigned zc = *(const unsigned*)(z0 + col); const unsigned zpv = hp ? *(const unsigned*)(zp + col) : 0u; const unsigned znv = hn ? *(const unsigned*)(zn + col) : 0u;
                const f32x2 mp = *(const f32x2*)(mup + col), mn = *(const f32x2*)(mun + col);
                const float x0 = lo2f(zc), x1 = hi2f(zc);
                s[ar][0] = x0 + mp.x * (lo2f(zpv) - x0) + mn.x * (lo2f(znv) - x0);
                s[ar][1] = x1 + mp.y * (hi2f(zpv) - x1) + mn.y * (hi2f(znv) - x1); }
            const f32x2 kkw = *(const f32x2*)(k_k + c), rkw = *(const f32x2*)(r_k + c);
            const float kr0 = s[1][0] * kkw.x, kr1 = s[1][1] * kkw.y;
            float ss = kr0 * kr0 + kr1 * kr1, bs = s[0][0] * s[1][0] * rkw.x + s[0][1] * s[1][1] * rkw.y;
#pragma unroll
            for (int o = 1; o < 32; o <<= 1) { ss += __shfl_xor(ss, o); bs += __shfl_xor(bs, o); }
            const float inv = 1.f / fmaxf(sqrtf(ss), 1e-12f);
            const size_t o = (size_t)m * DR + c;
            *(unsigned*)(RS + o) = pk2(s[0][0], s[0][1]); *(unsigned*)(KS + o) = pk2(s[1][0], s[1][1]);
            *(unsigned*)(VS + o) = pk2(s[2][0], s[2][1]); *(unsigned*)(KK + o) = pk2(kr0 * inv, kr1 * inv);
            if ((lane & 31) == 0) BONUS[m * 16 + hh * 2 + hp2] = bs;
        }
#pragma unroll
        for (int p = 0; p < 7; ++p) { const int j = p * 64 + lane;
            if (j < 416) { const int col = ZC_L + j, og = 3072 + j;
                const float x0 = lo2f(z0[col]); const float xp = hp ? lo2f(zp[col]) : 0.f; const float xn = hn ? lo2f(zn[col]) : 0.f;
                const float sv = x0 + mup[og] * (xp - x0) + mun[og] * (xn - x0);
                if (j < 128) XL[(size_t)m * 256 + j] = (bf16)f2bf(ftanh(sv));
                else if (j < 256) XL[(size_t)m * 256 + j] = (bf16)f2bf(sv);
                else XG[(size_t)m * 160 + (j - 256)] = (bf16)f2bf(fsigmoid(sv)); } }
    }
}

#define TR_STAGE(D_, N_) { const bool up_ = (lane & (D_)) != 0; _Pragma("unroll") for (int i_ = 0; i_ < (N_) / 2; ++i_) { \
    const float keep_ = up_ ? vals[i_ + (N_) / 2] : vals[i_]; const float send_ = up_ ? vals[i_] : vals[i_ + (N_) / 2]; vals[i_] = keep_ + __shfl_xor(send_, (D_)); } }
__device__ __forceinline__ void conv_phase(const Args& a, unsigned char* lds, int tid, int wave, int lane) {
    unsigned char* ws = a.ws;
    const bf16* Z = (const bf16*)(ws + WS_Z); bf16* MIXIN = (bf16*)(ws + WS_H);
    h2* utile = (h2*)lds;
    float* part = (float*)(lds + 126976);
    f32x2* stats = (f32x2*)(lds + 126976 + 2048);
    const float* dw_w = a.in[20]; const float* dw_b = a.in[21]; const float* cln_w = a.in[22]; const float* cln_b = a.in[23];
    const int cp = tid;
    for (int unit = blockIdx.x; unit < NTOK / 32; unit += gridDim.x) {
        const int m0 = unit * 32, t0 = m0 & (SEQ - 1);
        for (int idx = tid; idx < 62 * 512; idx += 512) { const int row = idx >> 9, c2 = idx & 511; const int t = t0 - 15 + row;
            h2 u = {(_Float16)0.f, (_Float16)0.f};
            if (t >= 0 && t < SEQ) { const bf16* zr = Z + (size_t)(m0 - 15 + row) * ZLD; const unsigned za = *(const unsigned*)(zr + ZC_CA + 2 * c2), zb = *(const unsigned*)(zr + ZC_CB + 2 * c2);
                u.x = (_Float16)(lo2f(za) * fsigmoid(lo2f(zb))); u.y = (_Float16)(hi2f(za) * fsigmoid(hi2f(zb))); }
            utile[idx] = u; }
        __syncthreads();
        f32x2 w[31];
#pragma unroll
        for (int j = 0; j < 31; ++j) w[j] = *(const f32x2*)(dw_w + j * 1024 + 2 * cp);
        const f32x2 bias = *(const f32x2*)(dw_b + 2 * cp);
        f32x2 out[32];
#pragma unroll
        for (int tb = 0; tb < 4; ++tb) {
            f32x2 acc[8];
#pragma unroll
            for (int o = 0; o < 8; ++o) acc[o] = bias;
#pragma unroll
            for (int jj = 0; jj < 38; ++jj) { const h2 uh = utile[(tb * 8 + jj) * 512 + cp]; const f32x2 u = {(float)uh.x, (float)uh.y};
#pragma unroll
                for (int o = 0; o < 8; ++o) { const int j = jj - o; if (j >= 0 && j < 31) acc[o] = u * w[j] + acc[o]; } }
#pragma unroll
            for (int o = 0; o < 8; ++o) out[tb * 8 + o] = acc[o];
            asm volatile("" ::: "memory");
        }
        float vals[64];
#pragma unroll
        for (int t = 0; t < 32; ++t) { vals[2 * t] = out[t].x + out[t].y; vals[2 * t + 1] = out[t].x * out[t].x + out[t].y * out[t].y; }
        TR_STAGE(32, 64) TR_STAGE(16, 32) TR_STAGE(8, 16) TR_STAGE(4, 8) TR_STAGE(2, 4) TR_STAGE(1, 2)
        part[wave * 64 + lane] = vals[0];
        __syncthreads();
        if (tid < 32) { float s = 0.f, q = 0.f;
#pragma unroll
            for (int wv = 0; wv < 8; ++wv) { s += part[wv * 64 + 2 * tid]; q += part[wv * 64 + 2 * tid + 1]; }
            const float mean = s * (1.f / 1024.f); const float var = q * (1.f / 1024.f) - mean * mean;
            stats[tid] = (f32x2){mean, 1.f / sqrtf(var + 1e-5f)}; }
        __syncthreads();
        const f32x2 lw = *(const f32x2*)(cln_w + 2 * cp), lb = *(const f32x2*)(cln_b + 2 * cp);
#pragma unroll
        for (int t = 0; t < 32; ++t) { const f32x2 st = stats[t];
            const float y0 = (out[t].x - st.x) * st.y * lw.x + lb.x, y1 = (out[t].y - st.x) * st.y * lw.y + lb.y;
            *(unsigned*)(MIXIN + (size_t)(m0 + t) * DM + DR + 2 * cp) = pk2(y0 * fsigmoid(y0), y1 * fsigmoid(y1)); }
        __syncthreads();
    }
}

__device__ __forceinline__ void scan_phase(const Args& a, unsigned char* lds, int wave, int lane) {
    if (blockIdx.x >= 192) return;
    unsigned char* ws = a.ws;
    const int scan = blockIdx.x >> 1, half = blockIdx.x & 1, dir = scan & 1, sh = scan >> 1, seq = sh >> 4, h = sh & 15;
    const size_t row0 = (size_t)seq * SEQ;
    const bf16* RS = (const bf16*)((unsigned char*)a.out + OUT_RS); const bf16* KS = (const bf16*)((unsigned char*)a.out + OUT_KS);
    const bf16* VS = (const bf16*)((unsigned char*)a.out + OUT_VS); const bf16* KK = (const bf16*)((unsigned char*)a.out + OUT_KK);
    const bf16* XL = (const bf16*)(ws + WS_XL);
    float* Y = (float*)(ws + (dir ? WS_YB : WS_YF));
    constexpr int NCH = SEQ / 32;
    const int ks = lane & 7, rr = half * 32 + (wave & 3) * 8 + (lane >> 3);
    f32x2 S0 = {0.f, 0.f}, S1 = S0, S2 = S0, S3 = S0;
    float* ybase = Y + row0 * DR + h * 64 + rr;
    const int pw = wave & 3, fr = lane & 15, fq = lane >> 4, cl = pw * 16 + fq * 4, gcol = h * 64 + cl;
    bf16x8 Bw0, Bw1, Ba0, Ba1; f32x4 w0v, a0v, kav;
    {
        const bf16* W2T = (const bf16*)(ws + WS_SMALL + (dir ? SM_W2TB : SM_W2TF)); const bf16* A2T = (const bf16*)(ws + WS_SMALL + (dir ? SM_A2TB : SM_A2TF));
        const size_t bo = (size_t)(h * 64 + pw * 16 + fr) * 64 + fq * 8;
        Bw0 = *(const bf16x8*)(W2T + bo); Bw1 = *(const bf16x8*)(W2T + bo + 32); Ba0 = *(const bf16x8*)(A2T + bo); Ba1 = *(const bf16x8*)(A2T + bo + 32);
        w0v = *(const f32x4*)((dir ? a.in[8] : a.in[6]) + gcol); a0v = *(const f32x4*)((dir ? a.in[12] : a.in[10]) + gcol); kav = *(const f32x4*)(a.in[16] + gcol);
    }
    for (int c = 0; c <= NCH; ++c) {
        if (wave >= 4) {
            if (c < NCH) {
                float* cb = (float*)(lds + (c & 1) * 49152);
#pragma unroll
                for (int mt = 0; mt < 2; ++mt) {
                    const int i = mt * 16 + fr, step = c * 32 + i, t = dir ? (SEQ - 1 - step) : step; const size_t m = row0 + t;
                    const bf16* xl = XL + m * 256 + dir * 64 + fq * 8;
                    const bf16x8 At0 = *(const bf16x8*)(xl), At1 = *(const bf16x8*)(xl + 32), Aa0 = *(const bf16x8*)(xl + 128), Aa1 = *(const bf16x8*)(xl + 160);
                    const size_t go = m * DR + gcol;
                    const v2u r4 = *(const v2u*)(RS + go), k4 = *(const v2u*)(KS + go), v4 = *(const v2u*)(VS + go), q4 = *(const v2u*)(KK + go);
                    f32x4 aw = {0.f, 0.f, 0.f, 0.f}, aa = aw;
                    aw = __builtin_amdgcn_mfma_f32_16x16x32_bf16(Bw0, At0, aw, 0, 0, 0); aw = __builtin_amdgcn_mfma_f32_16x16x32_bf16(Bw1, At1, aw, 0, 0, 0);
                    aa = __builtin_amdgcn_mfma_f32_16x16x32_bf16(Ba0, Aa0, aa, 0, 0, 0); aa = __builtin_amdgcn_mfma_f32_16x16x32_bf16(Ba1, Aa1, aa, 0, 0, 0);
                    const f32x4 rv = {lo2f(r4.x), hi2f(r4.x), lo2f(r4.y), hi2f(r4.y)}, kv = {lo2f(k4.x), hi2f(k4.x), lo2f(k4.y), hi2f(k4.y)};
                    const f32x4 vv = {lo2f(v4.x), hi2f(v4.x), lo2f(v4.y), hi2f(v4.y)}, qv = {lo2f(q4.x), hi2f(q4.x), lo2f(q4.y), hi2f(q4.y)};
                    f32x4 wv, av;
#pragma unroll
                    for (int j = 0; j < 4; ++j) { const float sg = fsigmoid(w0v[j] + aw[j]); wv[j] = __builtin_amdgcn_exp2f(-0.87500596f * sg); av[j] = fsigmoid(a0v[j] + aa[j]); }
                    const f32x4 kav4 = qv * av, kmv = kv * (1.f + (av - 1.f) * kav);
                    f32x4* dst = (f32x4*)(cb + i * 64 + cl);
                    dst[0] = qv; dst[512] = wv; dst[1024] = kav4; dst[1536] = kmv; dst[2048] = rv; dst[2560] = vv;
                }
            }
        } else if (c > 0) {
            const float* cb = (const float*)(lds + ((c - 1) & 1) * 49152);
            const int cbase = (c - 1) * 32;
#pragma unroll 4
            for (int i = 0; i < 32; ++i) {
                const f32x4* p = (const f32x4*)(cb + i * 64 + ks * 8);
                const f32x4 q0 = p[0], q1 = p[1], w0 = p[512], w1 = p[513], a0 = p[1024], a1 = p[1025], m0 = p[1536], m1 = p[1537], r0 = p[2048], r1 = p[2049];
                const float vv = cb[5 * 2048 + i * 64 + rr];
                f32x2 acc = S0 * q0.xy; acc = S1 * q0.zw + acc; acc = S2 * q1.xy + acc; acc = S3 * q1.zw + acc;
                const float sa = red8(acc.x + acc.y);
                const f32x2 sav = {sa, sa}, vv2 = {vv, vv};
                S0 = S0 * w0.xy + (vv2 * m0.xy - sav * a0.xy); S1 = S1 * w0.zw + (vv2 * m0.zw - sav * a0.zw);
                S2 = S2 * w1.xy + (vv2 * m1.xy - sav * a1.xy); S3 = S3 * w1.zw + (vv2 * m1.zw - sav * a1.zw);
                f32x2 yq = S0 * r0.xy; yq = S1 * r0.zw + yq; yq = S2 * r1.xy + yq; yq = S3 * r1.zw + yq;
                const float y = red8(yq.x + yq.y);
                const int step = cbase + i, t = dir ? (SEQ - 1 - step) : step;
                if (ks == 0) ybase[(size_t)t * DR] = y;
            }
        }
        __syncthreads();
    }
}

__device__ __forceinline__ void post_phase(const Args& a, int wave, int lane) {
    unsigned char* ws = a.ws;
    const bf16* XG = (const bf16*)(ws + WS_XG); const bf16* G2T = (const bf16*)(ws + WS_SMALL + SM_G2T);
    const float* YF = (const float*)(ws + WS_YF); const float* YB = (const float*)(ws + WS_YB); const float* BONUS = (const float*)(ws + WS_BONUS);
    const bf16* VS = (const bf16*)((unsigned char*)a.out + OUT_VS); bf16* MIXIN = (bf16*)(ws + WS_H);
    const float* gn_w = a.in[18]; const float* gn_b = a.in[19];
    const int fr = lane & 15, fq = lane >> 4, n0 = wave * 128;
    for (int unit = blockIdx.x; unit < NTOK / 32; unit += gridDim.x) {
        const int m0 = unit * 32;
        f32x4 acc[2][8];
#pragma unroll
        for (int mt = 0; mt < 2; ++mt)
#pragma unroll
            for (int nt = 0; nt < 8; ++nt) acc[mt][nt] = (f32x4){0.f, 0.f, 0.f, 0.f};
#pragma unroll
        for (int kq = 0; kq < 5; ++kq) {
            bf16x8 A[2];
#pragma unroll
            for (int mt = 0; mt < 2; ++mt) A[mt] = *(const bf16x8*)(XG + (size_t)(m0 + mt * 16 + fr) * 160 + kq * 32 + fq * 8);
#pragma unroll
            for (int nt = 0; nt < 8; ++nt) { const bf16x8 B = *(const bf16x8*)(G2T + (size_t)(n0 + nt * 16 + fr) * 160 + kq * 32 + fq * 8);
#pragma unroll
                for (int mt = 0; mt < 2; ++mt) acc[mt][nt] = __builtin_amdgcn_mfma_f32_16x16x32_bf16(B, A[mt], acc[mt][nt], 0, 0, 0); }
        }
#pragma unroll
        for (int mt = 0; mt < 2; ++mt) { const size_t m = (size_t)(m0 + mt * 16 + fr);
#pragma unroll
            for (int hh = 0; hh < 2; ++hh) { const int hd = wave * 2 + hh;
                f32x4 y[4]; float s = 0.f;
#pragma unroll
                for (int q = 0; q < 4; ++q) { const size_t o = m * DR + n0 + (hh * 4 + q) * 16 + fq * 4; y[q] = *(const f32x4*)(YF + o) + *(const f32x4*)(YB + o); s += (y[q].x + y[q].y) + (y[q].z + y[q].w); }
                s += __shfl_xor(s, 16); s += __shfl_xor(s, 32);
                const float mean = s * (1.f / 64.f); float ss = 0.f;
#pragma unroll
                for (int q = 0; q < 4; ++q) { y[q] = y[q] - mean; ss += (y[q].x * y[q].x + y[q].y * y[q].y) + (y[q].z * y[q].z + y[q].w * y[q].w); }
                ss += __shfl_xor(ss, 16); ss += __shfl_xor(ss, 32);
                const float rstd = 1.f / sqrtf(ss * (1.f / 64.f) + 64e-5f); const float bs = BONUS[m * 16 + hd];
#pragma unroll
                for (int q = 0; q < 4; ++q) { const int c = n0 + (hh * 4 + q) * 16 + fq * 4; const f32x4 gw4 = *(const f32x4*)(gn_w + c), gb4 = *(const f32x4*)(gn_b + c);
                    const v2u v4 = *(const v2u*)(VS + m * DR + c); const f32x4 vv = {lo2f(v4.x), hi2f(v4.x), lo2f(v4.y), hi2f(v4.y)};
                    const f32x4 o = (y[q] * rstd * gw4 + gb4 + bs * vv) * acc[mt][hh * 4 + q];
                    v2u ov; ov.x = pk2(o.x, o.y); ov.y = pk2(o.z, o.w); *(v2u*)(MIXIN + m * DM + c) = ov; }
            }
        }
    }
}

__device__ __forceinline__ void mid_rows(const Args& a, int gw, int NGW, int lane) {
    unsigned char* ws = a.ws; const bf16* MIX = (const bf16*)(ws + WS_MIX); bf16* H = (bf16*)(ws + WS_H);
    const f32x4* g1 = (const f32x4*)a.in[25] + lane; const f32x4* g2 = (const f32x4*)a.in[26] + lane;
    for (int m = gw; m < NTOK; m += NGW) {
        const v2u* mr = (const v2u*)(MIX + (size_t)m * DM) + lane; const f32x4* xr = (const f32x4*)xrow(a, m) + lane;
        f32x4 v[8]; float s = 0.f;
#pragma unroll
        for (int j = 0; j < 8; ++j) { const v2u u = mr[64 * j]; v[j] = (f32x4){lo2f(u.x), hi2f(u.x), lo2f(u.y), hi2f(u.y)}; s += (v[j].x * v[j].x + v[j].y * v[j].y) + (v[j].z * v[j].z + v[j].w * v[j].w); }
        const float rstd = 1.f / sqrtf(wave_sum(s) * (1.f / DM) + 1e-6f); float s1 = 0.f;
        f32x4* orow = (f32x4*)(a.out + (size_t)m * DM) + lane;
#pragma unroll
        for (int j = 0; j < 8; ++j) { v[j] = xr[64 * j] + v[j] * rstd * g1[64 * j]; orow[64 * j] = v[j]; s1 += (v[j].x * v[j].x + v[j].y * v[j].y) + (v[j].z * v[j].z + v[j].w * v[j].w); }
        const float rstd1 = 1.f / sqrtf(wave_sum(s1) * (1.f / DM) + 1e-6f);
        v2u* hr = (v2u*)(H + (size_t)m * DM) + lane;
#pragma unroll
        for (int j = 0; j < 8; ++j) { const f32x4 gg = g2[64 * j]; v2u o; o.x = pk2(v[j].x * rstd1 * gg.x, v[j].y * rstd1 * gg.y); o.y = pk2(v[j].z * rstd1 * gg.z, v[j].w * rstd1 * gg.w); hr[64 * j] = o; }
    }
}
__device__ __forceinline__ void final_rows(const Args& a, int gw, int NGW, int lane) {
    unsigned char* ws = a.ws; const bf16* FF = (const bf16*)(ws + WS_FF);
    const f32x4* g1 = (const f32x4*)a.in[29] + lane;
    for (int m = gw; m < NTOK; m += NGW) {
        const v2u* mr = (const v2u*)(FF + (size_t)m * DM) + lane;
        f32x4 v[8]; float s = 0.f;
#pragma unroll
        for (int j = 0; j < 8; ++j) { const v2u u = mr[64 * j]; v[j] = (f32x4){lo2f(u.x), hi2f(u.x), lo2f(u.y), hi2f(u.y)}; s += (v[j].x * v[j].x + v[j].y * v[j].y) + (v[j].z * v[j].z + v[j].w * v[j].w); }
        const float rstd = 1.f / sqrtf(wave_sum(s) * (1.f / DM) + 1e-6f);
        f32x4* orow = (f32x4*)(a.out + (size_t)m * DM) + lane;
#pragma unroll
        for (int j = 0; j < 8; ++j) orow[64 * j] = orow[64 * j] + v[j] * rstd * g1[64 * j];
    }
}

__global__ void __launch_bounds__(NWAVES * 64, 2) hymba_fwd(Args args) {
    extern __shared__ __attribute__((aligned(16))) unsigned char lds[];
    cg::grid_group grid = cg::this_grid();
    LAS unsigned char* ldsl = (LAS unsigned char*)lds;
    const int tid = threadIdx.x, lane = tid & 63, wave = __builtin_amdgcn_readfirstlane(tid >> 6);
    const int G = gridDim.x, gw = blockIdx.x * NWAVES + wave, NGW = G * NWAVES;
    unsigned char* ws = args.ws;
    const int lo = args.ph_lo, hi = args.ph_hi;
#define IN(k) (lo <= (k) && (k) < hi)
#define SEAM(k) do { if (IN(k) && IN((k) + 1)) grid.sync(); } while (0)
    typedef pg8::EpiBf16<0> E0; typedef pg8::EpiBf16<2> E2;
    if (IN(0)) { p0_prologue(args, ldsl, gw, NGW, wave, lane); }
    SEAM(0);
#ifndef NO_G1
    if (IN(1)) { pg8::Gemm g{(const bf16*)(ws + WS_H), (const bf16*)(ws + WS_WIN), NTOK, ZLD, DM}; pg8::StaticOrder S; S.init(NTOK, ZLD, G, (int)blockIdx.x);
        E0 E{(bf16*)(ws + WS_Z), ZLD}; pg8::gemm_phase<E0, pg8::StaticOrder, true, true>(ldsl, g, S, E); }
#endif
    SEAM(1);
    if (IN(2)) {
#ifndef NO_SHIFT
 shift_phase(args, gw, NGW, lane);
#endif
#ifndef NO_CONV
 conv_phase(args, lds, tid, wave, lane);
#endif
 }
    SEAM(2);
    if (IN(3)) {
#ifndef NO_SCAN
 scan_phase(args, lds, wave, lane);
#endif
 }
    SEAM(3);
    if (IN(4)) {
#ifndef NO_POST
 post_phase(args, wave, lane);
#endif
 }
    SEAM(4);
#ifndef NO_G5
    if (IN(5)) { pg8::Gemm g{(const bf16*)(ws + WS_H), (const bf16*)(ws + WS_WOUT), NTOK, DM, DM}; pg8::StaticOrder S; S.init(NTOK, DM, G, (int)blockIdx.x);
        E0 E{(bf16*)(ws + WS_MIX), DM}; pg8::gemm_phase<E0, pg8::StaticOrder, true, true>(ldsl, g, S, E); }
#endif
    SEAM(5);
    if (IN(6)) { mid_rows(args, gw, NGW, lane); }
    SEAM(6);
#ifndef NO_G7
    if (IN(7)) {
#pragma unroll
        for (int s = 0; s < 3; ++s) {
            { pg8::Gemm g{(const bf16*)(ws + WS_H) + (size_t)s * SEQ * DM, (const bf16*)(ws + WS_WUP), SEQ, DFF, DM}; pg8::StaticOrder S; S.init(SEQ, DFF, G, (int)blockIdx.x);
              E2 E{(bf16*)(ws + WS_U), DFF}; pg8::gemm_phase<E2, pg8::StaticOrder, true, true>(ldsl, g, S, E); }
            grid.sync();
            { pg8::Gemm g{(const bf16*)(ws + WS_U), (const bf16*)(ws + WS_WDN), SEQ, DM, DFF}; pg8::StaticOrder S; S.init(SEQ, DM, G, (int)blockIdx.x);
              E0 E{(bf16*)(ws + WS_FF) + (size_t)s * SEQ * DM, DM}; pg8::gemm_phase<E0, pg8::StaticOrder, true, true>(ldsl, g, S, E); }
            if (s < 2) grid.sync();
        }
    }
#endif
    SEAM(7);
    if (IN(8)) { final_rows(args, gw, NGW, lane); }
#undef IN
#undef SEAM
}

extern "C" void kernel_launch(void* const* d_in, const int* in_sizes, int n_in, void* d_out, int out_size, void* d_ws, size_t ws_size, hipStream_t stream) {
    static int grid = 0;
    if (grid == 0) {
        if (n_in != 30 || ws_size < WS_END) { fprintf(stderr, "kernel_launch: unexpected n_in %d / ws %zu\n", n_in, ws_size); grid = -1; return; }
        int dev = 0, cus = 0, per_cu = 0;
        hipGetDevice(&dev); hipDeviceGetAttribute(&cus, hipDeviceAttributeMultiprocessorCount, dev);
        if (hipFuncSetAttribute((const void*)hymba_fwd, hipFuncAttributeMaxDynamicSharedMemorySize, LDS_BYTES) != hipSuccess) { fprintf(stderr, "kernel_launch: hipFuncSetAttribute failed\n"); grid = -1; return; }
        hipOccupancyMaxActiveBlocksPerMultiprocessor(&per_cu, (const void*)hymba_fwd, NWAVES * 64, LDS_BYTES);
        (void)hipGetLastError();
        if (per_cu < 1) per_cu = 1;
        grid = cus * 1;
        if (grid < 192) { fprintf(stderr, "kernel_launch: grid %d too small\n", grid); grid = -1; return; }
    }
    if (grid < 0) return;
    Args a{};
    for (int i = 0; i < 30; ++i) a.in[i] = (const float*)d_in[i];
    a.out = (float*)d_out; a.ws = (unsigned char*)d_ws;
#ifndef N_LAUNCH_SPLIT
    a.ph_lo = 0; a.ph_hi = 9;
    void* kargs[] = {&a};
    hipError_t e = hipLaunchCooperativeKernel((const void*)hymba_fwd, dim3(grid), dim3(NWAVES * 64), kargs, LDS_BYTES, stream);
    if (e != hipSuccess) fprintf(stderr, "cooperative launch failed: %s (grid %d)\n", hipGetErrorString(e), grid);
#else
    for (int p = 0; p < 9; ++p) { a.ph_lo = p; a.ph_hi = p + 1; void* kargs[] = {&a};
        hipError_t e = hipLaunchCooperativeKernel((const void*)hymba_fwd, dim3(grid), dim3(NWAVES * 64), kargs, LDS_BYTES, stream);
        if (e != hipSuccess) fprintf(stderr, "cooperative launch %d failed: %s (grid %d)\n", p, hipGetErrorString(e), grid); }
#endif
}
```

```cpp
#include <hip/hip_runtime.h>
#include <hip/hip_cooperative_groups.h>
#include <cstdio>
#include <cstdint>
namespace cg = cooperative_groups;
namespace pg8 {
#define PG8_LAS __attribute__((address_space(3)))
typedef unsigned short bf16_t;
typedef short bf16x8 __attribute__((ext_vector_type(8)));
typedef float f32x4 __attribute__((ext_vector_type(4)));
typedef unsigned u32x4 __attribute__((ext_vector_type(4)));
constexpr int BM = 256, BK = 64, HALF = 128, HTB = HALF * BK * 2  , STAGE_BYTES = 8 * HTB, NXCD = 8, WGM = 8;

__host__ __device__ __forceinline__ int lds_byte(int r, int c) { const int st = (r >> 4) * 2 + (c >> 5), rr = r & 15, cc = c & 31, ob = rr * 64 + cc * 2; return st * 1024 + (ob ^ (((ob >> 9) & 1) << 5)); }
__host__ __device__ __forceinline__ void stage_rc(int b, int& R, int& C) { const int st = b / 1024, sb = b % 1024, swz = sb ^ (((sb >> 9) & 1) << 5); R = (st >> 1) * 16 + swz / 64; C = (st & 1) * 32 + (swz % 64) / 2; }
__host__ __device__ __forceinline__ int perm32(int rho) { const int n = rho >> 4, i = rho & 15; return 8 * (i >> 2) + 4 * n + (i & 3); }

struct Unit { int pm, pn; };
struct Gemm { const bf16_t* A; const bf16_t* Bt; int M, N, K; };

struct StaticOrder {
    int nM, nN, nwg, G, c;
    __host__ __device__ void init(int M, int N, int G_, int c_) { nM = M / BM; nN = N / BM; nwg = nM * nN; G = G_; c = c_; }
    __host__ __device__ bool next(int i, Unit& u) const {
        const long L = (long)i * G + c; if (L >= nwg) return false;
        int wgid = (int)L; { const int q = nwg / NXCD, r = nwg % NXCD, xcd = wgid % NXCD, off = wgid / NXCD; wgid = (xcd < r ? xcd * (q + 1) : r * (q + 1) + (xcd - r) * q) + off; }
        const int nig = WGM * nN, gid = wgid / nig, fm = gid * WGM, gsz = (nM - fm) < WGM ? (nM - fm) : WGM;
        u.pm = fm + ((wgid % nig) % gsz); u.pn = (wgid % nig) / gsz; return true;
    }
    __device__ __forceinline__ void a_ready(const Unit&) const {}
    __device__ __forceinline__ void done(const Unit&) const {}
};

__device__ __forceinline__ unsigned cvt_pk_bf16(float lo, float hi) { unsigned r; asm volatile("v_cvt_pk_bf16_f32 %0, %1, %2" : "=v"(r) : "v"(lo), "v"(hi)); return r; }
typedef float f32x2 __attribute__((ext_vector_type(2)));
template <int ACT> struct EpiBf16 {
    static constexpr bool PERM = true, AFTER_DRAIN = false;
    bf16_t* O; int ldc;
    __device__ __forceinline__ void operator()(const f32x4 (&acc)[2][2][4][2], const Unit& u, int wr, int wc, int fr, int fq) const {
        const int row0 = u.pm * BM + wr * 64 + fr; const int col0 = u.pn * BM + wc * 32 + 8 * fq;
#pragma unroll
        for (int ai = 0; ai < 2; ++ai)
#pragma unroll
            for (int m = 0; m < 4; ++m) { bf16_t* rowp = O + (size_t)(row0 + ai * HALF + m * 16) * ldc + col0;
#pragma unroll
                for (int bj = 0; bj < 2; ++bj) { f32x4 v0 = acc[ai][bj][m][0], v1 = acc[ai][bj][m][1];
                    if (ACT == 2) { const f32x4 z = (f32x4){0.f, 0.f, 0.f, 0.f}; v0 = __builtin_elementwise_max(v0, z); v1 = __builtin_elementwise_max(v1, z); v0 = v0 * v0; v1 = v1 * v1; }
                    u32x4 w; w.x = cvt_pk_bf16(v0[0], v0[1]); w.y = cvt_pk_bf16(v0[2], v0[3]); w.z = cvt_pk_bf16(v1[0], v1[1]); w.w = cvt_pk_bf16(v1[2], v1[3]);
                    *(u32x4*)(rowp + bj * HALF) = w; } }
    }
};

template <class Epi, class Sched, bool ALIGN_EPI = false, bool SP2 = false>
__device__ __forceinline__ void gemm_phase(PG8_LAS unsigned char* lds, const Gemm g, const Sched& S, const Epi& E) {
    const int tid = threadIdx.x, wid = __builtin_amdgcn_readfirstlane(tid >> 6), lane = tid & 63, wr = wid >> 2, wc = wid & 3, fr = lane & 15, fq = lane >> 4;
    const int K = g.K, nt = K / BK;
    unsigned voffA[2], voffB[2];
#pragma unroll
    for (int i = 0; i < 2; ++i) { int R, C; stage_rc(tid * 16 + i * 8192, R, C); const int Rb = Epi::PERM ? ((R & ~31) + perm32(R & 31)) : R;
        voffA[i] = (unsigned)(R * K + C) * 2u; voffB[i] = (unsigned)(Rb * K + C) * 2u; }
    const size_t kstep = (size_t)(BK * 2);
    const size_t hstep = (size_t)HALF * K * 2;
    const size_t tstep = 2 * hstep;
    const unsigned ldsw = (unsigned)wid * 1024u;
    const int aoff = lds_byte(wr * 64 + fr, fq * 8), boff = lds_byte(wc * 32 + fr, fq * 8);
#define PG8_SA(b, h) (((b) * 2 + (h)) * HTB)
#define PG8_SB(b, h) ((4 + (b) * 2 + (h)) * HTB)
#define PG8_STAGE(bufoff, gbase, voff) do { _Pragma("unroll") for (int _i = 0; _i < 2; ++_i) \
        __builtin_amdgcn_global_load_lds((const unsigned*)((const char*)(gbase) + (voff)[_i]), (PG8_LAS unsigned*)(lds + (bufoff) + ldsw + _i * 8192), 16, 0, 0); } while (0)
#define PG8_LDA(dst, b, h) do { _Pragma("unroll") for (int m = 0; m < 4; ++m) _Pragma("unroll") for (int k = 0; k < 2; ++k) dst[m][k] = *(const PG8_LAS bf16x8*)(lds + PG8_SA(b, h) + aoff + m * 2048 + k * 1024); } while (0)
#define PG8_LDB(dst, b, h) do { _Pragma("unroll") for (int n = 0; n < 2; ++n) _Pragma("unroll") for (int k = 0; k < 2; ++k) dst[n][k] = *(const PG8_LAS bf16x8*)(lds + PG8_SB(b, h) + boff + n * 2048 + k * 1024); } while (0)
#define PG8_MMA(ai, bj, At, Bt) do { __builtin_amdgcn_s_setprio(1); _Pragma("unroll") for (int m = 0; m < 4; ++m) _Pragma("unroll") for (int n = 0; n < 2; ++n) _Pragma("unroll") for (int k = 0; k < 2; ++k) \
        acc[ai][bj][m][n] = __builtin_amdgcn_mfma_f32_16x16x32_bf16(Bt[n][k], At[m][k], acc[ai][bj][m][n], 0, 0, 0); __builtin_amdgcn_s_setprio(0); } while (0)
#define PG8_WAIT_V(n) asm volatile("s_waitcnt vmcnt(" #n ")" ::: "memory")
#define PG8_WAIT_L(n) asm volatile("s_waitcnt lgkmcnt(" #n ")" ::: "memory")
#define PG8_BAR __builtin_amdgcn_s_barrier()
#define PG8_SCHED __builtin_amdgcn_sched_barrier(0)
    Unit cur, nxt; int ui = 0;
    if (!S.next(0, cur)) return;
    f32x4 acc[2][2][4][2];
#pragma unroll
    for (int a = 0; a < 2; ++a)
#pragma unroll
        for (int b = 0; b < 2; ++b)
#pragma unroll
            for (int m = 0; m < 4; ++m)
#pragma unroll
                for (int n = 0; n < 2; ++n) acc[a][b][m][n] = (f32x4){0.f, 0.f, 0.f, 0.f};
    bf16x8 At[4][2], B0[2][2], B1[2][2];
    const char* cA = (const char*)g.A + (size_t)cur.pm * tstep; const char* cB = (const char*)g.Bt + (size_t)cur.pn * tstep;
    S.a_ready(cur);
    if constexpr (SP2) {
        PG8_STAGE(PG8_SB(0, 0), cB, voffB); PG8_STAGE(PG8_SB(0, 1), cB + hstep, voffB); PG8_STAGE(PG8_SA(0, 0), cA, voffA); PG8_STAGE(PG8_SA(0, 1), cA + hstep, voffA);
        if (wr == 1) PG8_BAR;
        PG8_WAIT_V(2); PG8_BAR;
        PG8_STAGE(PG8_SB(1, 0), cB + kstep, voffB); PG8_STAGE(PG8_SA(1, 0), cA + kstep, voffA); PG8_STAGE(PG8_SB(1, 1), cB + hstep + kstep, voffB);
        PG8_WAIT_V(6); PG8_BAR;
    } else {
        PG8_STAGE(PG8_SB(0, 0), cB, voffB); PG8_STAGE(PG8_SA(0, 0), cA, voffA); PG8_STAGE(PG8_SB(0, 1), cB + hstep, voffB); PG8_STAGE(PG8_SA(0, 1), cA + hstep, voffA);
        if (wr == 1) PG8_BAR;
        PG8_WAIT_V(4); PG8_BAR;
        PG8_STAGE(PG8_SB(1, 0), cB + kstep, voffB); PG8_STAGE(PG8_SA(1, 0), cA + kstep, voffA); PG8_STAGE(PG8_SB(1, 1), cB + hstep + kstep, voffB);
        PG8_WAIT_V(6); PG8_BAR;
    }
    for (;;) {
        const bool has_next = S.next(ui + 1, nxt);
        const char* nA = has_next ? (const char*)g.A + (size_t)nxt.pm * tstep : cA; const char* nB = has_next ? (const char*)g.Bt + (size_t)nxt.pn * tstep : cB;
        for (int t = 0; t < nt; t += 2) {
            const bool last = (t == nt - 2);
            const char* a1 = cA + (size_t)(t + 1) * kstep;
            const char* a2 = last ? nA : cA + (size_t)(t + 2) * kstep; const char* b2 = last ? nB : cB + (size_t)(t + 2) * kstep;
            const char* a3 = a2 + kstep; const char* b3 = b2 + kstep;
            if (last && has_next) S.a_ready(nxt);
            if constexpr (SP2) {
            PG8_LDB(B0, 0, 0); PG8_LDB(B1, 0, 1); PG8_SCHED; PG8_LDA(At, 0, 0); PG8_STAGE(PG8_SA(1, 1), a1 + hstep, voffA);
            PG8_WAIT_V(8); PG8_WAIT_L(0); PG8_BAR; PG8_MMA(0, 0, At, B0); PG8_MMA(0, 1, At, B1); PG8_BAR; PG8_SCHED;
            PG8_LDA(At, 0, 1); PG8_STAGE(PG8_SB(0, 0), b2, voffB); PG8_STAGE(PG8_SB(0, 1), b2 + hstep, voffB); PG8_STAGE(PG8_SA(0, 0), a2, voffA);
            PG8_WAIT_V(8); PG8_WAIT_L(0); PG8_BAR; PG8_MMA(1, 0, At, B0); PG8_MMA(1, 1, At, B1); PG8_BAR; PG8_SCHED;
            PG8_LDB(B0, 1, 0); PG8_LDB(B1, 1, 1); PG8_SCHED; PG8_LDA(At, 1, 0); PG8_STAGE(PG8_SA(0, 1), a2 + hstep, voffA);
            PG8_WAIT_V(8); PG8_WAIT_L(0); PG8_BAR; PG8_MMA(0, 0, At, B0); PG8_MMA(0, 1, At, B1); PG8_BAR; PG8_SCHED;
            PG8_LDA(At, 1, 1); PG8_STAGE(PG8_SB(1, 0), b3, voffB); PG8_STAGE(PG8_SB(1, 1), b3 + hstep, voffB); PG8_STAGE(PG8_SA(1, 0), a3, voffA);
            PG8_WAIT_V(8); PG8_WAIT_L(0); PG8_BAR; PG8_MMA(1, 0, At, B0); PG8_MMA(1, 1, At, B1); PG8_BAR; PG8_SCHED;
            } else {
            PG8_LDB(B0, 0, 0); PG8_SCHED; PG8_LDA(At, 0, 0); PG8_STAGE(PG8_SA(1, 1), a1 + hstep, voffA);
            PG8_WAIT_L(8); PG8_BAR; PG8_WAIT_L(0); PG8_MMA(0, 0, At, B0); PG8_BAR; PG8_SCHED;
            PG8_LDB(B1, 0, 1); PG8_STAGE(PG8_SB(0, 0), b2, voffB);
            PG8_BAR; PG8_WAIT_L(0); PG8_MMA(0, 1, At, B1); PG8_BAR;
            PG8_LDA(At, 0, 1); PG8_STAGE(PG8_SA(0, 0), a2, voffA);
            PG8_BAR; PG8_WAIT_L(0); PG8_MMA(1, 0, At, B0); PG8_BAR; PG8_SCHED;
            PG8_STAGE(PG8_SB(0, 1), b2 + hstep, voffB);
            PG8_WAIT_V(6); PG8_BAR; PG8_MMA(1, 1, At, B1); PG8_BAR;
            PG8_LDB(B0, 1, 0); PG8_SCHED; PG8_LDA(At, 1, 0); PG8_STAGE(PG8_SA(0, 1), a2 + hstep, voffA);
            PG8_WAIT_L(8); PG8_BAR; PG8_WAIT_L(0); PG8_MMA(0, 0, At, B0); PG8_BAR; PG8_SCHED;
            PG8_LDB(B1, 1, 1); PG8_STAGE(PG8_SB(1, 0), b3, voffB);
            PG8_BAR; PG8_WAIT_L(0); PG8_MMA(0, 1, At, B1); PG8_BAR;
            PG8_LDA(At, 1, 1); PG8_STAGE(PG8_SA(1, 0), a3, voffA);
            PG8_BAR; PG8_WAIT_L(0); PG8_MMA(1, 0, At, B0); PG8_BAR; PG8_SCHED;
            PG8_STAGE(PG8_SB(1, 1), b3 + hstep, voffB);
            PG8_WAIT_V(6); PG8_BAR; PG8_MMA(1, 1, At, B1); PG8_BAR;
            }
        }
        if constexpr (ALIGN_EPI) { if (wr == 0) PG8_BAR; }
        if constexpr (!Epi::AFTER_DRAIN) { E(acc, cur, wr, wc, fr, fq); S.done(cur); }
        if (!has_next) break;
#pragma unroll
        for (int a = 0; a < 2; ++a)
#pragma unroll
            for (int b = 0; b < 2; ++b)
#pragma unroll
                for (int m = 0; m < 4; ++m)
#pragma unroll
                    for (int n = 0; n < 2; ++n) acc[a][b][m][n] = (f32x4){0.f, 0.f, 0.f, 0.f};
        cur = nxt; cA = nA; cB = nB; ++ui;
        if constexpr (ALIGN_EPI) { if (wr == 1) PG8_BAR; }
    }
    PG8_WAIT_V(0);
    if constexpr (!ALIGN_EPI) { if (wr == 0) PG8_BAR; }
    PG8_BAR;
    if constexpr (Epi::AFTER_DRAIN) { E.fused(acc, cur, wr, wc, fr, fq, lds, wid, lane); S.done(cur); }
#undef PG8_SA
#undef PG8_SB
#undef PG8_STAGE
#undef PG8_LDA
#undef PG8_LDB
#undef PG8_MMA
#undef PG8_WAIT_V
#undef PG8_WAIT_L
#undef PG8_BAR
#undef PG8_SCHED
}
}

#define GAS __attribute__((address_space(1)))
#define LAS __attribute__((address_space(3)))
typedef unsigned short bf16;
typedef unsigned v4u __attribute__((ext_vector_type(4)));
typedef unsigned v2u __attribute__((ext_vector_type(2)));
typedef float f32x4 __attribute__((ext_vector_type(4)));
typedef float f32x2 __attribute__((ext_vector_type(2)));
typedef short bf16x8 __attribute__((ext_vector_type(8)));
typedef _Float16 h2 __attribute__((ext_vector_type(2)));
#define LDS_WAIT() asm volatile("s_waitcnt lgkmcnt(0)" ::: "memory")

constexpr int NWAVES = 8;
constexpr int NTOK = 24576, SEQ = 8192, DM = 2048, DR = 1024, DFF = 8192;
constexpr int ZLD = 5632, ZC_CA = 3072, ZC_CB = 4096, ZC_L = 5120;
constexpr size_t MiB = 1u << 20;
constexpr size_t WS_WIN = 0, WS_WOUT = 22 * MiB, WS_WUP = 30 * MiB, WS_WDN = 62 * MiB, WS_SMALL = 94 * MiB, WS_XL = 95 * MiB, WS_XG = 107 * MiB,
                 WS_BONUS = 115 * MiB, WS_H = 118 * MiB, WS_Z = 214 * MiB, WS_END = 478 * MiB;
constexpr size_t SM_G2T = 0, SM_W2TF = 384 * 1024, SM_W2TB = 512 * 1024, SM_A2TF = 640 * 1024, SM_A2TB = 768 * 1024;
constexpr size_t WS_YF = WS_Z, WS_YB = WS_Z + 96 * MiB, WS_MIX = WS_Z, WS_U = WS_Z, WS_FF = WS_Z + 128 * MiB;
constexpr size_t OUT_RS = 0, OUT_KS = 48 * MiB, OUT_VS = 96 * MiB, OUT_KK = 144 * MiB;
constexpr int LDS_BYTES = 147456;

struct Args { const float* in[30]; float* out; unsigned char* ws; int ph_lo, ph_hi; };

__device__ __forceinline__ float lo2f(unsigned u) { return __uint_as_float(u << 16); }
__device__ __forceinline__ float hi2f(unsigned u) { return __uint_as_float(u & 0xffff0000u); }
__device__ __forceinline__ unsigned f2bf(float f) { unsigned u = __float_as_uint(f); return (u + 0x7fffu + ((u >> 16) & 1u)) >> 16; }
__device__ __forceinline__ unsigned pk2(float lo, float hi) { unsigned r; asm volatile("v_cvt_pk_bf16_f32 %0, %1, %2" : "=v"(r) : "v"(lo), "v"(hi)); return r; }
__device__ __forceinline__ float fsigmoid(float x) { return __builtin_amdgcn_rcpf(1.f + __builtin_amdgcn_exp2f(-1.44269504f * x)); }
__device__ __forceinline__ float ftanh(float x) { return 1.f - 2.f * __builtin_amdgcn_rcpf(1.f + __builtin_amdgcn_exp2f(2.88539008f * x)); }
__device__ __forceinline__ float wave_sum(float v) {
#pragma unroll
    for (int o = 1; o < 64; o <<= 1) v += __shfl_xor(v, o);
    return v;
}
template <int CTRL> __device__ __forceinline__ float dppf(float x) { return __int_as_float(__builtin_amdgcn_update_dpp(0, __float_as_int(x), CTRL, 0xF, 0xF, true)); }
__device__ __forceinline__ float red8(float x) { x += dppf<0xB1>(x); x += dppf<0x4E>(x); x += dppf<0x141>(x); return x; }
__device__ __forceinline__ const float* xrow(const Args& a, int m) { return m < 16384 ? a.in[0] + (size_t)m * DM : a.in[1] + (size_t)(m - 16384) * DM; }

__device__ __forceinline__ void tr_item(const float* W, int ldw, int k0, int sc0, bf16* WT, int ldt, int dr0, LAS float* scr, int lane) {
#pragma unroll 8
    for (int i = 0; i < 32; ++i) { const int kk = 2 * i + (lane >> 5); scr[kk * 33 + (lane & 31)] = W[(size_t)(k0 + kk) * ldw + sc0 + (lane & 31)]; }
    LDS_WAIT(); asm volatile("" ::: "memory");
    const int c = lane & 7;
#pragma unroll
    for (int j = 0; j < 4; ++j) { const int n = (lane >> 3) + 8 * j; const LAS float* s = scr + (8 * c) * 33 + n;
        v4u o; o.x = pk2(s[0 * 33], s[1 * 33]); o.y = pk2(s[2 * 33], s[3 * 33]); o.z = pk2(s[4 * 33], s[5 * 33]); o.w = pk2(s[6 * 33], s[7 * 33]);
        *(v4u*)(WT + (size_t)(dr0 + n) * ldt + k0 + 8 * c) = o; }
    LDS_WAIT(); asm volatile("" ::: "memory");
}
__device__ __forceinline__ void rms_row_bf16(const float* xr_, const float* g, bf16* orow, int lane) {
    const f32x4* xr = (const f32x4*)xr_ + lane; const f32x4* gr = (const f32x4*)g + lane;
    f32x4 v[8]; float s = 0.f;
#pragma unroll
    for (int j = 0; j < 8; ++j) { v[j] = xr[64 * j]; s += (v[j].x * v[j].x + v[j].y * v[j].y) + (v[j].z * v[j].z + v[j].w * v[j].w); }
    const float rstd = 1.f / sqrtf(wave_sum(s) * (1.f / DM) + 1e-6f);
    v2u* o8 = (v2u*)orow + lane;
#pragma unroll
    for (int j = 0; j < 8; ++j) { const f32x4 gg = gr[64 * j]; v2u o; o.x = pk2(v[j].x * rstd * gg.x, v[j].y * rstd * gg.y); o.y = pk2(v[j].z * rstd * gg.z, v[j].w * rstd * gg.w); o8[64 * j] = o; }
}
__device__ __forceinline__ void p0_prologue(const Args& a, LAS unsigned char* lds, int gw, int NGW, int wave, int lane) {
    unsigned char* ws = a.ws;
    LAS float* scr = (LAS float*)(lds + wave * 16384);
    bf16* WIN = (bf16*)(ws + WS_WIN); bf16* WOUT = (bf16*)(ws + WS_WOUT); bf16* WUP = (bf16*)(ws + WS_WUP); bf16* WDN = (bf16*)(ws + WS_WDN);
    constexpr int I_IN = 32 * 173, I_OUT = 32 * 64, I_UP = 32 * 256, I_DN = 128 * 64, I_S = 32;
    constexpr int NITEMS = I_IN + I_OUT + I_UP + I_DN + 4 * I_S;
    for (int it = gw; it < NITEMS; it += NGW) {
        int r = it;
        if (r < I_IN) { const int kb = r / 173, nb = r % 173, sc0 = nb * 32; const int dr0 = sc0 < 3072 ? sc0 : (sc0 < 3488 ? ZC_L + (sc0 - 3072) : ZC_CA + (sc0 - 3488));
            tr_item(a.in[3], 5536, kb * 64, sc0, WIN, DM, dr0, scr, lane); continue; } r -= I_IN;
        if (r < I_OUT) { tr_item(a.in[24], DM, (r / 64) * 64, (r % 64) * 32, WOUT, DM, (r % 64) * 32, scr, lane); continue; } r -= I_OUT;
        if (r < I_UP) { tr_item(a.in[27], DFF, (r / 256) * 64, (r % 256) * 32, WUP, DM, (r % 256) * 32, scr, lane); continue; } r -= I_UP;
        if (r < I_DN) { tr_item(a.in[28], DM, (r / 64) * 64, (r % 64) * 32, WDN, DFF, (r % 64) * 32, scr, lane); continue; } r -= I_DN;
        { const int which = r / I_S, nb = r % I_S; const float* src = which == 0 ? a.in[7] : which == 1 ? a.in[9] : which == 2 ? a.in[11] : a.in[13];
          bf16* dst = (bf16*)(ws + WS_SMALL + (which == 0 ? SM_W2TF : which == 1 ? SM_W2TB : which == 2 ? SM_A2TF : SM_A2TB));
          tr_item(src, DR, 0, nb * 32, dst, 64, nb * 32, scr, lane); }
    }
    { const int gt = gw * 64 + lane, NGT = NGW * 64;
      v4u zz = {0u, 0u, 0u, 0u}; v4u* zp = (v4u*)(WIN + (size_t)5536 * DM);
      for (int i = gt; i < 96 * DM / 8; i += NGT) zp[i] = zz;
      bf16* G2T = (bf16*)(ws + WS_SMALL + SM_G2T); const float* g2 = a.in[14];
      for (int i = gt; i < 160 * 1024; i += NGT) { const int k = i >> 10, n = i & 1023; G2T[n * 160 + k] = (bf16)f2bf(g2[i]); } }
    bf16* H = (bf16*)(ws + WS_H);
    for (int m = gw; m < NTOK; m += NGW) rms_row_bf16(xrow(a, m), a.in[2], H + (size_t)m * DM, lane);
}

__device__ __forceinline__ void shift_phase(const Args& a, int gw, int NGW, int lane) {
    unsigned char* ws = a.ws;
    const bf16* Z = (const bf16*)(ws + WS_Z);
    bf16* RS = (bf16*)((unsigned char*)a.out + OUT_RS); bf16* KS = (bf16*)((unsigned char*)a.out + OUT_KS);
    bf16* VS = (bf16*)((unsigned char*)a.out + OUT_VS); bf16* KK = (bf16*)((unsigned char*)a.out + OUT_KK);
    bf16* XL = (bf16*)(ws + WS_XL); bf16* XG = (bf16*)(ws + WS_XG); float* BONUS = (float*)(ws + WS_BONUS);
    const float* mup = a.in[4]; const float* mun = a.in[5]; const float* k_k = a.in[15]; const float* r_k = a.in[17];
    const int hp2 = lane >> 5, n2 = (lane & 31) * 2;
    for (int m = gw; m < NTOK; m += NGW) {
        const int t = m & (SEQ - 1); const bool hp = t > 0, hn = t < SEQ - 1;
        const bf16* z0 = Z + (size_t)m * ZLD; const bf16* zp = z0 - ZLD; const bf16* zn = z0 + ZLD;
#pragma unroll 2
        for (int hh = 0; hh < 8; ++hh) {
            const int c = (hh * 2 + hp2) * 64 + n2;
            float s[3][2];
#pragma unroll
            for (int ar = 0; ar < 3; ++ar) { const int col = ar * 1024 + c;
                const unsigned zc = *(const unsigned*)(z0 + col); const unsigned zpv = hp ? *(const unsigned*)(zp + col) : 0u; const unsigned znv = hn ? *(const unsigned*)(zn + col) : 0u;
                const f32x2 mp = *(const f32x2*)(mup + col), mn = *(const f32x2*)(mun + col);
                const float x0 = lo2f(zc), x1 = hi2f(zc);
                s[ar][0] = x0 + mp.x * (lo2f(zpv) - x0) + mn.x * (lo2f(znv) - x0);
                s[ar][1] = x1 + mp.y * (hi2f(zpv) - x1) + mn.y * (hi2f(znv) - x1); }
            const f32x2 kkw = *(const f32x2*)(k_k + c), rkw = *(const f32x2*)(r_k + c);
            const float kr0 = s[1][0] * kkw.x, kr1 = s[1][1] * kkw.y;
            float ss = kr0 * kr0 + kr1 * kr1, bs = s[0][0] * s[1][0] * rkw.x + s[0][1] * s[1][1] * rkw.y;
#pragma unroll
            for (int o = 1; o < 32; o <<= 1) { ss += __shfl_xor(ss, o); bs += __shfl_xor(bs, o); }
            const float inv = 1.f / fmaxf(sqrtf(ss), 1e-12f);
            const size_t o = (size_t)m * DR + c;
            *(unsigned*)(RS + o) = pk2(s[0][0], s[0][1]); *(unsigned*)(KS + o) = pk2(s[1][0], s[1][1]);
            *(unsigned*)(VS + o) = pk2(s[2][0], s[2][1]); *(unsigned*)(KK + o) = pk2(kr0 * inv, kr1 * inv);
            if ((lane & 31) == 0) BONUS[m * 16 + hh * 2 + hp2] = bs;
        }
#pragma unroll
        for (int p = 0; p < 7; ++p) { const int j = p * 64 + lane;
            if (j < 416) { const int col = ZC_L + j, og = 3072 + j;
                const float x0 = lo2f(z0[col]); const float xp = hp ? lo2f(zp[col]) : 0.f; const float xn = hn ? lo2f(zn[col]) : 0.f;
                const float sv = x0 + mup[og] * (xp - x0) + mun[og] * (xn - x0);
                if (j < 128) XL[(size_t)m * 256 + j] = (bf16)f2bf(ftanh(sv));
                else if (j < 256) XL[(size_t)m * 256 + j] = (bf16)f2bf(sv);
                else XG[(size_t)m * 160 + (j - 256)] = (bf16)f2bf(fsigmoid(sv)); } }
    }
}

#define TR_STAGE(D_, N_) { const bool up_ = (lane & (D_)) != 0; _Pragma("unroll") for (int i_ = 0; i_ < (N_) / 2; ++i_) { \
    const float keep_ = up_ ? vals[i_ + (N_) / 2] : vals[i_]; const float send_ = up_ ? vals[i_] : vals[i_ + (N_) / 2]; vals[i_] = keep_ + __shfl_xor(send_, (D_)); } }
__device__ __forceinline__ void conv_phase(const Args& a, unsigned char* lds, int tid, int wave, int lane) {
    unsigned char* ws = a.ws;
    const bf16* Z = (const bf16*)(ws + WS_Z); bf16* MIXIN = (bf16*)(ws + WS_H);
    h2* utile = (h2*)lds;
    float* part = (float*)(lds + 126976);
    f32x2* stats = (f32x2*)(lds + 126976 + 2048);
    const float* dw_w = a.in[20]; const float* dw_b = a.in[21]; const float* cln_w = a.in[22]; const float* cln_b = a.in[23];
    const int cp = tid;
    for (int unit = blockIdx.x; unit < NTOK / 32; unit += gridDim.x) {
        const int m0 = unit * 32, t0 = m0 & (SEQ - 1);
        for (int idx = tid; idx < 62 * 512; idx += 512) { const int row = idx >> 9, c2 = idx & 511; const int t = t0 - 15 + row;
            h2 u = {(_Float16)0.f, (_Float16)0.f};
            if (t >= 0 && t < SEQ) { const bf16* zr = Z + (size_t)(m0 - 15 + row) * ZLD; const unsigned za = *(const unsigned*)(zr + ZC_CA + 2 * c2), zb = *(const unsigned*)(zr + ZC_CB + 2 * c2);
                u.x = (_Float16)(lo2f(za) * fsigmoid(lo2f(zb))); u.y = (_Float16)(hi2f(za) * fsigmoid(hi2f(zb))); }
            utile[idx] = u; }
        __syncthreads();
        f32x2 w[31];
#pragma unroll
        for (int j = 0; j < 31; ++j) w[j] = *(const f32x2*)(dw_w + j * 1024 + 2 * cp);
        const f32x2 bias = *(const f32x2*)(dw_b + 2 * cp);
        f32x2 out[32];
#pragma unroll
        for (int tb = 0; tb < 4; ++tb) {
            f32x2 acc[8];
#pragma unroll
            for (int o = 0; o < 8; ++o) acc[o] = bias;
#pragma unroll
            for (int jj = 0; jj < 38; ++jj) { const h2 uh = utile[(tb * 8 + jj) * 512 + cp]; const f32x2 u = {(float)uh.x, (float)uh.y};
#pragma unroll
                for (int o = 0; o < 8; ++o) { const int j = jj - o; if (j >= 0 && j < 31) acc[o] = u * w[j] + acc[o]; } }
#pragma unroll
            for (int o = 0; o < 8; ++o) out[tb * 8 + o] = acc[o];
            asm volatile("" ::: "memory");
        }
        float vals[64];
#pragma unroll
        for (int t = 0; t < 32; ++t) { vals[2 * t] = out[t].x + out[t].y; vals[2 * t + 1] = out[t].x * out[t].x + out[t].y * out[t].y; }
        TR_STAGE(32, 64) TR_STAGE(16, 32) TR_STAGE(8, 16) TR_STAGE(4, 8) TR_STAGE(2, 4) TR_STAGE(1, 2)
        part[wave * 64 + lane] = vals[0];
        __syncthreads();
        if (tid < 32) { float s = 0.f, q = 0.f;
#pragma unroll
            for (int wv = 0; wv < 8; ++wv) { s += part[wv * 64 + 2 * tid]; q += part[wv * 64 + 2 * tid + 1]; }
            const float mean = s * (1.f / 1024.f); const float var = q * (1.f / 1024.f) - mean * mean;
            stats[tid] = (f32x2){mean, 1.f / sqrtf(var + 1e-5f)}; }
        __syncthreads();
        const f32x2 lw = *(const f32x2*)(cln_w + 2 * cp), lb = *(const f32x2*)(cln_b + 2 * cp);
#pragma unroll
        for (int t = 0; t < 32; ++t) { const f32x2 st = stats[t];
            const float y0 = (out[t].x - st.x) * st.y * lw.x + lb.x, y1 = (out[t].y - st.x) * st.y * lw.y + lb.y;
            *(unsigned*)(MIXIN + (size_t)(m0 + t) * DM + DR + 2 * cp) = pk2(y0 * fsigmoid(y0), y1 * fsigmoid(y1)); }
        __syncthreads();
    }
}

constexpr int SC_LD = 68, SC_ARR = 32 * SC_LD, SC_ARR4 = SC_ARR / 4, SC_BUF = 6 * SC_ARR * 4;
struct ScanOps { f32x4 q0, q1, w0, w1, a0, a1, m0, m1, r0, r1; float vv; };
__device__ __forceinline__ void ld_ops(ScanOps& o, const float* cb, int i, int ks, int rr) {
    const f32x4* p = (const f32x4*)(cb + i * SC_LD + ks * 8);
    o.q0 = p[0]; o.q1 = p[1]; o.w0 = p[SC_ARR4]; o.w1 = p[SC_ARR4 + 1]; o.a0 = p[2 * SC_ARR4]; o.a1 = p[2 * SC_ARR4 + 1];
    o.m0 = p[3 * SC_ARR4]; o.m1 = p[3 * SC_ARR4 + 1]; o.r0 = p[4 * SC_ARR4]; o.r1 = p[4 * SC_ARR4 + 1]; o.vv = cb[5 * SC_ARR + i * SC_LD + rr];
}
__device__ __forceinline__ void scan_phase(const Args& a, unsigned char* lds, int wave, int lane) {
    if (blockIdx.x >= 192) return;
    unsigned char* ws = a.ws;
    const int scan = blockIdx.x >> 1, half = blockIdx.x & 1, dir = scan & 1, sh = scan >> 1, seq = sh >> 4, h = sh & 15;
    const size_t row0 = (size_t)seq * SEQ;
    const bf16* RS = (const bf16*)((unsigned char*)a.out + OUT_RS); const bf16* KS = (const bf16*)((unsigned char*)a.out + OUT_KS);
    const bf16* VS = (const bf16*)((unsigned char*)a.out + OUT_VS); const bf16* KK = (const bf16*)((unsigned char*)a.out + OUT_KK);
    const bf16* XL = (const bf16*)(ws + WS_XL);
    float* Y = (float*)(ws + (dir ? WS_YB : WS_YF));
    constexpr int NCH = SEQ / 32;
    const int ks = lane & 7, rr = half * 32 + (wave & 3) * 8 + (lane >> 3);
    f32x2 S0 = {0.f, 0.f}, S1 = S0, S2 = S0, S3 = S0;
    float* ybase = Y + row0 * DR + h * 64 + rr;
    const int pw = wave & 3, fr = lane & 15, fq = lane >> 4, cl = pw * 16 + fq * 4, gcol = h * 64 + cl;
    bf16x8 Bw0, Bw1, Ba0, Ba1; f32x4 w0v, a0v, kav;
    {
        const bf16* W2T = (const bf16*)(ws + WS_SMALL + (dir ? SM_W2TB : SM_W2TF)); const bf16* A2T = (const bf16*)(ws + WS_SMALL + (dir ? SM_A2TB : SM_A2TF));
        const size_t bo = (size_t)(h * 64 + pw * 16 + fr) * 64 + fq * 8;
        Bw0 = *(const bf16x8*)(W2T + bo); Bw1 = *(const bf16x8*)(W2T + bo + 32); Ba0 = *(const bf16x8*)(A2T + bo); Ba1 = *(const bf16x8*)(A2T + bo + 32);
        w0v = *(const f32x4*)((dir ? a.in[8] : a.in[6]) + gcol); a0v = *(const f32x4*)((dir ? a.in[12] : a.in[10]) + gcol); kav = *(const f32x4*)(a.in[16] + gcol);
    }
    for (int c = 0; c <= NCH; ++c) {
        if (wave >= 4) {
            if (c < NCH) {
                float* cb = (float*)(lds + (c & 1) * SC_BUF);
#pragma unroll
                for (int mt = 0; mt < 2; ++mt) {
                    const int i = mt * 16 + fr, step = c * 32 + i, t = dir ? (SEQ - 1 - step) : step; const size_t m = row0 + t;
                    const bf16* xl = XL + m * 256 + dir * 64 + fq * 8;
                    const bf16x8 At0 = *(const bf16x8*)(xl), At1 = *(const bf16x8*)(xl + 32), Aa0 = *(const bf16x8*)(xl + 128), Aa1 = *(const bf16x8*)(xl + 160);
                    const size_t go = m * DR + gcol;
                    const v2u r4 = *(const v2u*)(RS + go), k4 = *(const v2u*)(KS + go), v4 = *(const v2u*)(VS + go), q4 = *(const v2u*)(KK + go);
                    f32x4 aw = {0.f, 0.f, 0.f, 0.f}, aa = aw;
                    aw = __builtin_amdgcn_mfma_f32_16x16x32_bf16(Bw0, At0, aw, 0, 0, 0); aw = __builtin_amdgcn_mfma_f32_16x16x32_bf16(Bw1, At1, aw, 0, 0, 0);
                    aa = __builtin_amdgcn_mfma_f32_16x16x32_bf16(Ba0, Aa0, aa, 0, 0, 0); aa = __builtin_amdgcn_mfma_f32_16x16x32_bf16(Ba1, Aa1, aa, 0, 0, 0);
                    const f32x4 rv = {lo2f(r4.x), hi2f(r4.x), lo2f(r4.y), hi2f(r4.y)}, kv = {lo2f(k4.x), hi2f(k4.x), lo2f(k4.y), hi2f(k4.y)};
                    const f32x4 vv = {lo2f(v4.x), hi2f(v4.x), lo2f(v4.y), hi2f(v4.y)}, qv = {lo2f(q4.x), hi2f(q4.x), lo2f(q4.y), hi2f(q4.y)};
                    f32x4 wv, av;
#pragma unroll
                    for (int j = 0; j < 4; ++j) { const float sg = fsigmoid(w0v[j] + aw[j]); wv[j] = __builtin_amdgcn_exp2f(-0.87500596f * sg); av[j] = fsigmoid(a0v[j] + aa[j]); }
                    const f32x4 kav4 = qv * av, kmv = kv * (1.f + (av - 1.f) * kav);
                    f32x4* dst = (f32x4*)(cb + i * SC_LD + cl);
                    dst[0] = qv; dst[SC_ARR4] = wv; dst[2 * SC_ARR4] = kav4; dst[3 * SC_ARR4] = kmv; dst[4 * SC_ARR4] = rv; dst[5 * SC_ARR4] = vv;
                }
            }
        } else if (c > 0) {
            const float* cb = (const float*)(lds + ((c - 1) & 1) * SC_BUF);
            const int cbase = (c - 1) * 32;
            ScanOps o[2]; ld_ops(o[0], cb, 0, ks, rr);
#pragma unroll
            for (int g = 0; g < 4; ++g) {
                float ysel = 0.f;
#pragma unroll
                for (int j = 0; j < 8; ++j) {
                    const int i = g * 8 + j;
                    if (i + 1 < 32) ld_ops(o[(i + 1) & 1], cb, i + 1, ks, rr);
                    const ScanOps& x = o[i & 1];
                    f32x2 acc = S0 * x.q0.xy, acc2 = S1 * x.q0.zw; acc = S2 * x.q1.xy + acc; acc2 = S3 * x.q1.zw + acc2; acc = acc + acc2;
                    const float sa = red8(acc.x + acc.y);
                    const f32x2 sav = {sa, sa}, vv2 = {x.vv, x.vv};
                    S0 = S0 * x.w0.xy + (vv2 * x.m0.xy - sav * x.a0.xy); S1 = S1 * x.w0.zw + (vv2 * x.m0.zw - sav * x.a0.zw);
                    S2 = S2 * x.w1.xy + (vv2 * x.m1.xy - sav * x.a1.xy); S3 = S3 * x.w1.zw + (vv2 * x.m1.zw - sav * x.a1.zw);
                    f32x2 yq = S0 * x.r0.xy, yq2 = S1 * x.r0.zw; yq = S2 * x.r1.xy + yq; yq2 = S3 * x.r1.zw + yq2; yq = yq + yq2;
                    const float y = red8(yq.x + yq.y);
                    ysel = (ks == j) ? y : ysel;
                }
                const int step = cbase + g * 8 + ks, t = dir ? (SEQ - 1 - step) : step;
                ybase[(size_t)t * DR] = ysel;
            }
        }
        __syncthreads();
    }
}

__device__ __forceinline__ void post_phase(const Args& a, int wave, int lane) {
    unsigned char* ws = a.ws;
    const bf16* XG = (const bf16*)(ws + WS_XG); const bf16* G2T = (const bf16*)(ws + WS_SMALL + SM_G2T);
    const float* YF = (const float*)(ws + WS_YF); const float* YB = (const float*)(ws + WS_YB); const float* BONUS = (const float*)(ws + WS_BONUS);
    const bf16* VS = (const bf16*)((unsigned char*)a.out + OUT_VS); bf16* MIXIN = (bf16*)(ws + WS_H);
    const float* gn_w = a.in[18]; const float* gn_b = a.in[19];
    const int fr = lane & 15, fq = lane >> 4, n0 = wave * 128;
    for (int unit = blockIdx.x; unit < NTOK / 32; unit += gridDim.x) {
        const int m0 = unit * 32;
        f32x4 acc[2][8];
#pragma unroll
        for (int mt = 0; mt < 2; ++mt)
#pragma unroll
            for (int nt = 0; nt < 8; ++nt) acc[mt][nt] = (f32x4){0.f, 0.f, 0.f, 0.f};
#pragma unroll
        for (int kq = 0; kq < 5; ++kq) {
            bf16x8 A[2];
#pragma unroll
            for (int mt = 0; mt < 2; ++mt) A[mt] = *(const bf16x8*)(XG + (size_t)(m0 + mt * 16 + fr) * 160 + kq * 32 + fq * 8);
#pragma unroll
            for (int nt = 0; nt < 8; ++nt) { const bf16x8 B = *(const bf16x8*)(G2T + (size_t)(n0 + nt * 16 + fr) * 160 + kq * 32 + fq * 8);
#pragma unroll
                for (int mt = 0; mt < 2; ++mt) acc[mt][nt] = __builtin_amdgcn_mfma_f32_16x16x32_bf16(B, A[mt], acc[mt][nt], 0, 0, 0); }
        }
#pragma unroll
        for (int mt = 0; mt < 2; ++mt) { const size_t m = (size_t)(m0 + mt * 16 + fr);
#pragma unroll
            for (int hh = 0; hh < 2; ++hh) { const int hd = wave * 2 + hh;
                f32x4 y[4]; float s = 0.f;
#pragma unroll
                for (int q = 0; q < 4; ++q) { const size_t o = m * DR + n0 + (hh * 4 + q) * 16 + fq * 4; y[q] = *(const f32x4*)(YF + o) + *(const f32x4*)(YB + o); s += (y[q].x + y[q].y) + (y[q].z + y[q].w); }
                s += __shfl_xor(s, 16); s += __shfl_xor(s, 32);
                const float mean = s * (1.f / 64.f); float ss = 0.f;
#pragma unroll
                for (int q = 0; q < 4; ++q) { y[q] = y[q] - mean; ss += (y[q].x * y[q].x + y[q].y * y[q].y) + (y[q].z * y[q].z + y[q].w * y[q].w); }
                ss += __shfl_xor(ss, 16); ss += __shfl_xor(ss, 32);
                const float rstd = 1.f / sqrtf(ss * (1.f / 64.f) + 64e-5f); const float bs = BONUS[m * 16 + hd];
#pragma unroll
                for (int q = 0; q < 4; ++q) { const int c = n0 + (hh * 4 + q) * 16 + fq * 4; const f32x4 gw4 = *(const f32x4*)(gn_w + c), gb4 = *(const f32x4*)(gn_b + c);
                    const v2u v4 = *(const v2u*)(VS + m * DR + c); const f32x4 vv = {lo2f(v4.x), hi2f(v4.x), lo2f(v4.y), hi2f(v4.y)};
                    const f32x4 o = (y[q] * rstd * gw4 + gb4 + bs * vv) * acc[mt][hh * 4 + q];
                    v2u ov; ov.x = pk2(o.x, o.y); ov.y = pk2(o.z, o.w); *(v2u*)(MIXIN + m * DM + c) = ov; }
            }
        }
    }
}

__device__ __forceinline__ void mid_rows(const Args& a, int gw, int NGW, int lane) {
    unsigned char* ws = a.ws; const bf16* MIX = (const bf16*)(ws + WS_MIX); bf16* H = (bf16*)(ws + WS_H);
    const f32x4* g1 = (const f32x4*)a.in[25] + lane; const f32x4* g2 = (const f32x4*)a.in[26] + lane;
    for (int m = gw; m < NTOK; m += NGW) {
        const v2u* mr = (const v2u*)(MIX + (size_t)m * DM) + lane; const f32x4* xr = (const f32x4*)xrow(a, m) + lane;
        f32x4 v[8]; float s = 0.f;
#pragma unroll
        for (int j = 0; j < 8; ++j) { const v2u u = mr[64 * j]; v[j] = (f32x4){lo2f(u.x), hi2f(u.x), lo2f(u.y), hi2f(u.y)}; s += (v[j].x * v[j].x + v[j].y * v[j].y) + (v[j].z * v[j].z + v[j].w * v[j].w); }
        const float rstd = 1.f / sqrtf(wave_sum(s) * (1.f / DM) + 1e-6f); float s1 = 0.f;
        f32x4* orow = (f32x4*)(a.out + (size_t)m * DM) + lane;
#pragma unroll
        for (int j = 0; j < 8; ++j) { v[j] = xr[64 * j] + v[j] * rstd * g1[64 * j]; orow[64 * j] = v[j]; s1 += (v[j].x * v[j].x + v[j].y * v[j].y) + (v[j].z * v[j].z + v[j].w * v[j].w); }
        const float rstd1 = 1.f / sqrtf(wave_sum(s1) * (1.f / DM) + 1e-6f);
        v2u* hr = (v2u*)(H + (size_t)m * DM) + lane;
#pragma unroll
        for (int j = 0; j < 8; ++j) { const f32x4 gg = g2[64 * j]; v2u o; o.x = pk2(v[j].x * rstd1 * gg.x, v[j].y * rstd1 * gg.y); o.y = pk2(v[j].z * rstd1 * gg.z, v[j].w * rstd1 * gg.w); hr[64 * j] = o; }
    }
}
__device__ __forceinline__ void final_rows(const Args& a, int gw, int NGW, int lane) {
    unsigned char* ws = a.ws; const bf16* FF = (const bf16*)(ws + WS_FF);
    const f32x4* g1 = (const f32x4*)a.in[29] + lane;
    for (int m = gw; m < NTOK; m += NGW) {
        const v2u* mr = (const v2u*)(FF + (size_t)m * DM) + lane;
        f32x4 v[8]; float s = 0.f;
#pragma unroll
        for (int j = 0; j < 8; ++j) { const v2u u = mr[64 * j]; v[j] = (f32x4){lo2f(u.x), hi2f(u.x), lo2f(u.y), hi2f(u.y)}; s += (v[j].x * v[j].x + v[j].y * v[j].y) + (v[j].z * v[j].z + v[j].w * v[j].w); }
        const float rstd = 1.f / sqrtf(wave_sum(s) * (1.f / DM) + 1e-6f);
        f32x4* orow = (f32x4*)(a.out + (size_t)m * DM) + lane;
#pragma unroll
        for (int j = 0; j < 8; ++j) orow[64 * j] = orow[64 * j] + v[j] * rstd * g1[64 * j];
    }
}

__global__ void __launch_bounds__(NWAVES * 64, 2) hymba_fwd(Args args) {
    extern __shared__ __attribute__((aligned(16))) unsigned char lds[];
    cg::grid_group grid = cg::this_grid();
    LAS unsigned char* ldsl = (LAS unsigned char*)lds;
    const int tid = threadIdx.x, lane = tid & 63, wave = __builtin_amdgcn_readfirstlane(tid >> 6);
    const int G = gridDim.x, gw = blockIdx.x * NWAVES + wave, NGW = G * NWAVES;
    unsigned char* ws = args.ws;
    const int lo = args.ph_lo, hi = args.ph_hi;
#define IN(k) (lo <= (k) && (k) < hi)
#define SEAM(k) do { if (IN(k) && IN((k) + 1)) grid.sync(); } while (0)
    typedef pg8::EpiBf16<0> E0; typedef pg8::EpiBf16<2> E2;
    if (IN(0)) { p0_prologue(args, ldsl, gw, NGW, wave, lane); }
    SEAM(0);
#ifndef NO_G1
    if (IN(1)) { pg8::Gemm g{(const bf16*)(ws + WS_H), (const bf16*)(ws + WS_WIN), NTOK, ZLD, DM}; pg8::StaticOrder S; S.init(NTOK, ZLD, G, (int)blockIdx.x);
        E0 E{(bf16*)(ws + WS_Z), ZLD}; pg8::gemm_phase<E0, pg8::StaticOrder, true, true>(ldsl, g, S, E); }
#endif
    SEAM(1);
    if (IN(2)) {
#ifndef NO_SHIFT
 shift_phase(args, gw, NGW, lane);
#endif
#ifndef NO_CONV
 conv_phase(args, lds, tid, wave, lane);
#endif
 }
    SEAM(2);
    if (IN(3)) {
#ifndef NO_SCAN
 scan_phase(args, lds, wave, lane);
#ifdef PROBE_SCAN2
 __syncthreads(); scan_phase(args, lds, wave, lane);
#endif
#endif
 }
    SEAM(3);
    if (IN(4)) {
#ifndef NO_POST
 post_phase(args, wave, lane);
#endif
 }
    SEAM(4);
#ifndef NO_G5
    if (IN(5)) { pg8::Gemm g{(const bf16*)(ws + WS_H), (const bf16*)(ws + WS_WOUT), NTOK, DM, DM}; pg8::StaticOrder S; S.init(NTOK, DM, G, (int)blockIdx.x);
        E0 E{(bf16*)(ws + WS_MIX), DM}; pg8::gemm_phase<E0, pg8::StaticOrder, true, true>(ldsl, g, S, E); }
#endif
    SEAM(5);
    if (IN(6)) { mid_rows(args, gw, NGW, lane); }
    SEAM(6);
#ifndef NO_G7
    if (IN(7)) {
#pragma unroll
        for (int s = 0; s < 3; ++s) {
            { pg8::Gemm g{(const bf16*)(ws + WS_H) + (size_t)s * SEQ * DM, (const bf16*)(ws + WS_WUP), SEQ, DFF, DM}; pg8::StaticOrder S; S.init(SEQ, DFF, G, (int)blockIdx.x);
              E2 E{(bf16*)(ws + WS_U), DFF}; pg8::gemm_phase<E2, pg8::StaticOrder, true, true>(ldsl, g, S, E); }
            grid.sync();
            { pg8::Gemm g{(const bf16*)(ws + WS_U), (const bf16*)(ws + WS_WDN), SEQ, DM, DFF}; pg8::StaticOrder S; S.init(SEQ, DM, G, (int)blockIdx.x);
              E0 E{(bf16*)(ws + WS_FF) + (size_t)s * SEQ * DM, DM}; pg8::gemm_phase<E0, pg8::StaticOrder, true, true>(ldsl, g, S, E); }
            if (s < 2) grid.sync();
        }
    }
#endif
    SEAM(7);
    if (IN(8)) { final_rows(args, gw, NGW, lane); }
#undef IN
#undef SEAM
}

extern "C" void kernel_launch(void* const* d_in, const int* in_sizes, int n_in, void* d_out, int out_size, void* d_ws, size_t ws_size, hipStream_t stream) {
    static int grid = 0;
    if (grid == 0) {
        if (n_in != 30 || ws_size < WS_END) { fprintf(stderr, "kernel_launch: unexpected n_in %d / ws %zu\n", n_in, ws_size); grid = -1; return; }
        int dev = 0, cus = 0, per_cu = 0;
        hipGetDevice(&dev); hipDeviceGetAttribute(&cus, hipDeviceAttributeMultiprocessorCount, dev);
        if (hipFuncSetAttribute((const void*)hymba_fwd, hipFuncAttributeMaxDynamicSharedMemorySize, LDS_BYTES) != hipSuccess) { fprintf(stderr, "kernel_launch: hipFuncSetAttribute failed\n"); grid = -1; return; }
        hipOccupancyMaxActiveBlocksPerMultiprocessor(&per_cu, (const void*)hymba_fwd, NWAVES * 64, LDS_BYTES);
        (void)hipGetLastError();
        if (per_cu < 1) per_cu = 1;
        grid = cus * 1;
        if (grid < 192) { fprintf(stderr, "kernel_launch: grid %d too small\n", grid); grid = -1; return; }
    }
    if (grid < 0) return;
    Args a{};
    for (int i = 0; i < 30; ++i) a.in[i] = (const float*)d_in[i];
    a.out = (float*)d_out; a.ws = (unsigned char*)d_ws;
#ifndef N_LAUNCH_SPLIT
    a.ph_lo = 0; a.ph_hi = 9;
    void* kargs[] = {&a};
    hipError_t e = hipLaunchCooperativeKernel((const void*)hymba_fwd, dim3(grid), dim3(NWAVES * 64), kargs, LDS_BYTES, stream);
    if (e != hipSuccess) fprintf(stderr, "cooperative launch failed: %s (grid %d)\n", hipGetErrorString(e), grid);
#else
    for (int p = 0; p < 9; ++p) { a.ph_lo = p; a.ph_hi = p + 1; void* kargs[] = {&a};
        hipError_t e = hipLaunchCooperativeKernel((const void*)hymba_fwd, dim3(grid), dim3(NWAVES * 64), kargs, LDS_BYTES, stream);
        if (e != hipSuccess) fprintf(stderr, "cooperative launch %d failed: %s (grid %d)\n", p, hipGetErrorString(e), grid); }
#endif
}
```

```cpp
#include <hip/hip_runtime.h>
#include <hip/hip_cooperative_groups.h>
#include <cstdio>
#include <cstdint>
namespace cg = cooperative_groups;
namespace pg8 {
#define PG8_LAS __attribute__((address_space(3)))
typedef unsigned short bf16_t;
typedef short bf16x8 __attribute__((ext_vector_type(8)));
typedef float f32x4 __attribute__((ext_vector_type(4)));
typedef unsigned u32x4 __attribute__((ext_vector_type(4)));
constexpr int BM = 256, BK = 64, HALF = 128, HTB = HALF * BK * 2  , STAGE_BYTES = 8 * HTB, NXCD = 8, WGM = 8;

__host__ __device__ __forceinline__ int lds_byte(int r, int c) { const int st = (r >> 4) * 2 + (c >> 5), rr = r & 15, cc = c & 31, ob = rr * 64 + cc * 2; return st * 1024 + (ob ^ (((ob >> 9) & 1) << 5)); }
__host__ __device__ __forceinline__ void stage_rc(int b, int& R, int& C) { const int st = b / 1024, sb = b % 1024, swz = sb ^ (((sb >> 9) & 1) << 5); R = (st >> 1) * 16 + swz / 64; C = (st & 1) * 32 + (swz % 64) / 2; }
__host__ __device__ __forceinline__ int perm32(int rho) { const int n = rho >> 4, i = rho & 15; return 8 * (i >> 2) + 4 * n + (i & 3); }

struct Unit { int pm, pn; };
struct Gemm { const bf16_t* A; const bf16_t* Bt; int M, N, K; };

struct StaticOrder {
    int nM, nN, nwg, G, c;
    __host__ __device__ void init(int M, int N, int G_, int c_) { nM = M / BM; nN = N / BM; nwg = nM * nN; G = G_; c = c_; }
    __host__ __device__ bool next(int i, Unit& u) const {
        const long L = (long)i * G + c; if (L >= nwg) return false;
        int wgid = (int)L; { const int q = nwg / NXCD, r = nwg % NXCD, xcd = wgid % NXCD, off = wgid / NXCD; wgid = (xcd < r ? xcd * (q + 1) : r * (q + 1) + (xcd - r) * q) + off; }
        const int nig = WGM * nN, gid = wgid / nig, fm = gid * WGM, gsz = (nM - fm) < WGM ? (nM - fm) : WGM;
        u.pm = fm + ((wgid % nig) % gsz); u.pn = (wgid % nig) / gsz; return true;
    }
    __device__ __forceinline__ void a_ready(const Unit&) const {}
    __device__ __forceinline__ void done(const Unit&) const {}
};

__device__ __forceinline__ unsigned cvt_pk_bf16(float lo, float hi) { unsigned r; asm volatile("v_cvt_pk_bf16_f32 %0, %1, %2" : "=v"(r) : "v"(lo), "v"(hi)); return r; }
typedef float f32x2 __attribute__((ext_vector_type(2)));
template <int ACT> struct EpiBf16 {
    static constexpr bool PERM = true, AFTER_DRAIN = false;
    bf16_t* O; int ldc;
    __device__ __forceinline__ void operator()(const f32x4 (&acc)[2][2][4][2], const Unit& u, int wr, int wc, int fr, int fq) const {
        const int row0 = u.pm * BM + wr * 64 + fr; const int col0 = u.pn * BM + wc * 32 + 8 * fq;
#pragma unroll
        for (int ai = 0; ai < 2; ++ai)
#pragma unroll
            for (int m = 0; m < 4; ++m) { bf16_t* rowp = O + (size_t)(row0 + ai * HALF + m * 16) * ldc + col0;
#pragma unroll
                for (int bj = 0; bj < 2; ++bj) { f32x4 v0 = acc[ai][bj][m][0], v1 = acc[ai][bj][m][1];
                    if (ACT == 2) { const f32x4 z = (f32x4){0.f, 0.f, 0.f, 0.f}; v0 = __builtin_elementwise_max(v0, z); v1 = __builtin_elementwise_max(v1, z); v0 = v0 * v0; v1 = v1 * v1; }
                    u32x4 w; w.x = cvt_pk_bf16(v0[0], v0[1]); w.y = cvt_pk_bf16(v0[2], v0[3]); w.z = cvt_pk_bf16(v1[0], v1[1]); w.w = cvt_pk_bf16(v1[2], v1[3]);
                    *(u32x4*)(rowp + bj * HALF) = w; } }
    }
};

template <class Epi, class Sched, bool ALIGN_EPI = false, bool SP2 = false>
__device__ __forceinline__ void gemm_phase(PG8_LAS unsigned char* lds, const Gemm g, const Sched& S, const Epi& E) {
    const int tid = threadIdx.x, wid = __builtin_amdgcn_readfirstlane(tid >> 6), lane = tid & 63, wr = wid >> 2, wc = wid & 3, fr = lane & 15, fq = lane >> 4;
    const int K = g.K, nt = K / BK;
    unsigned voffA[2], voffB[2];
#pragma unroll
    for (int i = 0; i < 2; ++i) { int R, C; stage_rc(tid * 16 + i * 8192, R, C); const int Rb = Epi::PERM ? ((R & ~31) + perm32(R & 31)) : R;
        voffA[i] = (unsigned)(R * K + C) * 2u; voffB[i] = (unsigned)(Rb * K + C) * 2u; }
    const size_t kstep = (size_t)(BK * 2);
    const size_t hstep = (size_t)HALF * K * 2;
    const size_t tstep = 2 * hstep;
    const unsigned ldsw = (unsigned)wid * 1024u;
    const int aoff = lds_byte(wr * 64 + fr, fq * 8), boff = lds_byte(wc * 32 + fr, fq * 8);
#define PG8_SA(b, h) (((b) * 2 + (h)) * HTB)
#define PG8_SB(b, h) ((4 + (b) * 2 + (h)) * HTB)
#define PG8_STAGE(bufoff, gbase, voff) do { _Pragma("unroll") for (int _i = 0; _i < 2; ++_i) \
        __builtin_amdgcn_global_load_lds((const unsigned*)((const char*)(gbase) + (voff)[_i]), (PG8_LAS unsigned*)(lds + (bufoff) + ldsw + _i * 8192), 16, 0, 0); } while (0)
#define PG8_LDA(dst, b, h) do { _Pragma("unroll") for (int m = 0; m < 4; ++m) _Pragma("unroll") for (int k = 0; k < 2; ++k) dst[m][k] = *(const PG8_LAS bf16x8*)(lds + PG8_SA(b, h) + aoff + m * 2048 + k * 1024); } while (0)
#define PG8_LDB(dst, b, h) do { _Pragma("unroll") for (int n = 0; n < 2; ++n) _Pragma("unroll") for (int k = 0; k < 2; ++k) dst[n][k] = *(const PG8_LAS bf16x8*)(lds + PG8_SB(b, h) + boff + n * 2048 + k * 1024); } while (0)
#define PG8_MMA(ai, bj, At, Bt) do { __builtin_amdgcn_s_setprio(1); _Pragma("unroll") for (int m = 0; m < 4; ++m) _Pragma("unroll") for (int n = 0; n < 2; ++n) _Pragma("unroll") for (int k = 0; k < 2; ++k) \
        acc[ai][bj][m][n] = __builtin_amdgcn_mfma_f32_16x16x32_bf16(Bt[n][k], At[m][k], acc[ai][bj][m][n], 0, 0, 0); __builtin_amdgcn_s_setprio(0); } while (0)
#define PG8_WAIT_V(n) asm volatile("s_waitcnt vmcnt(" #n ")" ::: "memory")
#define PG8_WAIT_L(n) asm volatile("s_waitcnt lgkmcnt(" #n ")" ::: "memory")
#define PG8_BAR __builtin_amdgcn_s_barrier()
#define PG8_SCHED __builtin_amdgcn_sched_barrier(0)
    Unit cur, nxt; int ui = 0;
    if (!S.next(0, cur)) return;
    f32x4 acc[2][2][4][2];
#pragma unroll
    for (int a = 0; a < 2; ++a)
#pragma unroll
        for (int b = 0; b < 2; ++b)
#pragma unroll
            for (int m = 0; m < 4; ++m)
#pragma unroll
                for (int n = 0; n < 2; ++n) acc[a][b][m][n] = (f32x4){0.f, 0.f, 0.f, 0.f};
    bf16x8 At[4][2], B0[2][2], B1[2][2];
    const char* cA = (const char*)g.A + (size_t)cur.pm * tstep; const char* cB = (const char*)g.Bt + (size_t)cur.pn * tstep;
    S.a_ready(cur);
    if constexpr (SP2) {
        PG8_STAGE(PG8_SB(0, 0), cB, voffB); PG8_STAGE(PG8_SB(0, 1), cB + hstep, voffB); PG8_STAGE(PG8_SA(0, 0), cA, voffA); PG8_STAGE(PG8_SA(0, 1), cA + hstep, voffA);
        if (wr == 1) PG8_BAR;
        PG8_WAIT_V(2); PG8_BAR;
        PG8_STAGE(PG8_SB(1, 0), cB + kstep, voffB); PG8_STAGE(PG8_SA(1, 0), cA + kstep, voffA); PG8_STAGE(PG8_SB(1, 1), cB + hstep + kstep, voffB);
        PG8_WAIT_V(6); PG8_BAR;
    } else {
        PG8_STAGE(PG8_SB(0, 0), cB, voffB); PG8_STAGE(PG8_SA(0, 0), cA, voffA); PG8_STAGE(PG8_SB(0, 1), cB + hstep, voffB); PG8_STAGE(PG8_SA(0, 1), cA + hstep, voffA);
        if (wr == 1) PG8_BAR;
        PG8_WAIT_V(4); PG8_BAR;
        PG8_STAGE(PG8_SB(1, 0), cB + kstep, voffB); PG8_STAGE(PG8_SA(1, 0), cA + kstep, voffA); PG8_STAGE(PG8_SB(1, 1), cB + hstep + kstep, voffB);
        PG8_WAIT_V(6); PG8_BAR;
    }
    for (;;) {
        const bool has_next = S.next(ui + 1, nxt);
        const char* nA = has_next ? (const char*)g.A + (size_t)nxt.pm * tstep : cA; const char* nB = has_next ? (const char*)g.Bt + (size_t)nxt.pn * tstep : cB;
        for (int t = 0; t < nt; t += 2) {
            const bool last = (t == nt - 2);
            const char* a1 = cA + (size_t)(t + 1) * kstep;
            const char* a2 = last ? nA : cA + (size_t)(t + 2) * kstep; const char* b2 = last ? nB : cB + (size_t)(t + 2) * kstep;
            const char* a3 = a2 + kstep; const char* b3 = b2 + kstep;
            if (last && has_next) S.a_ready(nxt);
            if constexpr (SP2) {
            PG8_LDB(B0, 0, 0); PG8_LDB(B1, 0, 1); PG8_SCHED; PG8_LDA(At, 0, 0); PG8_STAGE(PG8_SA(1, 1), a1 + hstep, voffA);
            PG8_WAIT_V(8); PG8_WAIT_L(0); PG8_BAR; PG8_MMA(0, 0, At, B0); PG8_MMA(0, 1, At, B1); PG8_BAR; PG8_SCHED;
            PG8_LDA(At, 0, 1); PG8_STAGE(PG8_SB(0, 0), b2, voffB); PG8_STAGE(PG8_SB(0, 1), b2 + hstep, voffB); PG8_STAGE(PG8_SA(0, 0), a2, voffA);
            PG8_WAIT_V(8); PG8_WAIT_L(0); PG8_BAR; PG8_MMA(1, 0, At, B0); PG8_MMA(1, 1, At, B1); PG8_BAR; PG8_SCHED;
            PG8_LDB(B0, 1, 0); PG8_LDB(B1, 1, 1); PG8_SCHED; PG8_LDA(At, 1, 0); PG8_STAGE(PG8_SA(0, 1), a2 + hstep, voffA);
            PG8_WAIT_V(8); PG8_WAIT_L(0); PG8_BAR; PG8_MMA(0, 0, At, B0); PG8_MMA(0, 1, At, B1); PG8_BAR; PG8_SCHED;
            PG8_LDA(At, 1, 1); PG8_STAGE(PG8_SB(1, 0), b3, voffB); PG8_STAGE(PG8_SB(1, 1), b3 + hstep, voffB); PG8_STAGE(PG8_SA(1, 0), a3, voffA);
            PG8_WAIT_V(8); PG8_WAIT_L(0); PG8_BAR; PG8_MMA(1, 0, At, B0); PG8_MMA(1, 1, At, B1); PG8_BAR; PG8_SCHED;
            } else {
            PG8_LDB(B0, 0, 0); PG8_SCHED; PG8_LDA(At, 0, 0); PG8_STAGE(PG8_SA(1, 1), a1 + hstep, voffA);
            PG8_WAIT_L(8); PG8_BAR; PG8_WAIT_L(0); PG8_MMA(0, 0, At, B0); PG8_BAR; PG8_SCHED;
            PG8_LDB(B1, 0, 1); PG8_STAGE(PG8_SB(0, 0), b2, voffB);
            PG8_BAR; PG8_WAIT_L(0); PG8_MMA(0, 1, At, B1); PG8_BAR;
            PG8_LDA(At, 0, 1); PG8_STAGE(PG8_SA(0, 0), a2, voffA);
            PG8_BAR; PG8_WAIT_L(0); PG8_MMA(1, 0, At, B0); PG8_BAR; PG8_SCHED;
            PG8_STAGE(PG8_SB(0, 1), b2 + hstep, voffB);
            PG8_WAIT_V(6); PG8_BAR; PG8_MMA(1, 1, At, B1); PG8_BAR;
            PG8_LDB(B0, 1, 0); PG8_SCHED; PG8_LDA(At, 1, 0); PG8_STAGE(PG8_SA(0, 1), a2 + hstep, voffA);
            PG8_WAIT_L(8); PG8_BAR; PG8_WAIT_L(0); PG8_MMA(0, 0, At, B0); PG8_BAR; PG8_SCHED;
            PG8_LDB(B1, 1, 1); PG8_STAGE(PG8_SB(1, 0), b3, voffB);
            PG8_BAR; PG8_WAIT_L(0); PG8_MMA(0, 1, At, B1); PG8_BAR;
            PG8_LDA(At, 1, 1); PG8_STAGE(PG8_SA(1, 0), a3, voffA);
            PG8_BAR; PG8_WAIT_L(0); PG8_MMA(1, 0, At, B0); PG8_BAR; PG8_SCHED;
            PG8_STAGE(PG8_SB(1, 1), b3 + hstep, voffB);
            PG8_WAIT_V(6); PG8_BAR; PG8_MMA(1, 1, At, B1); PG8_BAR;
            }
        }
        if constexpr (ALIGN_EPI) { if (wr == 0) PG8_BAR; }
        if constexpr (!Epi::AFTER_DRAIN) { E(acc, cur, wr, wc, fr, fq); S.done(cur); }
        if (!has_next) break;
#pragma unroll
        for (int a = 0; a < 2; ++a)
#pragma unroll
            for (int b = 0; b < 2; ++b)
#pragma unroll
                for (int m = 0; m < 4; ++m)
#pragma unroll
                    for (int n = 0; n < 2; ++n) acc[a][b][m][n] = (f32x4){0.f, 0.f, 0.f, 0.f};
        cur = nxt; cA = nA; cB = nB; ++ui;
        if constexpr (ALIGN_EPI) { if (wr == 1) PG8_BAR; }
    }
    PG8_WAIT_V(0);
    if constexpr (!ALIGN_EPI) { if (wr == 0) PG8_BAR; }
    PG8_BAR;
    if constexpr (Epi::AFTER_DRAIN) { E.fused(acc, cur, wr, wc, fr, fq, lds, wid, lane); S.done(cur); }
#undef PG8_SA
#undef PG8_SB
#undef PG8_STAGE
#undef PG8_LDA
#undef PG8_LDB
#undef PG8_MMA
#undef PG8_WAIT_V
#undef PG8_WAIT_L
#undef PG8_BAR
#undef PG8_SCHED
}
}

#define GAS __attribute__((address_space(1)))
#define LAS __attribute__((address_space(3)))
typedef unsigned short bf16;
typedef unsigned v4u __attribute__((ext_vector_type(4)));
typedef unsigned v2u __attribute__((ext_vector_type(2)));
typedef float f32x4 __attribute__((ext_vector_type(4)));
typedef float f32x2 __attribute__((ext_vector_type(2)));
typedef short bf16x8 __attribute__((ext_vector_type(8)));
typedef _Float16 h2 __attribute__((ext_vector_type(2)));
#define LDS_WAIT() asm volatile("s_waitcnt lgkmcnt(0)" ::: "memory")

constexpr int NWAVES = 8;
constexpr int NTOK = 24576, SEQ = 8192, DM = 2048, DR = 1024, DFF = 8192;
constexpr int ZLD = 5632, ZC_CA = 3072, ZC_CB = 4096, ZC_L = 5120;
constexpr size_t MiB = 1u << 20;
constexpr size_t WS_WIN = 0, WS_WOUT = 22 * MiB, WS_WUP = 30 * MiB, WS_WDN = 62 * MiB, WS_SMALL = 94 * MiB, WS_XL = 95 * MiB, WS_XG = 107 * MiB,
                 WS_BONUS = 115 * MiB, WS_H = 118 * MiB, WS_Z = 214 * MiB, WS_END = 478 * MiB;
constexpr size_t SM_G2T = 0, SM_W2TF = 384 * 1024, SM_W2TB = 512 * 1024, SM_A2TF = 640 * 1024, SM_A2TB = 768 * 1024;
constexpr size_t WS_YF = WS_Z, WS_YB = WS_Z + 96 * MiB, WS_MIX = WS_Z, WS_U = WS_Z, WS_FF = WS_Z + 128 * MiB;
constexpr size_t OUT_RS = 0, OUT_KS = 48 * MiB, OUT_VS = 96 * MiB, OUT_KK = 144 * MiB;
constexpr int LDS_BYTES = 147456, MISC_OFF = 131072 + 320;
constexpr size_t WS_CTL = 117 * MiB, CTL_BYTES = 16384;

struct Args { const float* in[30]; float* out; unsigned char* ws; int ph_lo, ph_hi; };

__device__ __forceinline__ float lo2f(unsigned u) { return __uint_as_float(u << 16); }
__device__ __forceinline__ float hi2f(unsigned u) { return __uint_as_float(u & 0xffff0000u); }
__device__ __forceinline__ unsigned f2bf(float f) { unsigned u = __float_as_uint(f); return (u + 0x7fffu + ((u >> 16) & 1u)) >> 16; }
__device__ __forceinline__ unsigned pk2(float lo, float hi) { unsigned r; asm volatile("v_cvt_pk_bf16_f32 %0, %1, %2" : "=v"(r) : "v"(lo), "v"(hi)); return r; }
__device__ __forceinline__ float fsigmoid(float x) { return __builtin_amdgcn_rcpf(1.f + __builtin_amdgcn_exp2f(-1.44269504f * x)); }
__device__ __forceinline__ float ftanh(float x) { return 1.f - 2.f * __builtin_amdgcn_rcpf(1.f + __builtin_amdgcn_exp2f(2.88539008f * x)); }
__device__ __forceinline__ float wave_sum(float v) {
#pragma unroll
    for (int o = 1; o < 64; o <<= 1) v += __shfl_xor(v, o);
    return v;
}
template <int CTRL> __device__ __forceinline__ float dppf(float x) { return __int_as_float(__builtin_amdgcn_update_dpp(0, __float_as_int(x), CTRL, 0xF, 0xF, true)); }
__device__ __forceinline__ float red8(float x) { x += dppf<0xB1>(x); x += dppf<0x4E>(x); x += dppf<0x141>(x); return x; }
__device__ __forceinline__ const float* xrow(const Args& a, int m) { return m < 16384 ? a.in[0] + (size_t)m * DM : a.in[1] + (size_t)(m - 16384) * DM; }

__device__ __forceinline__ void tr_item(const float* W, int ldw, int k0, int sc0, bf16* WT, int ldt, int dr0, LAS float* scr, int lane) {
#pragma unroll 8
    for (int i = 0; i < 32; ++i) { const int kk = 2 * i + (lane >> 5); scr[kk * 33 + (lane & 31)] = W[(size_t)(k0 + kk) * ldw + sc0 + (lane & 31)]; }
    LDS_WAIT(); asm volatile("" ::: "memory");
    const int c = lane & 7;
#pragma unroll
    for (int j = 0; j < 4; ++j) { const int n = (lane >> 3) + 8 * j; const LAS float* s = scr + (8 * c) * 33 + n;
        v4u o; o.x = pk2(s[0 * 33], s[1 * 33]); o.y = pk2(s[2 * 33], s[3 * 33]); o.z = pk2(s[4 * 33], s[5 * 33]); o.w = pk2(s[6 * 33], s[7 * 33]);
        *(v4u*)(WT + (size_t)(dr0 + n) * ldt + k0 + 8 * c) = o; }
    LDS_WAIT(); asm volatile("" ::: "memory");
}
__device__ __forceinline__ void rms_row_bf16(const float* xr_, const float* g, bf16* orow, int lane) {
    const f32x4* xr = (const f32x4*)xr_ + lane; const f32x4* gr = (const f32x4*)g + lane;
    f32x4 v[8]; float s = 0.f;
#pragma unroll
    for (int j = 0; j < 8; ++j) { v[j] = xr[64 * j]; s += (v[j].x * v[j].x + v[j].y * v[j].y) + (v[j].z * v[j].z + v[j].w * v[j].w); }
    const float rstd = 1.f / sqrtf(wave_sum(s) * (1.f / DM) + 1e-6f);
    v2u* o8 = (v2u*)orow + lane;
#pragma unroll
    for (int j = 0; j < 8; ++j) { const f32x4 gg = gr[64 * j]; v2u o; o.x = pk2(v[j].x * rstd * gg.x, v[j].y * rstd * gg.y); o.y = pk2(v[j].z * rstd * gg.z, v[j].w * rstd * gg.w); o8[64 * j] = o; }
}
__device__ __forceinline__ void p0_prologue(const Args& a, LAS unsigned char* lds, int gw, int NGW, int wave, int lane) {
    unsigned char* ws = a.ws;
    LAS float* scr = (LAS float*)(lds + wave * 16384);
    bf16* WIN = (bf16*)(ws + WS_WIN); bf16* WOUT = (bf16*)(ws + WS_WOUT); bf16* WUP = (bf16*)(ws + WS_WUP); bf16* WDN = (bf16*)(ws + WS_WDN);
    constexpr int I_IN = 32 * 173, I_OUT = 32 * 64, I_UP = 32 * 256, I_DN = 128 * 64, I_S = 32;
    constexpr int NITEMS = I_IN + I_OUT + I_UP + I_DN + 4 * I_S;
    for (int it = gw; it < NITEMS; it += NGW) {
        int r = it;
        if (r < I_IN) { const int kb = r / 173, nb = r % 173, sc0 = nb * 32; const int dr0 = sc0 < 3072 ? sc0 : (sc0 < 3488 ? ZC_L + (sc0 - 3072) : ZC_CA + (sc0 - 3488));
            tr_item(a.in[3], 5536, kb * 64, sc0, WIN, DM, dr0, scr, lane); continue; } r -= I_IN;
        if (r < I_OUT) { tr_item(a.in[24], DM, (r / 64) * 64, (r % 64) * 32, WOUT, DM, (r % 64) * 32, scr, lane); continue; } r -= I_OUT;
        if (r < I_UP) { tr_item(a.in[27], DFF, (r / 256) * 64, (r % 256) * 32, WUP, DM, (r % 256) * 32, scr, lane); continue; } r -= I_UP;
        if (r < I_DN) { tr_item(a.in[28], DM, (r / 64) * 64, (r % 64) * 32, WDN, DFF, (r % 64) * 32, scr, lane); continue; } r -= I_DN;
        { const int which = r / I_S, nb = r % I_S; const float* src = which == 0 ? a.in[7] : which == 1 ? a.in[9] : which == 2 ? a.in[11] : a.in[13];
          bf16* dst = (bf16*)(ws + WS_SMALL + (which == 0 ? SM_W2TF : which == 1 ? SM_W2TB : which == 2 ? SM_A2TF : SM_A2TB));
          tr_item(src, DR, 0, nb * 32, dst, 64, nb * 32, scr, lane); }
    }
    { const int gt = gw * 64 + lane, NGT = NGW * 64;
      v4u zz = {0u, 0u, 0u, 0u}; v4u* zp = (v4u*)(WIN + (size_t)5536 * DM);
      for (int i = gt; i < 96 * DM / 8; i += NGT) zp[i] = zz;
      bf16* G2T = (bf16*)(ws + WS_SMALL + SM_G2T); const float* g2 = a.in[14];
      for (int i = gt; i < 160 * 1024; i += NGT) { const int k = i >> 10, n = i & 1023; G2T[n * 160 + k] = (bf16)f2bf(g2[i]); } }
    bf16* H = (bf16*)(ws + WS_H);
    for (int m = gw; m < NTOK; m += NGW) rms_row_bf16(xrow(a, m), a.in[2], H + (size_t)m * DM, lane);
}

__device__ __forceinline__ void shift_phase(const Args& a, int gw, int NGW, int lane) {
    unsigned char* ws = a.ws;
    const bf16* Z = (const bf16*)(ws + WS_Z);
    bf16* RS = (bf16*)((unsigned char*)a.out + OUT_RS); bf16* KS = (bf16*)((unsigned char*)a.out + OUT_KS);
    bf16* VS = (bf16*)((unsigned char*)a.out + OUT_VS); bf16* KK = (bf16*)((unsigned char*)a.out + OUT_KK);
    bf16* XL = (bf16*)(ws + WS_XL); bf16* XG = (bf16*)(ws + WS_XG); float* BONUS = (float*)(ws + WS_BONUS);
    const float* mup = a.in[4]; const float* mun = a.in[5]; const float* k_k = a.in[15]; const float* r_k = a.in[17];
    const int hp2 = lane >> 5, n2 = (lane & 31) * 2;
    for (int m = gw; m < NTOK; m += NGW) {
        const int t = m & (SEQ - 1); const bool hp = t > 0, hn = t < SEQ - 1;
        const bf16* z0 = Z + (size_t)m * ZLD; const bf16* zp = z0 - ZLD; const bf16* zn = z0 + ZLD;
#pragma unroll 2
        for (int hh = 0; hh < 8; ++hh) {
            const int c = (hh * 2 + hp2) * 64 + n2;
            float s[3][2];
#pragma unroll
            for (int ar = 0; ar < 3; ++ar) { const int col = ar * 1024 + c;
                const unsigned zc = *(const unsigned*)(z0 + col); const unsigned zpv = hp ? *(const unsigned*)(zp + col) : 0u; const unsigned znv = hn ? *(const unsigned*)(zn + col) : 0u;
                const f32x2 mp = *(const f32x2*)(mup + col), mn = *(const f32x2*)(mun + col);
                const float x0 = lo2f(zc), x1 = hi2f(zc);
                s[ar][0] = x0 + mp.x * (lo2f(zpv) - x0) + mn.x * (lo2f(znv) - x0);
                s[ar][1] = x1 + mp.y * (hi2f(zpv) - x1) + mn.y * (hi2f(znv) - x1); }
            const f32x2 kkw = *(const f32x2*)(k_k + c), rkw = *(const f32x2*)(r_k + c);
            const float kr0 = s[1][0] * kkw.x, kr1 = s[1][1] * kkw.y;
            float ss = kr0 * kr0 + kr1 * kr1, bs = s[0][0] * s[1][0] * rkw.x + s[0][1] * s[1][1] * rkw.y;
#pragma unroll
            for (int o = 1; o < 32; o <<= 1) { ss += __shfl_xor(ss, o); bs += __shfl_xor(bs, o); }
            const float inv = 1.f / fmaxf(sqrtf(ss), 1e-12f);
            const size_t o = (size_t)m * DR + c;
            *(unsigned*)(RS + o) = pk2(s[0][0], s[0][1]); *(unsigned*)(KS + o) = pk2(s[1][0], s[1][1]);
            *(unsigned*)(VS + o) = pk2(s[2][0], s[2][1]); *(unsigned*)(KK + o) = pk2(kr0 * inv, kr1 * inv);
            if ((lane & 31) == 0) BONUS[m * 16 + hh * 2 + hp2] = bs;
        }
#pragma unroll
        for (int p = 0; p < 7; ++p) { const int j = p * 64 + lane;
            if (j < 416) { const int col = ZC_L + j, og = 3072 + j;
                const float x0 = lo2f(z0[col]); const float xp = hp ? lo2f(zp[col]) : 0.f; const float xn = hn ? lo2f(zn[col]) : 0.f;
                const float sv = x0 + mup[og] * (xp - x0) + mun[og] * (xn - x0);
                if (j < 128) XL[(size_t)m * 256 + j] = (bf16)f2bf(ftanh(sv));
                else if (j < 256) XL[(size_t)m * 256 + j] = (bf16)f2bf(sv);
                else XG[(size_t)m * 160 + (j - 256)] = (bf16)f2bf(fsigmoid(sv)); } }
    }
}

#define TR_STAGE(D_, N_) { const bool up_ = (lane & (D_)) != 0; _Pragma("unroll") for (int i_ = 0; i_ < (N_) / 2; ++i_) { \
    const float keep_ = up_ ? vals[i_ + (N_) / 2] : vals[i_]; const float send_ = up_ ? vals[i_] : vals[i_ + (N_) / 2]; vals[i_] = keep_ + __shfl_xor(send_, (D_)); } }
__device__ __forceinline__ void conv_phase(const Args& a, unsigned char* lds, int tid, int wave, int lane) {
    unsigned char* ws = a.ws;
    const bf16* Z = (const bf16*)(ws + WS_Z); bf16* MIXIN = (bf16*)(ws + WS_H);
    h2* utile = (h2*)lds;
    float* part = (float*)(lds + 126976);
    f32x2* stats = (f32x2*)(lds + 126976 + 2048);
    const float* dw_w = a.in[20]; const float* dw_b = a.in[21]; const float* cln_w = a.in[22]; const float* cln_b = a.in[23];
    const int cp = tid;
    for (int unit = blockIdx.x; unit < NTOK / 32; unit += gridDim.x) {
        const int m0 = unit * 32, t0 = m0 & (SEQ - 1);
        for (int idx = tid; idx < 62 * 512; idx += 512) { const int row = idx >> 9, c2 = idx & 511; const int t = t0 - 15 + row;
            h2 u = {(_Float16)0.f, (_Float16)0.f};
            if (t >= 0 && t < SEQ) { const bf16* zr = Z + (size_t)(m0 - 15 + row) * ZLD; const unsigned za = *(const unsigned*)(zr + ZC_CA + 2 * c2), zb = *(const unsigned*)(zr + ZC_CB + 2 * c2);
                u.x = (_Float16)(lo2f(za) * fsigmoid(lo2f(zb))); u.y = (_Float16)(hi2f(za) * fsigmoid(hi2f(zb))); }
            utile[idx] = u; }
        __syncthreads();
        f32x2 w[31];
#pragma unroll
        for (int j = 0; j < 31; ++j) w[j] = *(const f32x2*)(dw_w + j * 1024 + 2 * cp);
        const f32x2 bias = *(const f32x2*)(dw_b + 2 * cp);
        f32x2 out[32];
#pragma unroll
        for (int tb = 0; tb < 4; ++tb) {
            f32x2 acc[8];
#pragma unroll
            for (int o = 0; o < 8; ++o) acc[o] = bias;
#pragma unroll
            for (int jj = 0; jj < 38; ++jj) { const h2 uh = utile[(tb * 8 + jj) * 512 + cp]; const f32x2 u = {(float)uh.x, (float)uh.y};
#pragma unroll
                for (int o = 0; o < 8; ++o) { const int j = jj - o; if (j >= 0 && j < 31) acc[o] = u * w[j] + acc[o]; } }
#pragma unroll
            for (int o = 0; o < 8; ++o) out[tb * 8 + o] = acc[o];
            asm volatile("" ::: "memory");
        }
        float vals[64];
#pragma unroll
        for (int t = 0; t < 32; ++t) { vals[2 * t] = out[t].x + out[t].y; vals[2 * t + 1] = out[t].x * out[t].x + out[t].y * out[t].y; }
        TR_STAGE(32, 64) TR_STAGE(16, 32) TR_STAGE(8, 16) TR_STAGE(4, 8) TR_STAGE(2, 4) TR_STAGE(1, 2)
        part[wave * 64 + lane] = vals[0];
        __syncthreads();
        if (tid < 32) { float s = 0.f, q = 0.f;
#pragma unroll
            for (int wv = 0; wv < 8; ++wv) { s += part[wv * 64 + 2 * tid]; q += part[wv * 64 + 2 * tid + 1]; }
            const float mean = s * (1.f / 1024.f); const float var = q * (1.f / 1024.f) - mean * mean;
            stats[tid] = (f32x2){mean, 1.f / sqrtf(var + 1e-5f)}; }
        __syncthreads();
        const f32x2 lw = *(const f32x2*)(cln_w + 2 * cp), lb = *(const f32x2*)(cln_b + 2 * cp);
#pragma unroll
        for (int t = 0; t < 32; ++t) { const f32x2 st = stats[t];
            const float y0 = (out[t].x - st.x) * st.y * lw.x + lb.x, y1 = (out[t].y - st.x) * st.y * lw.y + lb.y;
            *(unsigned*)(MIXIN + (size_t)(m0 + t) * DM + DR + 2 * cp) = pk2(y0 * fsigmoid(y0), y1 * fsigmoid(y1)); }
        __syncthreads();
    }
}

constexpr int SC_LD = 68, SC_ARR = 32 * SC_LD, SC_ARR4 = SC_ARR / 4, SC_BUF = 6 * SC_ARR * 4;
struct ScanOps { f32x4 q0, q1, w0, w1, a0, a1, m0, m1, r0, r1; float vv; };
__device__ __forceinline__ void ld_ops(ScanOps& o, const float* cb, int i, int ks, int rr) {
    const f32x4* p = (const f32x4*)(cb + i * SC_LD + ks * 8);
    o.q0 = p[0]; o.q1 = p[1]; o.w0 = p[SC_ARR4]; o.w1 = p[SC_ARR4 + 1]; o.a0 = p[2 * SC_ARR4]; o.a1 = p[2 * SC_ARR4 + 1];
    o.m0 = p[3 * SC_ARR4]; o.m1 = p[3 * SC_ARR4 + 1]; o.r0 = p[4 * SC_ARR4]; o.r1 = p[4 * SC_ARR4 + 1]; o.vv = cb[5 * SC_ARR + i * SC_LD + rr];
}
__device__ __forceinline__ void scan_phase(const Args& a, unsigned char* lds, int wave, int lane) {
    if (blockIdx.x >= 192) return;
    unsigned char* ws = a.ws;
    const int scan = blockIdx.x >> 1, half = blockIdx.x & 1, dir = scan & 1, sh = scan >> 1, seq = sh >> 4, h = sh & 15;
    const size_t row0 = (size_t)seq * SEQ;
    const bf16* RS = (const bf16*)((unsigned char*)a.out + OUT_RS); const bf16* KS = (const bf16*)((unsigned char*)a.out + OUT_KS);
    const bf16* VS = (const bf16*)((unsigned char*)a.out + OUT_VS); const bf16* KK = (const bf16*)((unsigned char*)a.out + OUT_KK);
    const bf16* XL = (const bf16*)(ws + WS_XL);
    float* Y = (float*)(ws + (dir ? WS_YB : WS_YF));
    constexpr int NCH = SEQ / 32;
    const int ks = lane & 7, rr = half * 32 + (wave & 3) * 8 + (lane >> 3);
    f32x2 S0 = {0.f, 0.f}, S1 = S0, S2 = S0, S3 = S0;
    float* ybase = Y + row0 * DR + h * 64 + rr;
    const int pw = wave & 3, fr = lane & 15, fq = lane >> 4, cl = pw * 16 + fq * 4, gcol = h * 64 + cl;
    bf16x8 Bw0, Bw1, Ba0, Ba1; f32x4 w0v, a0v, kav;
    {
        const bf16* W2T = (const bf16*)(ws + WS_SMALL + (dir ? SM_W2TB : SM_W2TF)); const bf16* A2T = (const bf16*)(ws + WS_SMALL + (dir ? SM_A2TB : SM_A2TF));
        const size_t bo = (size_t)(h * 64 + pw * 16 + fr) * 64 + fq * 8;
        Bw0 = *(const bf16x8*)(W2T + bo); Bw1 = *(const bf16x8*)(W2T + bo + 32); Ba0 = *(const bf16x8*)(A2T + bo); Ba1 = *(const bf16x8*)(A2T + bo + 32);
        w0v = *(const f32x4*)((dir ? a.in[8] : a.in[6]) + gcol); a0v = *(const f32x4*)((dir ? a.in[12] : a.in[10]) + gcol); kav = *(const f32x4*)(a.in[16] + gcol);
    }
    for (int c = 0; c <= NCH; ++c) {
        if (wave >= 4) {
            if (c < NCH) {
                float* cb = (float*)(lds + (c & 1) * SC_BUF);
#pragma unroll
                for (int mt = 0; mt < 2; ++mt) {
                    const int i = mt * 16 + fr, step = c * 32 + i, t = dir ? (SEQ - 1 - step) : step; const size_t m = row0 + t;
                    const bf16* xl = XL + m * 256 + dir * 64 + fq * 8;
                    const bf16x8 At0 = *(const bf16x8*)(xl), At1 = *(const bf16x8*)(xl + 32), Aa0 = *(const bf16x8*)(xl + 128), Aa1 = *(const bf16x8*)(xl + 160);
                    const size_t go = m * DR + gcol;
                    const v2u r4 = *(const v2u*)(RS + go), k4 = *(const v2u*)(KS + go), v4 = *(const v2u*)(VS + go), q4 = *(const v2u*)(KK + go);
                    f32x4 aw = {0.f, 0.f, 0.f, 0.f}, aa = aw;
                    aw = __builtin_amdgcn_mfma_f32_16x16x32_bf16(Bw0, At0, aw, 0, 0, 0); aw = __builtin_amdgcn_mfma_f32_16x16x32_bf16(Bw1, At1, aw, 0, 0, 0);
                    aa = __builtin_amdgcn_mfma_f32_16x16x32_bf16(Ba0, Aa0, aa, 0, 0, 0); aa = __builtin_amdgcn_mfma_f32_16x16x32_bf16(Ba1, Aa1, aa, 0, 0, 0);
                    const f32x4 rv = {lo2f(r4.x), hi2f(r4.x), lo2f(r4.y), hi2f(r4.y)}, kv = {lo2f(k4.x), hi2f(k4.x), lo2f(k4.y), hi2f(k4.y)};
                    const f32x4 vv = {lo2f(v4.x), hi2f(v4.x), lo2f(v4.y), hi2f(v4.y)}, qv = {lo2f(q4.x), hi2f(q4.x), lo2f(q4.y), hi2f(q4.y)};
                    f32x4 wv, av;
#pragma unroll
                    for (int j = 0; j < 4; ++j) { const float sg = fsigmoid(w0v[j] + aw[j]); wv[j] = __builtin_amdgcn_exp2f(-0.87500596f * sg); av[j] = fsigmoid(a0v[j] + aa[j]); }
                    const f32x4 kav4 = qv * av, kmv = kv * (1.f + (av - 1.f) * kav);
                    f32x4* dst = (f32x4*)(cb + i * SC_LD + cl);
                    dst[0] = qv; dst[SC_ARR4] = wv; dst[2 * SC_ARR4] = kav4; dst[3 * SC_ARR4] = kmv; dst[4 * SC_ARR4] = rv; dst[5 * SC_ARR4] = vv;
                }
            }
        } else if (c > 0) {
            const float* cb = (const float*)(lds + ((c - 1) & 1) * SC_BUF);
            const int cbase = (c - 1) * 32;
            ScanOps o[2]; ld_ops(o[0], cb, 0, ks, rr);
#pragma unroll
            for (int g = 0; g < 4; ++g) {
                float ysel = 0.f;
#pragma unroll
                for (int j = 0; j < 8; ++j) {
                    const int i = g * 8 + j;
                    if (i + 1 < 32) ld_ops(o[(i + 1) & 1], cb, i + 1, ks, rr);
                    const ScanOps& x = o[i & 1];
                    f32x2 acc = S0 * x.q0.xy, acc2 = S1 * x.q0.zw; acc = S2 * x.q1.xy + acc; acc2 = S3 * x.q1.zw + acc2; acc = acc + acc2;
                    const float sa = red8(acc.x + acc.y);
                    const f32x2 sav = {sa, sa}, vv2 = {x.vv, x.vv};
                    S0 = S0 * x.w0.xy + (vv2 * x.m0.xy - sav * x.a0.xy); S1 = S1 * x.w0.zw + (vv2 * x.m0.zw - sav * x.a0.zw);
                    S2 = S2 * x.w1.xy + (vv2 * x.m1.xy - sav * x.a1.xy); S3 = S3 * x.w1.zw + (vv2 * x.m1.zw - sav * x.a1.zw);
                    f32x2 yq = S0 * x.r0.xy, yq2 = S1 * x.r0.zw; yq = S2 * x.r1.xy + yq; yq2 = S3 * x.r1.zw + yq2; yq = yq + yq2;
                    const float y = red8(yq.x + yq.y);
                    ysel = (ks == j) ? y : ysel;
                }
                const int step = cbase + g * 8 + ks, t = dir ? (SEQ - 1 - step) : step;
                ybase[(size_t)t * DR] = ysel;
            }
        }
        __syncthreads();
    }
}

__device__ __forceinline__ void post_phase(const Args& a, int wave, int lane) {
    unsigned char* ws = a.ws;
    const bf16* XG = (const bf16*)(ws + WS_XG); const bf16* G2T = (const bf16*)(ws + WS_SMALL + SM_G2T);
    const float* YF = (const float*)(ws + WS_YF); const float* YB = (const float*)(ws + WS_YB); const float* BONUS = (const float*)(ws + WS_BONUS);
    const bf16* VS = (const bf16*)((unsigned char*)a.out + OUT_VS); bf16* MIXIN = (bf16*)(ws + WS_H);
    const float* gn_w = a.in[18]; const float* gn_b = a.in[19];
    const int fr = lane & 15, fq = lane >> 4, n0 = wave * 128;
    for (int unit = blockIdx.x; unit < NTOK / 32; unit += gridDim.x) {
        const int m0 = unit * 32;
        f32x4 acc[2][8];
#pragma unroll
        for (int mt = 0; mt < 2; ++mt)
#pragma unroll
            for (int nt = 0; nt < 8; ++nt) acc[mt][nt] = (f32x4){0.f, 0.f, 0.f, 0.f};
#pragma unroll
        for (int kq = 0; kq < 5; ++kq) {
            bf16x8 A[2];
#pragma unroll
            for (int mt = 0; mt < 2; ++mt) A[mt] = *(const bf16x8*)(XG + (size_t)(m0 + mt * 16 + fr) * 160 + kq * 32 + fq * 8);
#pragma unroll
            for (int nt = 0; nt < 8; ++nt) { const bf16x8 B = *(const bf16x8*)(G2T + (size_t)(n0 + nt * 16 + fr) * 160 + kq * 32 + fq * 8);
#pragma unroll
                for (int mt = 0; mt < 2; ++mt) acc[mt][nt] = __builtin_amdgcn_mfma_f32_16x16x32_bf16(B, A[mt], acc[mt][nt], 0, 0, 0); }
        }
#pragma unroll
        for (int mt = 0; mt < 2; ++mt) { const size_t m = (size_t)(m0 + mt * 16 + fr);
#pragma unroll
            for (int hh = 0; hh < 2; ++hh) { const int hd = wave * 2 + hh;
                f32x4 y[4]; float s = 0.f;
#pragma unroll
                for (int q = 0; q < 4; ++q) { const size_t o = m * DR + n0 + (hh * 4 + q) * 16 + fq * 4; y[q] = *(const f32x4*)(YF + o) + *(const f32x4*)(YB + o); s += (y[q].x + y[q].y) + (y[q].z + y[q].w); }
                s += __shfl_xor(s, 16); s += __shfl_xor(s, 32);
                const float mean = s * (1.f / 64.f); float ss = 0.f;
#pragma unroll
                for (int q = 0; q < 4; ++q) { y[q] = y[q] - mean; ss += (y[q].x * y[q].x + y[q].y * y[q].y) + (y[q].z * y[q].z + y[q].w * y[q].w); }
                ss += __shfl_xor(ss, 16); ss += __shfl_xor(ss, 32);
                const float rstd = 1.f / sqrtf(ss * (1.f / 64.f) + 64e-5f); const float bs = BONUS[m * 16 + hd];
#pragma unroll
                for (int q = 0; q < 4; ++q) { const int c = n0 + (hh * 4 + q) * 16 + fq * 4; const f32x4 gw4 = *(const f32x4*)(gn_w + c), gb4 = *(const f32x4*)(gn_b + c);
                    const v2u v4 = *(const v2u*)(VS + m * DR + c); const f32x4 vv = {lo2f(v4.x), hi2f(v4.x), lo2f(v4.y), hi2f(v4.y)};
                    const f32x4 o = (y[q] * rstd * gw4 + gb4 + bs * vv) * acc[mt][hh * 4 + q];
                    v2u ov; ov.x = pk2(o.x, o.y); ov.y = pk2(o.z, o.w); *(v2u*)(MIXIN + m * DM + c) = ov; }
            }
        }
    }
}

__device__ __forceinline__ void mid_rows(const Args& a, int gw, int NGW, int lane) {
    unsigned char* ws = a.ws; const bf16* MIX = (const bf16*)(ws + WS_MIX); bf16* H = (bf16*)(ws + WS_H);
    const f32x4* g1 = (const f32x4*)a.in[25] + lane; const f32x4* g2 = (const f32x4*)a.in[26] + lane;
    for (int m = gw; m < NTOK; m += NGW) {
        const v2u* mr = (const v2u*)(MIX + (size_t)m * DM) + lane; const f32x4* xr = (const f32x4*)xrow(a, m) + lane;
        f32x4 v[8]; float s = 0.f;
#pragma unroll
        for (int j = 0; j < 8; ++j) { const v2u u = mr[64 * j]; v[j] = (f32x4){lo2f(u.x), hi2f(u.x), lo2f(u.y), hi2f(u.y)}; s += (v[j].x * v[j].x + v[j].y * v[j].y) + (v[j].z * v[j].z + v[j].w * v[j].w); }
        const float rstd = 1.f / sqrtf(wave_sum(s) * (1.f / DM) + 1e-6f); float s1 = 0.f;
        f32x4* orow = (f32x4*)(a.out + (size_t)m * DM) + lane;
#pragma unroll
        for (int j = 0; j < 8; ++j) { v[j] = xr[64 * j] + v[j] * rstd * g1[64 * j]; orow[64 * j] = v[j]; s1 += (v[j].x * v[j].x + v[j].y * v[j].y) + (v[j].z * v[j].z + v[j].w * v[j].w); }
        const float rstd1 = 1.f / sqrtf(wave_sum(s1) * (1.f / DM) + 1e-6f);
        v2u* hr = (v2u*)(H + (size_t)m * DM) + lane;
#pragma unroll
        for (int j = 0; j < 8; ++j) { const f32x4 gg = g2[64 * j]; v2u o; o.x = pk2(v[j].x * rstd1 * gg.x, v[j].y * rstd1 * gg.y); o.y = pk2(v[j].z * rstd1 * gg.z, v[j].w * rstd1 * gg.w); hr[64 * j] = o; }
    }
}
__device__ __forceinline__ void final_rows(const Args& a, int gw, int NGW, int lane) {
    unsigned char* ws = a.ws; const bf16* FF = (const bf16*)(ws + WS_FF);
    const f32x4* g1 = (const f32x4*)a.in[29] + lane;
    for (int m = gw; m < NTOK; m += NGW) {
        const v2u* mr = (const v2u*)(FF + (size_t)m * DM) + lane;
        f32x4 v[8]; float s = 0.f;
#pragma unroll
        for (int j = 0; j < 8; ++j) { const v2u u = mr[64 * j]; v[j] = (f32x4){lo2f(u.x), hi2f(u.x), lo2f(u.y), hi2f(u.y)}; s += (v[j].x * v[j].x + v[j].y * v[j].y) + (v[j].z * v[j].z + v[j].w * v[j].w); }
        const float rstd = 1.f / sqrtf(wave_sum(s) * (1.f / DM) + 1e-6f);
        f32x4* orow = (f32x4*)(a.out + (size_t)m * DM) + lane;
#pragma unroll
        for (int j = 0; j < 8; ++j) orow[64 * j] = orow[64 * j] + v[j] * rstd * g1[64 * j];
    }
}

typedef GAS unsigned gu32;
#define XB_TMO      128
#define XB_XCNT(j)  (256  + 64 * (j))
#define XB_XSUB(j)  (1280 + 64 * (j))
#define XB_XGEN(j)  (2304 + 64 * (j))
#define XB_TOP      3328
#define XB_TOPGEN   3392
#define XCD_BAR_WORDS 3456
#define XB_SPIN_CAP (1u << 18)

__device__ __forceinline__ unsigned xb_ld(unsigned* p)              { return __hip_atomic_load(p, __ATOMIC_RELAXED, __HIP_MEMORY_SCOPE_AGENT); }
__device__ __forceinline__ unsigned xb_add(unsigned* p, unsigned v) { return __hip_atomic_fetch_add(p, v, __ATOMIC_RELAXED, __HIP_MEMORY_SCOPE_AGENT); }
__device__ __forceinline__ unsigned xb_xcc_id() { return (unsigned)__builtin_amdgcn_s_getreg((3 << 11) | 20) & 0xFu; }
#define XB_SPIN(cond, bar) do { unsigned _sp = 0; while (cond) { __builtin_amdgcn_s_sleep(1); \
    if ((++_sp & 255u) == 0u) { if (xb_ld(&(bar)[XB_TMO])) break; if (_sp > XB_SPIN_CAP) { atomicAdd(&(bar)[XB_TMO], 1u); break; } } } } while (0)

struct XcdBarrier {
    unsigned* bar; unsigned x;
    volatile LAS unsigned* st;
};

__device__ __forceinline__ XcdBarrier xcd_barrier_post(unsigned* bar, volatile LAS unsigned* st) {
    XcdBarrier b; b.bar = bar; b.x = xb_xcc_id(); b.st = st;
    if (threadIdx.x == 0) (void)xb_add(&bar[XB_XCNT(b.x)], 1u);
    return b;
}
__device__ __forceinline__ void xcd_barrier_complete(unsigned* bar, unsigned x, unsigned& nloc, unsigned& nx) {
    const unsigned G = gridDim.x * gridDim.y * gridDim.z;
    unsigned sum, cnt, mine, sp = 0u;
    for (;;) {
        sum = 0u; cnt = 0u; mine = 0u;
#pragma unroll
        for (unsigned j = 0; j < 16; ++j) { const unsigned c = xb_ld(&bar[XB_XCNT(j)]); sum += c; cnt += (c > 0u) ? 1u : 0u; mine = (j == x) ? c : mine; }
        if (sum == G) break;
        __builtin_amdgcn_s_sleep(1);
        if ((++sp & 255u) == 0u) { if (xb_ld(&bar[XB_TMO])) break; if (sp > XB_SPIN_CAP) { atomicAdd(&bar[XB_TMO], 1u); break; } }
    }
    nloc = mine > 0u ? mine : 1u; nx = cnt > 0u ? cnt : 1u;
}

__device__ __forceinline__ void xcd_barrier(const XcdBarrier& b) {
    asm volatile("s_waitcnt vmcnt(0)" ::: "memory");
    __syncthreads();
    if (threadIdx.x == 0) {
        unsigned* bar = b.bar;
        __builtin_amdgcn_s_waitcnt(0);
        unsigned nloc = b.st[0], nx = b.st[1];
        if (nloc == 0u) { xcd_barrier_complete(bar, b.x, nloc, nx); b.st[0] = nloc; b.st[1] = nx; }
        const unsigned old = xb_add(&bar[XB_XSUB(b.x)], 1u);
        const unsigned gen = old / nloc;
        if (old + 1u == (gen + 1u) * nloc) {
            __builtin_amdgcn_fence(__ATOMIC_RELEASE, "agent");
            asm volatile("s_waitcnt vmcnt(0)" ::: "memory");
            const unsigned og = xb_add(&bar[XB_TOP], 1u);
            const unsigned tg = og / nx;
            if (og + 1u == (tg + 1u) * nx) xb_add(&bar[XB_TOPGEN], 1u);
            else XB_SPIN(xb_ld(&bar[XB_TOPGEN]) == tg, bar);
            __builtin_amdgcn_fence(__ATOMIC_ACQUIRE, "agent");
            xb_add(&bar[XB_XGEN(b.x)], 1u);
            asm volatile("s_waitcnt vmcnt(0)" ::: "memory");
        } else {
            XB_SPIN(xb_ld(&bar[XB_XGEN(b.x)]) == gen, bar);
            __builtin_amdgcn_fence(__ATOMIC_ACQUIRE, "agent");
            asm volatile("s_waitcnt vmcnt(0)" ::: "memory");
        }
    }
    __syncthreads();
}

__global__ void __launch_bounds__(NWAVES * 64, 2) hymba_fwd(Args args) {
    extern __shared__ __attribute__((aligned(16))) unsigned char lds[];
    cg::grid_group grid = cg::this_grid();
    LAS unsigned char* ldsl = (LAS unsigned char*)lds;
    const int tid = threadIdx.x, lane = tid & 63, wave = __builtin_amdgcn_readfirstlane(tid >> 6);
    const int G = gridDim.x, gw = blockIdx.x * NWAVES + wave, NGW = G * NWAVES;
    unsigned char* ws = args.ws;
    const int lo = args.ph_lo, hi = args.ph_hi;
    if (tid < 32) ((volatile LAS unsigned*)(ldsl + MISC_OFF))[tid] = 0u;
    __syncthreads();
    const XcdBarrier xbar = xcd_barrier_post((unsigned*)(ws + WS_CTL), (volatile LAS unsigned*)(ldsl + MISC_OFF) + 8);
#define IN(k) (lo <= (k) && (k) < hi)
#define SEAM(k) do { if (IN(k) && IN((k) + 1)) { if ((k) == 0) grid.sync(); else xcd_barrier(xbar); } } while (0)
    typedef pg8::EpiBf16<0> E0; typedef pg8::EpiBf16<2> E2;
    if (IN(0)) { p0_prologue(args, ldsl, gw, NGW, wave, lane); }
    SEAM(0);
#ifndef NO_G1
    if (IN(1)) { pg8::Gemm g{(const bf16*)(ws + WS_H), (const bf16*)(ws + WS_WIN), NTOK, ZLD, DM}; pg8::StaticOrder S; S.init(NTOK, ZLD, G, (int)blockIdx.x);
        E0 E{(bf16*)(ws + WS_Z), ZLD}; pg8::gemm_phase<E0, pg8::StaticOrder, true, true>(ldsl, g, S, E); }
#endif
    SEAM(1);
    if (IN(2)) {
#ifndef NO_SHIFT
 shift_phase(args, gw, NGW, lane);
#endif
#ifndef NO_CONV
 conv_phase(args, lds, tid, wave, lane);
#endif
 }
    SEAM(2);
    if (IN(3)) {
#ifndef NO_SCAN
 scan_phase(args, lds, wave, lane);
#ifdef PROBE_SCAN2
 __syncthreads(); scan_phase(args, lds, wave, lane);
#endif
#endif
 }
    SEAM(3);
    if (IN(4)) {
#ifndef NO_POST
 post_phase(args, wave, lane);
#endif
 }
    SEAM(4);
#ifndef NO_G5
    if (IN(5)) { pg8::Gemm g{(const bf16*)(ws + WS_H), (const bf16*)(ws + WS_WOUT), NTOK, DM, DM}; pg8::StaticOrder S; S.init(NTOK, DM, G, (int)blockIdx.x);
        E0 E{(bf16*)(ws + WS_MIX), DM}; pg8::gemm_phase<E0, pg8::StaticOrder, true, true>(ldsl, g, S, E); }
#endif
    SEAM(5);
    if (IN(6)) { mid_rows(args, gw, NGW, lane); }
    SEAM(6);
#ifndef NO_G7
    if (IN(7)) {
#pragma unroll
        for (int s = 0; s < 3; ++s) {
            { pg8::Gemm g{(const bf16*)(ws + WS_H) + (size_t)s * SEQ * DM, (const bf16*)(ws + WS_WUP), SEQ, DFF, DM}; pg8::StaticOrder S; S.init(SEQ, DFF, G, (int)blockIdx.x);
              E2 E{(bf16*)(ws + WS_U), DFF}; pg8::gemm_phase<E2, pg8::StaticOrder, true, true>(ldsl, g, S, E); }
            xcd_barrier(xbar);
            { pg8::Gemm g{(const bf16*)(ws + WS_U), (const bf16*)(ws + WS_WDN), SEQ, DM, DFF}; pg8::StaticOrder S; S.init(SEQ, DM, G, (int)blockIdx.x);
              E0 E{(bf16*)(ws + WS_FF) + (size_t)s * SEQ * DM, DM}; pg8::gemm_phase<E0, pg8::StaticOrder, true, true>(ldsl, g, S, E); }
            if (s < 2) xcd_barrier(xbar);
        }
    }
#endif
    SEAM(7);
    if (IN(8)) { final_rows(args, gw, NGW, lane); }
#undef IN
#undef SEAM
}

extern "C" void kernel_launch(void* const* d_in, const int* in_sizes, int n_in, void* d_out, int out_size, void* d_ws, size_t ws_size, hipStream_t stream) {
    static int grid = 0;
    if (grid == 0) {
        if (n_in != 30 || ws_size < WS_END) { fprintf(stderr, "kernel_launch: unexpected n_in %d / ws %zu\n", n_in, ws_size); grid = -1; return; }
        int dev = 0, cus = 0, per_cu = 0;
        hipGetDevice(&dev); hipDeviceGetAttribute(&cus, hipDeviceAttributeMultiprocessorCount, dev);
        if (hipFuncSetAttribute((const void*)hymba_fwd, hipFuncAttributeMaxDynamicSharedMemorySize, LDS_BYTES) != hipSuccess) { fprintf(stderr, "kernel_launch: hipFuncSetAttribute failed\n"); grid = -1; return; }
        hipOccupancyMaxActiveBlocksPerMultiprocessor(&per_cu, (const void*)hymba_fwd, NWAVES * 64, LDS_BYTES);
        (void)hipGetLastError();
        if (per_cu < 1) per_cu = 1;
        grid = cus * 1;
        if (grid < 192) { fprintf(stderr, "kernel_launch: grid %d too small\n", grid); grid = -1; return; }
    }
    if (grid < 0) return;
    if (hipMemsetAsync((char*)d_ws + WS_CTL, 0, CTL_BYTES, stream) != hipSuccess) { fprintf(stderr, "kernel_launch: memset failed\n"); return; }
    Args a{};
    for (int i = 0; i < 30; ++i) a.in[i] = (const float*)d_in[i];
    a.out = (float*)d_out; a.ws = (unsigned char*)d_ws;
#ifndef N_LAUNCH_SPLIT
    a.ph_lo = 0; a.ph_hi = 9;
    void* kargs[] = {&a};
    hipError_t e = hipLaunchCooperativeKernel((const void*)hymba_fwd, dim3(grid), dim3(NWAVES * 64), kargs, LDS_BYTES, stream);
    if (e != hipSuccess) fprintf(stderr, "cooperative launch failed: %s (grid %d)\n", hipGetErrorString(e), grid);
#else
    for (int p = 0; p < 9; ++p) { a.ph_lo = p; a.ph_hi = p + 1; void* kargs[] = {&a};
        hipError_t e = hipLaunchCooperativeKernel((const void*)hymba_fwd, dim3(grid), dim3(NWAVES * 64), kargs, LDS_BYTES, stream);
        if (e != hipSuccess) fprintf(stderr, "cooperative launch %d failed: %s (grid %d)\n", p, hipGetErrorString(e), grid); }
#endif
}
```

```cpp
#include <hip/hip_runtime.h>
#include <hip/hip_cooperative_groups.h>
#include <cstdio>
#include <cstdint>
namespace cg = cooperative_groups;
namespace pg8 {
#define PG8_LAS __attribute__((address_space(3)))
typedef unsigned short bf16_t;
typedef short bf16x8 __attribute__((ext_vector_type(8)));
typedef float f32x4 __attribute__((ext_vector_type(4)));
typedef unsigned u32x4 __attribute__((ext_vector_type(4)));
constexpr int BM = 256, BK = 64, HALF = 128, HTB = HALF * BK * 2  , STAGE_BYTES = 8 * HTB, NXCD = 8, WGM = 8;

__host__ __device__ __forceinline__ int lds_byte(int r, int c) { const int st = (r >> 4) * 2 + (c >> 5), rr = r & 15, cc = c & 31, ob = rr * 64 + cc * 2; return st * 1024 + (ob ^ (((ob >> 9) & 1) << 5)); }
__host__ __device__ __forceinline__ void stage_rc(int b, int& R, int& C) { const int st = b / 1024, sb = b % 1024, swz = sb ^ (((sb >> 9) & 1) << 5); R = (st >> 1) * 16 + swz / 64; C = (st & 1) * 32 + (swz % 64) / 2; }
__host__ __device__ __forceinline__ int perm32(int rho) { const int n = rho >> 4, i = rho & 15; return 8 * (i >> 2) + 4 * n + (i & 3); }

struct Unit { int pm, pn; };
struct Gemm { const bf16_t* A; const bf16_t* Bt; int M, N, K; };

struct StaticOrder {
    int nM, nN, nwg, G, c;
    __host__ __device__ void init(int M, int N, int G_, int c_) { nM = M / BM; nN = N / BM; nwg = nM * nN; G = G_; c = c_; }
    __host__ __device__ bool next(int i, Unit& u) const {
        const long L = (long)i * G + c; if (L >= nwg) return false;
        int wgid = (int)L; { const int q = nwg / NXCD, r = nwg % NXCD, xcd = wgid % NXCD, off = wgid / NXCD; wgid = (xcd < r ? xcd * (q + 1) : r * (q + 1) + (xcd - r) * q) + off; }
        const int nig = WGM * nN, gid = wgid / nig, fm = gid * WGM, gsz = (nM - fm) < WGM ? (nM - fm) : WGM;
        u.pm = fm + ((wgid % nig) % gsz); u.pn = (wgid % nig) / gsz; return true;
    }
    __device__ __forceinline__ void a_ready(const Unit&) const {}
    __device__ __forceinline__ void done(const Unit&) const {}
};

__device__ __forceinline__ unsigned cvt_pk_bf16(float lo, float hi) { unsigned r; asm volatile("v_cvt_pk_bf16_f32 %0, %1, %2" : "=v"(r) : "v"(lo), "v"(hi)); return r; }
typedef float f32x2 __attribute__((ext_vector_type(2)));
template <int ACT> struct EpiBf16 {
    static constexpr bool PERM = true, AFTER_DRAIN = false;
    bf16_t* O; int ldc;
    __device__ __forceinline__ void operator()(const f32x4 (&acc)[2][2][4][2], const Unit& u, int wr, int wc, int fr, int fq) const {
        const int row0 = u.pm * BM + wr * 64 + fr; const int col0 = u.pn * BM + wc * 32 + 8 * fq;
#pragma unroll
        for (int ai = 0; ai < 2; ++ai)
#pragma unroll
            for (int m = 0; m < 4; ++m) { bf16_t* rowp = O + (size_t)(row0 + ai * HALF + m * 16) * ldc + col0;
#pragma unroll
                for (int bj = 0; bj < 2; ++bj) { f32x4 v0 = acc[ai][bj][m][0], v1 = acc[ai][bj][m][1];
                    if (ACT == 2) { const f32x4 z = (f32x4){0.f, 0.f, 0.f, 0.f}; v0 = __builtin_elementwise_max(v0, z); v1 = __builtin_elementwise_max(v1, z); v0 = v0 * v0; v1 = v1 * v1; }
                    u32x4 w; w.x = cvt_pk_bf16(v0[0], v0[1]); w.y = cvt_pk_bf16(v0[2], v0[3]); w.z = cvt_pk_bf16(v1[0], v1[1]); w.w = cvt_pk_bf16(v1[2], v1[3]);
                    *(u32x4*)(rowp + bj * HALF) = w; } }
    }
};

template <class Epi, class Sched, bool ALIGN_EPI = false, bool SP2 = false>
__device__ __forceinline__ void gemm_phase(PG8_LAS unsigned char* lds, const Gemm g, const Sched& S, const Epi& E) {
    const int tid = threadIdx.x, wid = __builtin_amdgcn_readfirstlane(tid >> 6), lane = tid & 63, wr = wid >> 2, wc = wid & 3, fr = lane & 15, fq = lane >> 4;
    const int K = g.K, nt = K / BK;
    unsigned voffA[2], voffB[2];
#pragma unroll
    for (int i = 0; i < 2; ++i) { int R, C; stage_rc(tid * 16 + i * 8192, R, C); const int Rb = Epi::PERM ? ((R & ~31) + perm32(R & 31)) : R;
        voffA[i] = (unsigned)(R * K + C) * 2u; voffB[i] = (unsigned)(Rb * K + C) * 2u; }
    const size_t kstep = (size_t)(BK * 2);
    const size_t hstep = (size_t)HALF * K * 2;
    const size_t tstep = 2 * hstep;
    const unsigned ldsw = (unsigned)wid * 1024u;
    const int aoff = lds_byte(wr * 64 + fr, fq * 8), boff = lds_byte(wc * 32 + fr, fq * 8);
#define PG8_SA(b, h) (((b) * 2 + (h)) * HTB)
#define PG8_SB(b, h) ((4 + (b) * 2 + (h)) * HTB)
#define PG8_STAGE(bufoff, gbase, voff) do { _Pragma("unroll") for (int _i = 0; _i < 2; ++_i) \
        __builtin_amdgcn_global_load_lds((const unsigned*)((const char*)(gbase) + (voff)[_i]), (PG8_LAS unsigned*)(lds + (bufoff) + ldsw + _i * 8192), 16, 0, 0); } while (0)
#define PG8_LDA(dst, b, h) do { _Pragma("unroll") for (int m = 0; m < 4; ++m) _Pragma("unroll") for (int k = 0; k < 2; ++k) dst[m][k] = *(const PG8_LAS bf16x8*)(lds + PG8_SA(b, h) + aoff + m * 2048 + k * 1024); } while (0)
#define PG8_LDB(dst, b, h) do { _Pragma("unroll") for (int n = 0; n < 2; ++n) _Pragma("unroll") for (int k = 0; k < 2; ++k) dst[n][k] = *(const PG8_LAS bf16x8*)(lds + PG8_SB(b, h) + boff + n * 2048 + k * 1024); } while (0)
#define PG8_MMA(ai, bj, At, Bt) do { __builtin_amdgcn_s_setprio(1); _Pragma("unroll") for (int m = 0; m < 4; ++m) _Pragma("unroll") for (int n = 0; n < 2; ++n) _Pragma("unroll") for (int k = 0; k < 2; ++k) \
        acc[ai][bj][m][n] = __builtin_amdgcn_mfma_f32_16x16x32_bf16(Bt[n][k], At[m][k], acc[ai][bj][m][n], 0, 0, 0); __builtin_amdgcn_s_setprio(0); } while (0)
#define PG8_WAIT_V(n) asm volatile("s_waitcnt vmcnt(" #n ")" ::: "memory")
#define PG8_WAIT_L(n) asm volatile("s_waitcnt lgkmcnt(" #n ")" ::: "memory")
#define PG8_BAR __builtin_amdgcn_s_barrier()
#define PG8_SCHED __builtin_amdgcn_sched_barrier(0)
    Unit cur, nxt; int ui = 0;
    if (!S.next(0, cur)) return;
    f32x4 acc[2][2][4][2];
#pragma unroll
    for (int a = 0; a < 2; ++a)
#pragma unroll
        for (int b = 0; b < 2; ++b)
#pragma unroll
            for (int m = 0; m < 4; ++m)
#pragma unroll
                for (int n = 0; n < 2; ++n) acc[a][b][m][n] = (f32x4){0.f, 0.f, 0.f, 0.f};
    bf16x8 At[4][2], B0[2][2], B1[2][2];
    const char* cA = (const char*)g.A + (size_t)cur.pm * tstep; const char* cB = (const char*)g.Bt + (size_t)cur.pn * tstep;
    S.a_ready(cur);
    if constexpr (SP2) {
        PG8_STAGE(PG8_SB(0, 0), cB, voffB); PG8_STAGE(PG8_SB(0, 1), cB + hstep, voffB); PG8_STAGE(PG8_SA(0, 0), cA, voffA); PG8_STAGE(PG8_SA(0, 1), cA + hstep, voffA);
        if (wr == 1) PG8_BAR;
        PG8_WAIT_V(2); PG8_BAR;
        PG8_STAGE(PG8_SB(1, 0), cB + kstep, voffB); PG8_STAGE(PG8_SA(1, 0), cA + kstep, voffA); PG8_STAGE(PG8_SB(1, 1), cB + hstep + kstep, voffB);
        PG8_WAIT_V(6); PG8_BAR;
    } else {
        PG8_STAGE(PG8_SB(0, 0), cB, voffB); PG8_STAGE(PG8_SA(0, 0), cA, voffA); PG8_STAGE(PG8_SB(0, 1), cB + hstep, voffB); PG8_STAGE(PG8_SA(0, 1), cA + hstep, voffA);
        if (wr == 1) PG8_BAR;
        PG8_WAIT_V(4); PG8_BAR;
        PG8_STAGE(PG8_SB(1, 0), cB + kstep, voffB); PG8_STAGE(PG8_SA(1, 0), cA + kstep, voffA); PG8_STAGE(PG8_SB(1, 1), cB + hstep + kstep, voffB);
        PG8_WAIT_V(6); PG8_BAR;
    }
    for (;;) {
        const bool has_next = S.next(ui + 1, nxt);
        const char* nA = has_next ? (const char*)g.A + (size_t)nxt.pm * tstep : cA; const char* nB = has_next ? (const char*)g.Bt + (size_t)nxt.pn * tstep : cB;
        for (int t = 0; t < nt; t += 2) {
            const bool last = (t == nt - 2);
            const char* a1 = cA + (size_t)(t + 1) * kstep;
            const char* a2 = last ? nA : cA + (size_t)(t + 2) * kstep; const char* b2 = last ? nB : cB + (size_t)(t + 2) * kstep;
            const char* a3 = a2 + kstep; const char* b3 = b2 + kstep;
            if (last && has_next) S.a_ready(nxt);
            if constexpr (SP2) {
            PG8_LDB(B0, 0, 0); PG8_LDB(B1, 0, 1); PG8_SCHED; PG8_LDA(At, 0, 0); PG8_STAGE(PG8_SA(1, 1), a1 + hstep, voffA);
            PG8_WAIT_V(8); PG8_WAIT_L(0); PG8_BAR; PG8_MMA(0, 0, At, B0); PG8_MMA(0, 1, At, B1); PG8_BAR; PG8_SCHED;
            PG8_LDA(At, 0, 1); PG8_STAGE(PG8_SB(0, 0), b2, voffB); PG8_STAGE(PG8_SB(0, 1), b2 + hstep, voffB); PG8_STAGE(PG8_SA(0, 0), a2, voffA);
            PG8_WAIT_V(8); PG8_WAIT_L(0); PG8_BAR; PG8_MMA(1, 0, At, B0); PG8_MMA(1, 1, At, B1); PG8_BAR; PG8_SCHED;
            PG8_LDB(B0, 1, 0); PG8_LDB(B1, 1, 1); PG8_SCHED; PG8_LDA(At, 1, 0); PG8_STAGE(PG8_SA(0, 1), a2 + hstep, voffA);
            PG8_WAIT_V(8); PG8_WAIT_L(0); PG8_BAR; PG8_MMA(0, 0, At, B0); PG8_MMA(0, 1, At, B1); PG8_BAR; PG8_SCHED;
            PG8_LDA(At, 1, 1); PG8_STAGE(PG8_SB(1, 0), b3, voffB); PG8_STAGE(PG8_SB(1, 1), b3 + hstep, voffB); PG8_STAGE(PG8_SA(1, 0), a3, voffA);
            PG8_WAIT_V(8); PG8_WAIT_L(0); PG8_BAR; PG8_MMA(1, 0, At, B0); PG8_MMA(1, 1, At, B1); PG8_BAR; PG8_SCHED;
            } else {
            PG8_LDB(B0, 0, 0); PG8_SCHED; PG8_LDA(At, 0, 0); PG8_STAGE(PG8_SA(1, 1), a1 + hstep, voffA);
            PG8_WAIT_L(8); PG8_BAR; PG8_WAIT_L(0); PG8_MMA(0, 0, At, B0); PG8_BAR; PG8_SCHED;
            PG8_LDB(B1, 0, 1); PG8_STAGE(PG8_SB(0, 0), b2, voffB);
            PG8_BAR; PG8_WAIT_L(0); PG8_MMA(0, 1, At, B1); PG8_BAR;
            PG8_LDA(At, 0, 1); PG8_STAGE(PG8_SA(0, 0), a2, voffA);
            PG8_BAR; PG8_WAIT_L(0); PG8_MMA(1, 0, At, B0); PG8_BAR; PG8_SCHED;
            PG8_STAGE(PG8_SB(0, 1), b2 + hstep, voffB);
            PG8_WAIT_V(6); PG8_BAR; PG8_MMA(1, 1, At, B1); PG8_BAR;
            PG8_LDB(B0, 1, 0); PG8_SCHED; PG8_LDA(At, 1, 0); PG8_STAGE(PG8_SA(0, 1), a2 + hstep, voffA);
            PG8_WAIT_L(8); PG8_BAR; PG8_WAIT_L(0); PG8_MMA(0, 0, At, B0); PG8_BAR; PG8_SCHED;
            PG8_LDB(B1, 1, 1); PG8_STAGE(PG8_SB(1, 0), b3, voffB);
            PG8_BAR; PG8_WAIT_L(0); PG8_MMA(0, 1, At, B1); PG8_BAR;
            PG8_LDA(At, 1, 1); PG8_STAGE(PG8_SA(1, 0), a3, voffA);
            PG8_BAR; PG8_WAIT_L(0); PG8_MMA(1, 0, At, B0); PG8_BAR; PG8_SCHED;
            PG8_STAGE(PG8_SB(1, 1), b3 + hstep, voffB);
            PG8_WAIT_V(6); PG8_BAR; PG8_MMA(1, 1, At, B1); PG8_BAR;
            }
        }
        if constexpr (ALIGN_EPI) { if (wr == 0) PG8_BAR; }
        if constexpr (!Epi::AFTER_DRAIN) { E(acc, cur, wr, wc, fr, fq); S.done(cur); }
        if (!has_next) break;
#pragma unroll
        for (int a = 0; a < 2; ++a)
#pragma unroll
            for (int b = 0; b < 2; ++b)
#pragma unroll
                for (int m = 0; m < 4; ++m)
#pragma unroll
                    for (int n = 0; n < 2; ++n) acc[a][b][m][n] = (f32x4){0.f, 0.f, 0.f, 0.f};
        cur = nxt; cA = nA; cB = nB; ++ui;
        if constexpr (ALIGN_EPI) { if (wr == 1) PG8_BAR; }
    }
    PG8_WAIT_V(0);
    if constexpr (!ALIGN_EPI) { if (wr == 0) PG8_BAR; }
    PG8_BAR;
    if constexpr (Epi::AFTER_DRAIN) { E.fused(acc, cur, wr, wc, fr, fq, lds, wid, lane); S.done(cur); }
#undef PG8_SA
#undef PG8_SB
#undef PG8_STAGE
#undef PG8_LDA
#undef PG8_LDB
#undef PG8_MMA
#undef PG8_WAIT_V
#undef PG8_WAIT_L
#undef PG8_BAR
#undef PG8_SCHED
}
}

#define GAS __attribute__((address_space(1)))
#define LAS __attribute__((address_space(3)))
typedef unsigned short bf16;
typedef unsigned v4u __attribute__((ext_vector_type(4)));
typedef unsigned v2u __attribute__((ext_vector_type(2)));
typedef float f32x4 __attribute__((ext_vector_type(4)));
typedef float f32x2 __attribute__((ext_vector_type(2)));
typedef short bf16x8 __attribute__((ext_vector_type(8)));
typedef _Float16 h2 __attribute__((ext_vector_type(2)));
#define LDS_WAIT() asm volatile("s_waitcnt lgkmcnt(0)" ::: "memory")

constexpr int NWAVES = 8;
constexpr int NTOK = 24576, SEQ = 8192, DM = 2048, DR = 1024, DFF = 8192;
constexpr int ZLD = 5632, ZC_CA = 3072, ZC_CB = 4096, ZC_L = 5120;
constexpr size_t MiB = 1u << 20;
constexpr size_t WS_WIN = 0, WS_WOUT = 22 * MiB, WS_WUP = 30 * MiB, WS_WDN = 62 * MiB, WS_SMALL = 94 * MiB, WS_XL = 95 * MiB, WS_XG = 107 * MiB,
                 WS_BONUS = 115 * MiB, WS_H = 118 * MiB, WS_Z = 214 * MiB, WS_END = 478 * MiB;
constexpr size_t SM_G2T = 0, SM_W2TF = 384 * 1024, SM_W2TB = 512 * 1024, SM_A2TF = 640 * 1024, SM_A2TB = 768 * 1024;
constexpr size_t WS_YF = WS_Z, WS_YB = WS_Z + 96 * MiB, WS_MIX = WS_Z, WS_U = WS_Z, WS_FF = WS_Z + 128 * MiB;
constexpr size_t OUT_RS = 0, OUT_KS = 48 * MiB, OUT_VS = 96 * MiB, OUT_KK = 144 * MiB;
constexpr int LDS_BYTES = 147456, MISC_OFF = 131072 + 320;
constexpr size_t WS_CTL = 117 * MiB, CTL_BYTES = 16384;

struct Args { const float* in[30]; float* out; unsigned char* ws; int ph_lo, ph_hi; };

__device__ __forceinline__ float lo2f(unsigned u) { return __uint_as_float(u << 16); }
__device__ __forceinline__ float hi2f(unsigned u) { return __uint_as_float(u & 0xffff0000u); }
__device__ __forceinline__ unsigned f2bf(float f) { unsigned u = __float_as_uint(f); return (u + 0x7fffu + ((u >> 16) & 1u)) >> 16; }
__device__ __forceinline__ unsigned pk2(float lo, float hi) { unsigned r; asm volatile("v_cvt_pk_bf16_f32 %0, %1, %2" : "=v"(r) : "v"(lo), "v"(hi)); return r; }
__device__ __forceinline__ float fsigmoid(float x) { return __builtin_amdgcn_rcpf(1.f + __builtin_amdgcn_exp2f(-1.44269504f * x)); }
__device__ __forceinline__ float ftanh(float x) { return 1.f - 2.f * __builtin_amdgcn_rcpf(1.f + __builtin_amdgcn_exp2f(2.88539008f * x)); }
__device__ __forceinline__ float wave_sum(float v) {
#pragma unroll
    for (int o = 1; o < 64; o <<= 1) v += __shfl_xor(v, o);
    return v;
}
template <int CTRL> __device__ __forceinline__ float dppf(float x) { return __int_as_float(__builtin_amdgcn_update_dpp(0, __float_as_int(x), CTRL, 0xF, 0xF, true)); }
__device__ __forceinline__ float red8(float x) { x += dppf<0xB1>(x); x += dppf<0x4E>(x); x += dppf<0x141>(x); return x; }
__device__ __forceinline__ const float* xrow(const Args& a, int m) { return m < 16384 ? a.in[0] + (size_t)m * DM : a.in[1] + (size_t)(m - 16384) * DM; }

__device__ __forceinline__ void tr_item(const float* W, int ldw, int k0, int sc0, bf16* WT, int ldt, int dr0, LAS float* scr, int lane) {
#pragma unroll 8
    for (int i = 0; i < 32; ++i) { const int kk = 2 * i + (lane >> 5); scr[kk * 33 + (lane & 31)] = W[(size_t)(k0 + kk) * ldw + sc0 + (lane & 31)]; }
    LDS_WAIT(); asm volatile("" ::: "memory");
    const int c = lane & 7;
#pragma unroll
    for (int j = 0; j < 4; ++j) { const int n = (lane >> 3) + 8 * j; const LAS float* s = scr + (8 * c) * 33 + n;
        v4u o; o.x = pk2(s[0 * 33], s[1 * 33]); o.y = pk2(s[2 * 33], s[3 * 33]); o.z = pk2(s[4 * 33], s[5 * 33]); o.w = pk2(s[6 * 33], s[7 * 33]);
        *(v4u*)(WT + (size_t)(dr0 + n) * ldt + k0 + 8 * c) = o; }
    LDS_WAIT(); asm volatile("" ::: "memory");
}
__device__ __forceinline__ void rms_row_bf16(const float* xr_, const float* g, bf16* orow, int lane) {
    const f32x4* xr = (const f32x4*)xr_ + lane; const f32x4* gr = (const f32x4*)g + lane;
    f32x4 v[8]; float s = 0.f;
#pragma unroll
    for (int j = 0; j < 8; ++j) { v[j] = xr[64 * j]; s += (v[j].x * v[j].x + v[j].y * v[j].y) + (v[j].z * v[j].z + v[j].w * v[j].w); }
    const float rstd = 1.f / sqrtf(wave_sum(s) * (1.f / DM) + 1e-6f);
    v2u* o8 = (v2u*)orow + lane;
#pragma unroll
    for (int j = 0; j < 8; ++j) { const f32x4 gg = gr[64 * j]; v2u o; o.x = pk2(v[j].x * rstd * gg.x, v[j].y * rstd * gg.y); o.y = pk2(v[j].z * rstd * gg.z, v[j].w * rstd * gg.w); o8[64 * j] = o; }
}
__device__ __forceinline__ void p0_prologue(const Args& a, LAS unsigned char* lds, int gw, int NGW, int wave, int lane) {
    unsigned char* ws = a.ws;
    LAS float* scr = (LAS float*)(lds + wave * 16384);
    bf16* WIN = (bf16*)(ws + WS_WIN); bf16* WOUT = (bf16*)(ws + WS_WOUT); bf16* WUP = (bf16*)(ws + WS_WUP); bf16* WDN = (bf16*)(ws + WS_WDN);
    constexpr int I_IN = 32 * 173, I_OUT = 32 * 64, I_UP = 32 * 256, I_DN = 128 * 64, I_S = 32;
    constexpr int NITEMS = I_IN + I_OUT + I_UP + I_DN + 4 * I_S;
    for (int it = gw; it < NITEMS; it += NGW) {
        int r = it;
        if (r < I_IN) { const int kb = r / 173, nb = r % 173, sc0 = nb * 32; const int dr0 = sc0 < 3072 ? sc0 : (sc0 < 3488 ? ZC_L + (sc0 - 3072) : ZC_CA + (sc0 - 3488));
            tr_item(a.in[3], 5536, kb * 64, sc0, WIN, DM, dr0, scr, lane); continue; } r -= I_IN;
        if (r < I_OUT) { tr_item(a.in[24], DM, (r / 64) * 64, (r % 64) * 32, WOUT, DM, (r % 64) * 32, scr, lane); continue; } r -= I_OUT;
        if (r < I_UP) { tr_item(a.in[27], DFF, (r / 256) * 64, (r % 256) * 32, WUP, DM, (r % 256) * 32, scr, lane); continue; } r -= I_UP;
        if (r < I_DN) { tr_item(a.in[28], DM, (r / 64) * 64, (r % 64) * 32, WDN, DFF, (r % 64) * 32, scr, lane); continue; } r -= I_DN;
        { const int which = r / I_S, nb = r % I_S; const float* src = which == 0 ? a.in[7] : which == 1 ? a.in[9] : which == 2 ? a.in[11] : a.in[13];
          bf16* dst = (bf16*)(ws + WS_SMALL + (which == 0 ? SM_W2TF : which == 1 ? SM_W2TB : which == 2 ? SM_A2TF : SM_A2TB));
          tr_item(src, DR, 0, nb * 32, dst, 64, nb * 32, scr, lane); }
    }
    { const int gt = gw * 64 + lane, NGT = NGW * 64;
      v4u zz = {0u, 0u, 0u, 0u}; v4u* zp = (v4u*)(WIN + (size_t)5536 * DM);
      for (int i = gt; i < 96 * DM / 8; i += NGT) zp[i] = zz;
      bf16* G2T = (bf16*)(ws + WS_SMALL + SM_G2T); const float* g2 = a.in[14];
      for (int i = gt; i < 160 * 1024; i += NGT) { const int k = i >> 10, n = i & 1023; G2T[n * 160 + k] = (bf16)f2bf(g2[i]); } }
    bf16* H = (bf16*)(ws + WS_H);
    for (int m = gw; m < NTOK; m += NGW) rms_row_bf16(xrow(a, m), a.in[2], H + (size_t)m * DM, lane);
}

__device__ __forceinline__ void shift_phase(const Args& a, int gw, int NGW, int lane) {
    unsigned char* ws = a.ws;
    const bf16* Z = (const bf16*)(ws + WS_Z);
    bf16* RS = (bf16*)((unsigned char*)a.out + OUT_RS); bf16* KS = (bf16*)((unsigned char*)a.out + OUT_KS);
    bf16* VS = (bf16*)((unsigned char*)a.out + OUT_VS); bf16* KK = (bf16*)((unsigned char*)a.out + OUT_KK);
    bf16* XL = (bf16*)(ws + WS_XL); bf16* XG = (bf16*)(ws + WS_XG); float* BONUS = (float*)(ws + WS_BONUS);
    const float* mup = a.in[4]; const float* mun = a.in[5]; const float* k_k = a.in[15]; const float* r_k = a.in[17];
    const int hp2 = lane >> 5, n2 = (lane & 31) * 2;
    for (int m = gw; m < NTOK; m += NGW) {
        const int t = m & (SEQ - 1); const bool hp = t > 0, hn = t < SEQ - 1;
        const bf16* z0 = Z + (size_t)m * ZLD; const bf16* zp = z0 - ZLD; const bf16* zn = z0 + ZLD;
#pragma unroll 2
        for (int hh = 0; hh < 8; ++hh) {
            const int c = (hh * 2 + hp2) * 64 + n2;
            float s[3][2];
#pragma unroll
            for (int ar = 0; ar < 3; ++ar) { const int col = ar * 1024 + c;
                const unsigned zc = *(const unsigned*)(z0 + col); const unsigned zpv = hp ? *(const unsigned*)(zp + col) : 0u; const unsigned znv = hn ? *(const unsigned*)(zn + col) : 0u;
                const f32x2 mp = *(const f32x2*)(mup + col), mn = *(const f32x2*)(mun + col);
                const float x0 = lo2f(zc), x1 = hi2f(zc);
                s[ar][0] = x0 + mp.x * (lo2f(zpv) - x0) + mn.x * (lo2f(znv) - x0);
                s[ar][1] = x1 + mp.y * (hi2f(zpv) - x1) + mn.y * (hi2f(znv) - x1); }
            const f32x2 kkw = *(const f32x2*)(k_k + c), rkw = *(const f32x2*)(r_k + c);
            const float kr0 = s[1][0] * kkw.x, kr1 = s[1][1] * kkw.y;
            float ss = kr0 * kr0 + kr1 * kr1, bs = s[0][0] * s[1][0] * rkw.x + s[0][1] * s[1][1] * rkw.y;
#pragma unroll
            for (int o = 1; o < 32; o <<= 1) { ss += __shfl_xor(ss, o); bs += __shfl_xor(bs, o); }
            const float inv = 1.f / fmaxf(sqrtf(ss), 1e-12f);
            const size_t o = (size_t)m * DR + c;
            *(unsigned*)(RS + o) = pk2(s[0][0], s[0][1]); *(unsigned*)(KS + o) = pk2(s[1][0], s[1][1]);
            *(unsigned*)(VS + o) = pk2(s[2][0], s[2][1]); *(unsigned*)(KK + o) = pk2(kr0 * inv, kr1 * inv);
            if ((lane & 31) == 0) BONUS[m * 16 + hh * 2 + hp2] = bs;
        }
#pragma unroll
        for (int p = 0; p < 7; ++p) { const int j = p * 64 + lane;
            if (j < 416) { const int col = ZC_L + j, og = 3072 + j;
                const float x0 = lo2f(z0[col]); const float xp = hp ? lo2f(zp[col]) : 0.f; const float xn = hn ? lo2f(zn[col]) : 0.f;
                const float sv = x0 + mup[og] * (xp - x0) + mun[og] * (xn - x0);
                if (j < 128) XL[(size_t)m * 256 + j] = (bf16)f2bf(ftanh(sv));
                else if (j < 256) XL[(size_t)m * 256 + j] = (bf16)f2bf(sv);
                else XG[(size_t)m * 160 + (j - 256)] = (bf16)f2bf(fsigmoid(sv)); } }
    }
}

#define TR_STAGE(D_, N_) { const bool up_ = (lane & (D_)) != 0; _Pragma("unroll") for (int i_ = 0; i_ < (N_) / 2; ++i_) { \
    const float keep_ = up_ ? vals[i_ + (N_) / 2] : vals[i_]; const float send_ = up_ ? vals[i_] : vals[i_ + (N_) / 2]; vals[i_] = keep_ + __shfl_xor(send_, (D_)); } }
__device__ __forceinline__ void conv_phase(const Args& a, unsigned char* lds, int tid, int wave, int lane) {
    unsigned char* ws = a.ws;
    const bf16* Z = (const bf16*)(ws + WS_Z); bf16* MIXIN = (bf16*)(ws + WS_H);
    h2* utile = (h2*)lds;
    float* part = (float*)(lds + 126976);
    f32x2* stats = (f32x2*)(lds + 126976 + 2048);
    const float* dw_w = a.in[20]; const float* dw_b = a.in[21]; const float* cln_w = a.in[22]; const float* cln_b = a.in[23];
    const int cp = tid;
    for (int unit = blockIdx.x; unit < NTOK / 32; unit += gridDim.x) {
        const int m0 = unit * 32, t0 = m0 & (SEQ - 1);
        for (int idx = tid; idx < 62 * 512; idx += 512) { const int row = idx >> 9, c2 = idx & 511; const int t = t0 - 15 + row;
            h2 u = {(_Float16)0.f, (_Float16)0.f};
            if (t >= 0 && t < SEQ) { const bf16* zr = Z + (size_t)(m0 - 15 + row) * ZLD; const unsigned za = *(const unsigned*)(zr + ZC_CA + 2 * c2), zb = *(const unsigned*)(zr + ZC_CB + 2 * c2);
                u.x = (_Float16)(lo2f(za) * fsigmoid(lo2f(zb))); u.y = (_Float16)(hi2f(za) * fsigmoid(hi2f(zb))); }
            utile[idx] = u; }
        __syncthreads();
        f32x2 w[31];
#pragma unroll
        for (int j = 0; j < 31; ++j) w[j] = *(const f32x2*)(dw_w + j * 1024 + 2 * cp);
        const f32x2 bias = *(const f32x2*)(dw_b + 2 * cp);
        f32x2 out[32];
#pragma unroll
        for (int tb = 0; tb < 4; ++tb) {
            f32x2 acc[8];
#pragma unroll
            for (int o = 0; o < 8; ++o) acc[o] = bias;
#pragma unroll
            for (int jj = 0; jj < 38; ++jj) { const h2 uh = utile[(tb * 8 + jj) * 512 + cp]; const f32x2 u = {(float)uh.x, (float)uh.y};
#pragma unroll
                for (int o = 0; o < 8; ++o) { const int j = jj - o; if (j >= 0 && j < 31) acc[o] = u * w[j] + acc[o]; } }
#pragma unroll
            for (int o = 0; o < 8; ++o) out[tb * 8 + o] = acc[o];
            asm volatile("" ::: "memory");
        }
        float vals[64];
#pragma unroll
        for (int t = 0; t < 32; ++t) { vals[2 * t] = out[t].x + out[t].y; vals[2 * t + 1] = out[t].x * out[t].x + out[t].y * out[t].y; }
        TR_STAGE(32, 64) TR_STAGE(16, 32) TR_STAGE(8, 16) TR_STAGE(4, 8) TR_STAGE(2, 4) TR_STAGE(1, 2)
        part[wave * 64 + lane] = vals[0];
        __syncthreads();
        if (tid < 32) { float s = 0.f, q = 0.f;
#pragma unroll
            for (int wv = 0; wv < 8; ++wv) { s += part[wv * 64 + 2 * tid]; q += part[wv * 64 + 2 * tid + 1]; }
            const float mean = s * (1.f / 1024.f); const float var = q * (1.f / 1024.f) - mean * mean;
            stats[tid] = (f32x2){mean, 1.f / sqrtf(var + 1e-5f)}; }
        __syncthreads();
        const f32x2 lw = *(const f32x2*)(cln_w + 2 * cp), lb = *(const f32x2*)(cln_b + 2 * cp);
#pragma unroll
        for (int t = 0; t < 32; ++t) { const f32x2 st = stats[t];
            const float y0 = (out[t].x - st.x) * st.y * lw.x + lb.x, y1 = (out[t].y - st.x) * st.y * lw.y + lb.y;
            *(unsigned*)(MIXIN + (size_t)(m0 + t) * DM + DR + 2 * cp) = pk2(y0 * fsigmoid(y0), y1 * fsigmoid(y1)); }
        __syncthreads();
    }
}

constexpr int SC_LD = 68, SC_ARR = 32 * SC_LD, SC_ARR4 = SC_ARR / 4, SC_BUF = (5 * SC_ARR + SC_LD) * 4;
struct ScanOps { f32x4 q0, q1, a0, a1, m0, m1, r0, r1; float vv; };
__device__ __forceinline__ void ld_ops(ScanOps& o, const float* cb, int i, int ks, int rr) {
    const f32x4* p = (const f32x4*)(cb + i * SC_LD + ks * 8);
    o.q0 = p[0]; o.q1 = p[1]; o.a0 = p[SC_ARR4]; o.a1 = p[SC_ARR4 + 1]; o.m0 = p[2 * SC_ARR4]; o.m1 = p[2 * SC_ARR4 + 1]; o.r0 = p[3 * SC_ARR4]; o.r1 = p[3 * SC_ARR4 + 1];
    o.vv = cb[4 * SC_ARR + i * SC_LD + rr];
}
__device__ __forceinline__ void scan_phase(const Args& a, unsigned char* lds, int wave, int lane) {
    if (blockIdx.x >= 192) return;
    unsigned char* ws = a.ws;
    const int scan = blockIdx.x >> 1, half = blockIdx.x & 1, dir = scan & 1, sh = scan >> 1, seq = sh >> 4, h = sh & 15;
    const size_t row0 = (size_t)seq * SEQ;
    const bf16* RS = (const bf16*)((unsigned char*)a.out + OUT_RS); const bf16* KS = (const bf16*)((unsigned char*)a.out + OUT_KS);
    const bf16* VS = (const bf16*)((unsigned char*)a.out + OUT_VS); const bf16* KK = (const bf16*)((unsigned char*)a.out + OUT_KK);
    const bf16* XL = (const bf16*)(ws + WS_XL);
    float* Y = (float*)(ws + (dir ? WS_YB : WS_YF));
    constexpr int NCH = SEQ / 32;
    const int ks = lane & 7, rr = half * 32 + (wave & 3) * 8 + (lane >> 3);
    f32x2 S0 = {0.f, 0.f}, S1 = S0, S2 = S0, S3 = S0;
    float* ybase = Y + row0 * DR + h * 64 + rr;
    const int pw = wave & 3, fr = lane & 15, fq = lane >> 4, cl = pw * 16 + fq * 4, gcol = h * 64 + cl;
    bf16x8 Bw0, Bw1, Ba0, Ba1; f32x4 w0v, a0v, kav;
    {
        const bf16* W2T = (const bf16*)(ws + WS_SMALL + (dir ? SM_W2TB : SM_W2TF)); const bf16* A2T = (const bf16*)(ws + WS_SMALL + (dir ? SM_A2TB : SM_A2TF));
        const size_t bo = (size_t)(h * 64 + pw * 16 + fr) * 64 + fq * 8;
        Bw0 = *(const bf16x8*)(W2T + bo); Bw1 = *(const bf16x8*)(W2T + bo + 32); Ba0 = *(const bf16x8*)(A2T + bo); Ba1 = *(const bf16x8*)(A2T + bo + 32);
        w0v = *(const f32x4*)((dir ? a.in[8] : a.in[6]) + gcol); a0v = *(const f32x4*)((dir ? a.in[12] : a.in[10]) + gcol); kav = *(const f32x4*)(a.in[16] + gcol);
    }
    for (int c = 0; c <= NCH; ++c) {
        if (wave >= 4) {
            if (c < NCH) {
                float* cb = (float*)(lds + (c & 1) * SC_BUF);
                f32x4 off = {0.f, 0.f, 0.f, 0.f};
#pragma unroll
                for (int mt = 0; mt < 2; ++mt) {
                    const int i = mt * 16 + fr, step = c * 32 + i, t = dir ? (SEQ - 1 - step) : step; const size_t m = row0 + t;
                    const bf16* xl = XL + m * 256 + dir * 64 + fq * 8;
                    const bf16x8 At0 = *(const bf16x8*)(xl), At1 = *(const bf16x8*)(xl + 32), Aa0 = *(const bf16x8*)(xl + 128), Aa1 = *(const bf16x8*)(xl + 160);
                    const size_t go = m * DR + gcol;
                    const v2u r4 = *(const v2u*)(RS + go), k4 = *(const v2u*)(KS + go), v4 = *(const v2u*)(VS + go), q4 = *(const v2u*)(KK + go);
                    f32x4 aw = {0.f, 0.f, 0.f, 0.f}, aa = aw;
                    aw = __builtin_amdgcn_mfma_f32_16x16x32_bf16(Bw0, At0, aw, 0, 0, 0); aw = __builtin_amdgcn_mfma_f32_16x16x32_bf16(Bw1, At1, aw, 0, 0, 0);
                    aa = __builtin_amdgcn_mfma_f32_16x16x32_bf16(Ba0, Aa0, aa, 0, 0, 0); aa = __builtin_amdgcn_mfma_f32_16x16x32_bf16(Ba1, Aa1, aa, 0, 0, 0);
                    const f32x4 rv = {lo2f(r4.x), hi2f(r4.x), lo2f(r4.y), hi2f(r4.y)}, kv = {lo2f(k4.x), hi2f(k4.x), lo2f(k4.y), hi2f(k4.y)};
                    const f32x4 vv = {lo2f(v4.x), hi2f(v4.x), lo2f(v4.y), hi2f(v4.y)}, qv = {lo2f(q4.x), hi2f(q4.x), lo2f(q4.y), hi2f(q4.y)};
                    f32x4 lw, cum, av, pm1, pin, pp;
#pragma unroll
                    for (int j = 0; j < 4; ++j) {
                        lw[j] = -0.87500596f * fsigmoid(w0v[j] + aw[j]); av[j] = fsigmoid(a0v[j] + aa[j]);
                        float x = lw[j]; x += dppf<0x111>(x); x += dppf<0x112>(x); x += dppf<0x114>(x); x += dppf<0x118>(x);
                        cum[j] = x + off[j];
                        pm1[j] = __builtin_amdgcn_exp2f(cum[j] - lw[j]); pin[j] = __builtin_amdgcn_exp2f(-cum[j]); pp[j] = __builtin_amdgcn_exp2f(cum[j]);
                    }
                    if (mt == 0) {
#pragma unroll
                        for (int j = 0; j < 4; ++j) off[j] = __shfl(cum[j], (lane & 48) | 15);
                    }
                    f32x4* dst = (f32x4*)(cb + i * SC_LD + cl);
                    dst[0] = qv * pm1; dst[SC_ARR4] = qv * av * pin; dst[2 * SC_ARR4] = kv * (1.f + (av - 1.f) * kav) * pin; dst[3 * SC_ARR4] = rv * pp; dst[4 * SC_ARR4] = vv;
                    if (i == 31) *(f32x4*)(cb + 5 * SC_ARR + cl) = pp;
                }
            }
        } else if (c > 0) {
            const float* cb = (const float*)(lds + ((c - 1) & 1) * SC_BUF);
            const int cbase = (c - 1) * 32;
            ScanOps o[2]; ld_ops(o[0], cb, 0, ks, rr);
#pragma unroll
            for (int g = 0; g < 4; ++g) {
                float ysel = 0.f;
#pragma unroll
                for (int j = 0; j < 8; ++j) {
                    const int i = g * 8 + j;
                    if (i + 1 < 32) ld_ops(o[(i + 1) & 1], cb, i + 1, ks, rr);
                    const ScanOps& x = o[i & 1];
                    f32x2 acc = S0 * x.q0.xy, acc2 = S1 * x.q0.zw; acc = S2 * x.q1.xy + acc; acc2 = S3 * x.q1.zw + acc2; acc = acc + acc2;
                    const float sa = red8(acc.x + acc.y);
                    const f32x2 sav = {sa, sa}, vv2 = {x.vv, x.vv};
                    S0 = vv2 * x.m0.xy + S0; S1 = vv2 * x.m0.zw + S1; S2 = vv2 * x.m1.xy + S2; S3 = vv2 * x.m1.zw + S3;
                    S0 = S0 - sav * x.a0.xy; S1 = S1 - sav * x.a0.zw; S2 = S2 - sav * x.a1.xy; S3 = S3 - sav * x.a1.zw;
                    f32x2 yq = S0 * x.r0.xy, yq2 = S1 * x.r0.zw; yq = S2 * x.r1.xy + yq; yq2 = S3 * x.r1.zw + yq2; yq = yq + yq2;
                    const float y = red8(yq.x + yq.y);
                    ysel = (ks == j) ? y : ysel;
                }
                const int step = cbase + g * 8 + ks, t = dir ? (SEQ - 1 - step) : step;
                ybase[(size_t)t * DR] = ysel;
            }
            const f32x4* pe = (const f32x4*)(cb + 5 * SC_ARR + ks * 8);
            const f32x4 pe0 = pe[0], pe1 = pe[1];
            S0 = S0 * pe0.xy; S1 = S1 * pe0.zw; S2 = S2 * pe1.xy; S3 = S3 * pe1.zw;
        }
        __syncthreads();
    }
}

__device__ __forceinline__ void post_phase(const Args& a, int wave, int lane) {
    unsigned char* ws = a.ws;
    const bf16* XG = (const bf16*)(ws + WS_XG); const bf16* G2T = (const bf16*)(ws + WS_SMALL + SM_G2T);
    const float* YF = (const float*)(ws + WS_YF); const float* YB = (const float*)(ws + WS_YB); const float* BONUS = (const float*)(ws + WS_BONUS);
    const bf16* VS = (const bf16*)((unsigned char*)a.out + OUT_VS); bf16* MIXIN = (bf16*)(ws + WS_H);
    const float* gn_w = a.in[18]; const float* gn_b = a.in[19];
    const int fr = lane & 15, fq = lane >> 4, n0 = wave * 128;
    for (int unit = blockIdx.x; unit < NTOK / 32; unit += gridDim.x) {
        const int m0 = unit * 32;
        f32x4 acc[2][8];
#pragma unroll
        for (int mt = 0; mt < 2; ++mt)
#pragma unroll
            for (int nt = 0; nt < 8; ++nt) acc[mt][nt] = (f32x4){0.f, 0.f, 0.f, 0.f};
#pragma unroll
        for (int kq = 0; kq < 5; ++kq) {
            bf16x8 A[2];
#pragma unroll
            for (int mt = 0; mt < 2; ++mt) A[mt] = *(const bf16x8*)(XG + (size_t)(m0 + mt * 16 + fr) * 160 + kq * 32 + fq * 8);
#pragma unroll
            for (int nt = 0; nt < 8; ++nt) { const bf16x8 B = *(const bf16x8*)(G2T + (size_t)(n0 + nt * 16 + fr) * 160 + kq * 32 + fq * 8);
#pragma unroll
                for (int mt = 0; mt < 2; ++mt) acc[mt][nt] = __builtin_amdgcn_mfma_f32_16x16x32_bf16(B, A[mt], acc[mt][nt], 0, 0, 0); }
        }
#pragma unroll
        for (int mt = 0; mt < 2; ++mt) { const size_t m = (size_t)(m0 + mt * 16 + fr);
#pragma unroll
            for (int hh = 0; hh < 2; ++hh) { const int hd = wave * 2 + hh;
                f32x4 y[4]; float s = 0.f;
#pragma unroll
                for (int q = 0; q < 4; ++q) { const size_t o = m * DR + n0 + (hh * 4 + q) * 16 + fq * 4; y[q] = *(const f32x4*)(YF + o) + *(const f32x4*)(YB + o); s += (y[q].x + y[q].y) + (y[q].z + y[q].w); }
                s += __shfl_xor(s, 16); s += __shfl_xor(s, 32);
                const float mean = s * (1.f / 64.f); float ss = 0.f;
#pragma unroll
                for (int q = 0; q < 4; ++q) { y[q] = y[q] - mean; ss += (y[q].x * y[q].x + y[q].y * y[q].y) + (y[q].z * y[q].z + y[q].w * y[q].w); }
                ss += __shfl_xor(ss, 16); ss += __shfl_xor(ss, 32);
                const float rstd = 1.f / sqrtf(ss * (1.f / 64.f) + 64e-5f); const float bs = BONUS[m * 16 + hd];
#pragma unroll
                for (int q = 0; q < 4; ++q) { const int c = n0 + (hh * 4 + q) * 16 + fq * 4; const f32x4 gw4 = *(const f32x4*)(gn_w + c), gb4 = *(const f32x4*)(gn_b + c);
                    const v2u v4 = *(const v2u*)(VS + m * DR + c); const f32x4 vv = {lo2f(v4.x), hi2f(v4.x), lo2f(v4.y), hi2f(v4.y)};
                    const f32x4 o = (y[q] * rstd * gw4 + gb4 + bs * vv) * acc[mt][hh * 4 + q];
                    v2u ov; ov.x = pk2(o.x, o.y); ov.y = pk2(o.z, o.w); *(v2u*)(MIXIN + m * DM + c) = ov; }
            }
        }
    }
}

__device__ __forceinline__ void mid_rows(const Args& a, int gw, int NGW, int lane) {
    unsigned char* ws = a.ws; const bf16* MIX = (const bf16*)(ws + WS_MIX); bf16* H = (bf16*)(ws + WS_H);
    const f32x4* g1 = (const f32x4*)a.in[25] + lane; const f32x4* g2 = (const f32x4*)a.in[26] + lane;
    for (int m = gw; m < NTOK; m += NGW) {
        const v2u* mr = (const v2u*)(MIX + (size_t)m * DM) + lane; const f32x4* xr = (const f32x4*)xrow(a, m) + lane;
        f32x4 v[8]; float s = 0.f;
#pragma unroll
        for (int j = 0; j < 8; ++j) { const v2u u = mr[64 * j]; v[j] = (f32x4){lo2f(u.x), hi2f(u.x), lo2f(u.y), hi2f(u.y)}; s += (v[j].x * v[j].x + v[j].y * v[j].y) + (v[j].z * v[j].z + v[j].w * v[j].w); }
        const float rstd = 1.f / sqrtf(wave_sum(s) * (1.f / DM) + 1e-6f); float s1 = 0.f;
        f32x4* orow = (f32x4*)(a.out + (size_t)m * DM) + lane;
#pragma unroll
        for (int j = 0; j < 8; ++j) { v[j] = xr[64 * j] + v[j] * rstd * g1[64 * j]; orow[64 * j] = v[j]; s1 += (v[j].x * v[j].x + v[j].y * v[j].y) + (v[j].z * v[j].z + v[j].w * v[j].w); }
        const float rstd1 = 1.f / sqrtf(wave_sum(s1) * (1.f / DM) + 1e-6f);
        v2u* hr = (v2u*)(H + (size_t)m * DM) + lane;
#pragma unroll
        for (int j = 0; j < 8; ++j) { const f32x4 gg = g2[64 * j]; v2u o; o.x = pk2(v[j].x * rstd1 * gg.x, v[j].y * rstd1 * gg.y); o.y = pk2(v[j].z * rstd1 * gg.z, v[j].w * rstd1 * gg.w); hr[64 * j] = o; }
    }
}
__device__ __forceinline__ void final_rows(const Args& a, int gw, int NGW, int lane) {
    unsigned char* ws = a.ws; const bf16* FF = (const bf16*)(ws + WS_FF);
    const f32x4* g1 = (const f32x4*)a.in[29] + lane;
    for (int m = gw; m < NTOK; m += NGW) {
        const v2u* mr = (const v2u*)(FF + (size_t)m * DM) + lane;
        f32x4 v[8]; float s = 0.f;
#pragma unroll
        for (int j = 0; j < 8; ++j) { const v2u u = mr[64 * j]; v[j] = (f32x4){lo2f(u.x), hi2f(u.x), lo2f(u.y), hi2f(u.y)}; s += (v[j].x * v[j].x + v[j].y * v[j].y) + (v[j].z * v[j].z + v[j].w * v[j].w); }
        const float rstd = 1.f / sqrtf(wave_sum(s) * (1.f / DM) + 1e-6f);
        f32x4* orow = (f32x4*)(a.out + (size_t)m * DM) + lane;
#pragma unroll
        for (int j = 0; j < 8; ++j) orow[64 * j] = orow[64 * j] + v[j] * rstd * g1[64 * j];
    }
}

typedef GAS unsigned gu32;
#define XB_TMO      128
#define XB_XCNT(j)  (256  + 64 * (j))
#define XB_XSUB(j)  (1280 + 64 * (j))
#define XB_XGEN(j)  (2304 + 64 * (j))
#define XB_TOP      3328
#define XB_TOPGEN   3392
#define XCD_BAR_WORDS 3456
#define XB_SPIN_CAP (1u << 18)

__device__ __forceinline__ unsigned xb_ld(unsigned* p)              { return __hip_atomic_load(p, __ATOMIC_RELAXED, __HIP_MEMORY_SCOPE_AGENT); }
__device__ __forceinline__ unsigned xb_add(unsigned* p, unsigned v) { return __hip_atomic_fetch_add(p, v, __ATOMIC_RELAXED, __HIP_MEMORY_SCOPE_AGENT); }
__device__ __forceinline__ unsigned xb_xcc_id() { return (unsigned)__builtin_amdgcn_s_getreg((3 << 11) | 20) & 0xFu; }
#define XB_SPIN(cond, bar) do { unsigned _sp = 0; while (cond) { __builtin_amdgcn_s_sleep(1); \
    if ((++_sp & 255u) == 0u) { if (xb_ld(&(bar)[XB_TMO])) break; if (_sp > XB_SPIN_CAP) { atomicAdd(&(bar)[XB_TMO], 1u); break; } } } } while (0)

struct XcdBarrier {
    unsigned* bar; unsigned x;
    volatile LAS unsigned* st;
};

__device__ __forceinline__ XcdBarrier xcd_barrier_post(unsigned* bar, volatile LAS unsigned* st) {
    XcdBarrier b; b.bar = bar; b.x = xb_xcc_id(); b.st = st;
    if (threadIdx.x == 0) (void)xb_add(&bar[XB_XCNT(b.x)], 1u);
    return b;
}
__device__ __forceinline__ void xcd_barrier_complete(unsigned* bar, unsigned x, unsigned& nloc, unsigned& nx) {
    const unsigned G = gridDim.x * gridDim.y * gridDim.z;
    unsigned sum, cnt, mine, sp = 0u;
    for (;;) {
        sum = 0u; cnt = 0u; mine = 0u;
#pragma unroll
        for (unsigned j = 0; j < 16; ++j) { const unsigned c = xb_ld(&bar[XB_XCNT(j)]); sum += c; cnt += (c > 0u) ? 1u : 0u; mine = (j == x) ? c : mine; }
        if (sum == G) break;
        __builtin_amdgcn_s_sleep(1);
        if ((++sp & 255u) == 0u) { if (xb_ld(&bar[XB_TMO])) break; if (sp > XB_SPIN_CAP) { atomicAdd(&bar[XB_TMO], 1u); break; } }
    }
    nloc = mine > 0u ? mine : 1u; nx = cnt > 0u ? cnt : 1u;
}

__device__ __forceinline__ void xcd_barrier(const XcdBarrier& b) {
    asm volatile("s_waitcnt vmcnt(0)" ::: "memory");
    __syncthreads();
    if (threadIdx.x == 0) {
        unsigned* bar = b.bar;
        __builtin_amdgcn_s_waitcnt(0);
        unsigned nloc = b.st[0], nx = b.st[1];
        if (nloc == 0u) { xcd_barrier_complete(bar, b.x, nloc, nx); b.st[0] = nloc; b.st[1] = nx; }
        const unsigned old = xb_add(&bar[XB_XSUB(b.x)], 1u);
        const unsigned gen = old / nloc;
        if (old + 1u == (gen + 1u) * nloc) {
            __builtin_amdgcn_fence(__ATOMIC_RELEASE, "agent");
            asm volatile("s_waitcnt vmcnt(0)" ::: "memory");
            const unsigned og = xb_add(&bar[XB_TOP], 1u);
            const unsigned tg = og / nx;
            if (og + 1u == (tg + 1u) * nx) xb_add(&bar[XB_TOPGEN], 1u);
            else XB_SPIN(xb_ld(&bar[XB_TOPGEN]) == tg, bar);
            __builtin_amdgcn_fence(__ATOMIC_ACQUIRE, "agent");
            xb_add(&bar[XB_XGEN(b.x)], 1u);
            asm volatile("s_waitcnt vmcnt(0)" ::: "memory");
        } else {
            XB_SPIN(xb_ld(&bar[XB_XGEN(b.x)]) == gen, bar);
            __builtin_amdgcn_fence(__ATOMIC_ACQUIRE, "agent");
            asm volatile("s_waitcnt vmcnt(0)" ::: "memory");
        }
    }
    __syncthreads();
}

__global__ void __launch_bounds__(NWAVES * 64, 2) hymba_fwd(Args args) {
    extern __shared__ __attribute__((aligned(16))) unsigned char lds[];
    cg::grid_group grid = cg::this_grid();
    LAS unsigned char* ldsl = (LAS unsigned char*)lds;
    const int tid = threadIdx.x, lane = tid & 63, wave = __builtin_amdgcn_readfirstlane(tid >> 6);
    const int G = gridDim.x, gw = blockIdx.x * NWAVES + wave, NGW = G * NWAVES;
    unsigned char* ws = args.ws;
    const int lo = args.ph_lo, hi = args.ph_hi;
    if (tid < 32) ((volatile LAS unsigned*)(ldsl + MISC_OFF))[tid] = 0u;
    __syncthreads();
    const XcdBarrier xbar = xcd_barrier_post((unsigned*)(ws + WS_CTL), (volatile LAS unsigned*)(ldsl + MISC_OFF) + 8);
#define IN(k) (lo <= (k) && (k) < hi)
#define SEAM(k) do { if (IN(k) && IN((k) + 1)) { if ((k) == 0) grid.sync(); else xcd_barrier(xbar); } } while (0)
    typedef pg8::EpiBf16<0> E0; typedef pg8::EpiBf16<2> E2;
    if (IN(0)) { p0_prologue(args, ldsl, gw, NGW, wave, lane); }
    SEAM(0);
#ifndef NO_G1
    if (IN(1)) { pg8::Gemm g{(const bf16*)(ws + WS_H), (const bf16*)(ws + WS_WIN), NTOK, ZLD, DM}; pg8::StaticOrder S; S.init(NTOK, ZLD, G, (int)blockIdx.x);
        E0 E{(bf16*)(ws + WS_Z), ZLD}; pg8::gemm_phase<E0, pg8::StaticOrder, true, true>(ldsl, g, S, E); }
#endif
    SEAM(1);
    if (IN(2)) {
#ifndef NO_SHIFT
 shift_phase(args, gw, NGW, lane);
#endif
#ifndef NO_CONV
 conv_phase(args, lds, tid, wave, lane);
#endif
 }
    SEAM(2);
    if (IN(3)) {
#ifndef NO_SCAN
 scan_phase(args, lds, wave, lane);
#ifdef PROBE_SCAN2
 __syncthreads(); scan_phase(args, lds, wave, lane);
#endif
#endif
 }
    SEAM(3);
    if (IN(4)) {
#ifndef NO_POST
 post_phase(args, wave, lane);
#endif
 }
    SEAM(4);
#ifndef NO_G5
    if (IN(5)) { pg8::Gemm g{(const bf16*)(ws + WS_H), (const bf16*)(ws + WS_WOUT), NTOK, DM, DM}; pg8::StaticOrder S; S.init(NTOK, DM, G, (int)blockIdx.x);
        E0 E{(bf16*)(ws + WS_MIX), DM}; pg8::gemm_phase<E0, pg8::StaticOrder, true, true>(ldsl, g, S, E); }
#endif
    SEAM(5);
    if (IN(6)) { mid_rows(args, gw, NGW, lane); }
    SEAM(6);
#ifndef NO_G7
    if (IN(7)) {
#pragma unroll
        for (int s = 0; s < 3; ++s) {
            { pg8::Gemm g{(const bf16*)(ws + WS_H) + (size_t)s * SEQ * DM, (const bf16*)(ws + WS_WUP), SEQ, DFF, DM}; pg8::StaticOrder S; S.init(SEQ, DFF, G, (int)blockIdx.x);
              E2 E{(bf16*)(ws + WS_U), DFF}; pg8::gemm_phase<E2, pg8::StaticOrder, true, true>(ldsl, g, S, E); }
            xcd_barrier(xbar);
            { pg8::Gemm g{(const bf16*)(ws + WS_U), (const bf16*)(ws + WS_WDN), SEQ, DM, DFF}; pg8::StaticOrder S; S.init(SEQ, DM, G, (int)blockIdx.x);
              E0 E{(bf16*)(ws + WS_FF) + (size_t)s * SEQ * DM, DM}; pg8::gemm_phase<E0, pg8::StaticOrder, true, true>(ldsl, g, S, E); }
            if (s < 2) xcd_barrier(xbar);
        }
    }
#endif
    SEAM(7);
    if (IN(8)) { final_rows(args, gw, NGW, lane); }
#undef IN
#undef SEAM
}

extern "C" void kernel_launch(void* const* d_in, const int* in_sizes, int n_in, void* d_out, int out_size, void* d_ws, size_t ws_size, hipStream_t stream) {
    static int grid = 0;
    if (grid == 0) {
        if (n_in != 30 || ws_size < WS_END) { fprintf(stderr, "kernel_launch: unexpected n_in %d / ws %zu\n", n_in, ws_size); grid = -1; return; }
        int dev = 0, cus = 0, per_cu = 0;
        hipGetDevice(&dev); hipDeviceGetAttribute(&cus, hipDeviceAttributeMultiprocessorCount, dev);
        if (hipFuncSetAttribute((const void*)hymba_fwd, hipFuncAttributeMaxDynamicSharedMemorySize, LDS_BYTES) != hipSuccess) { fprintf(stderr, "kernel_launch: hipFuncSetAttribute failed\n"); grid = -1; return; }
        hipOccupancyMaxActiveBlocksPerMultiprocessor(&per_cu, (const void*)hymba_fwd, NWAVES * 64, LDS_BYTES);
        (void)hipGetLastError();
        if (per_cu < 1) per_cu = 1;
        grid = cus * 1;
        if (grid < 192) { fprintf(stderr, "kernel_launch: grid %d too small\n", grid); grid = -1; return; }
    }
    if (grid < 0) return;
    if (hipMemsetAsync((char*)d_ws + WS_CTL, 0, CTL_BYTES, stream) != hipSuccess) { fprintf(stderr, "kernel_launch: memset failed\n"); return; }
    Args a{};
    for (int i = 0; i < 30; ++i) a.in[i] = (const float*)d_in[i];
    a.out = (float*)d_out; a.ws = (unsigned char*)d_ws;
#ifndef N_LAUNCH_SPLIT
    a.ph_lo = 0; a.ph_hi = 9;
    void* kargs[] = {&a};
    hipError_t e = hipLaunchCooperativeKernel((const void*)hymba_fwd, dim3(grid), dim3(NWAVES * 64), kargs, LDS_BYTES, stream);
    if (e != hipSuccess) fprintf(stderr, "cooperative launch failed: %s (grid %d)\n", hipGetErrorString(e), grid);
#else
    for (int p = 0; p < 9; ++p) { a.ph_lo = p; a.ph_hi = p + 1; void* kargs[] = {&a};
        hipError_t e = hipLaunchCooperativeKernel((const void*)hymba_fwd, dim3(grid), dim3(NWAVES * 64), kargs, LDS_BYTES, stream);
        if (e != hipSuccess) fprintf(stderr, "cooperative launch %d failed: %s (grid %d)\n", p, hipGetErrorString(e), grid); }
#endif
}
```

```cpp
#include <hip/hip_runtime.h>
#include <hip/hip_cooperative_groups.h>
#include <cstdio>
#include <cstdint>
namespace cg = cooperative_groups;
namespace pg8 {
#define PG8_LAS __attribute__((address_space(3)))
typedef unsigned short bf16_t;
typedef short bf16x8 __attribute__((ext_vector_type(8)));
typedef float f32x4 __attribute__((ext_vector_type(4)));
typedef unsigned u32x4 __attribute__((ext_vector_type(4)));
constexpr int BM = 256, BK = 64, HALF = 128, HTB = HALF * BK * 2  , STAGE_BYTES = 8 * HTB, NXCD = 8, WGM = 8;

__host__ __device__ __forceinline__ int lds_byte(int r, int c) { const int st = (r >> 4) * 2 + (c >> 5), rr = r & 15, cc = c & 31, ob = rr * 64 + cc * 2; return st * 1024 + (ob ^ (((ob >> 9) & 1) << 5)); }
__host__ __device__ __forceinline__ void stage_rc(int b, int& R, int& C) { const int st = b / 1024, sb = b % 1024, swz = sb ^ (((sb >> 9) & 1) << 5); R = (st >> 1) * 16 + swz / 64; C = (st & 1) * 32 + (swz % 64) / 2; }
__host__ __device__ __forceinline__ int perm32(int rho) { const int n = rho >> 4, i = rho & 15; return 8 * (i >> 2) + 4 * n + (i & 3); }

struct Unit { int pm, pn; };
struct Gemm { const bf16_t* A; const bf16_t* Bt; int M, N, K; };

struct StaticOrder {
    int nM, nN, nwg, G, c;
    __host__ __device__ void init(int M, int N, int G_, int c_) { nM = M / BM; nN = N / BM; nwg = nM * nN; G = G_; c = c_; }
    __host__ __device__ bool next(int i, Unit& u) const {
        const long L = (long)i * G + c; if (L >= nwg) return false;
        int wgid = (int)L; { const int q = nwg / NXCD, r = nwg % NXCD, xcd = wgid % NXCD, off = wgid / NXCD; wgid = (xcd < r ? xcd * (q + 1) : r * (q + 1) + (xcd - r) * q) + off; }
        const int nig = WGM * nN, gid = wgid / nig, fm = gid * WGM, gsz = (nM - fm) < WGM ? (nM - fm) : WGM;
        u.pm = fm + ((wgid % nig) % gsz); u.pn = (wgid % nig) / gsz; return true;
    }
    __device__ __forceinline__ void a_ready(const Unit&) const {}
    __device__ __forceinline__ void done(const Unit&) const {}
};

__device__ __forceinline__ unsigned cvt_pk_bf16(float lo, float hi) { unsigned r; asm volatile("v_cvt_pk_bf16_f32 %0, %1, %2" : "=v"(r) : "v"(lo), "v"(hi)); return r; }
typedef float f32x2 __attribute__((ext_vector_type(2)));
template <int ACT> struct EpiBf16 {
    static constexpr bool PERM = true, AFTER_DRAIN = false;
    bf16_t* O; int ldc;
    __device__ __forceinline__ void operator()(const f32x4 (&acc)[2][2][4][2], const Unit& u, int wr, int wc, int fr, int fq) const {
        const int row0 = u.pm * BM + wr * 64 + fr; const int col0 = u.pn * BM + wc * 32 + 8 * fq;
#pragma unroll
        for (int ai = 0; ai < 2; ++ai)
#pragma unroll
            for (int m = 0; m < 4; ++m) { bf16_t* rowp = O + (size_t)(row0 + ai * HALF + m * 16) * ldc + col0;
#pragma unroll
                for (int bj = 0; bj < 2; ++bj) { f32x4 v0 = acc[ai][bj][m][0], v1 = acc[ai][bj][m][1];
                    if (ACT == 2) { const f32x4 z = (f32x4){0.f, 0.f, 0.f, 0.f}; v0 = __builtin_elementwise_max(v0, z); v1 = __builtin_elementwise_max(v1, z); v0 = v0 * v0; v1 = v1 * v1; }
                    u32x4 w; w.x = cvt_pk_bf16(v0[0], v0[1]); w.y = cvt_pk_bf16(v0[2], v0[3]); w.z = cvt_pk_bf16(v1[0], v1[1]); w.w = cvt_pk_bf16(v1[2], v1[3]);
                    *(u32x4*)(rowp + bj * HALF) = w; } }
    }
};


struct EpiZ {
    static constexpr bool PERM = true, AFTER_DRAIN = false;
    bf16_t* ZM; bf16_t* ZC;
    __device__ __forceinline__ void operator()(const f32x4 (&acc)[2][2][4][2], const Unit& u, int wr, int wc, int fr, int fq) const {
        const int pn = u.pn; bf16_t* O; int ldc, colt;
        if (pn < 12) { O = ZM; ldc = 3584; colt = pn * BM; } else if (pn < 20) { O = ZC; ldc = 2048; colt = (pn - 12) * BM; } else { O = ZM; ldc = 3584; colt = 3072 + (pn - 20) * BM; }
        const int row0 = u.pm * BM + wr * 64 + fr; const int col0 = colt + wc * 32 + 8 * fq;
#pragma unroll
        for (int ai = 0; ai < 2; ++ai)
#pragma unroll
            for (int m = 0; m < 4; ++m) { bf16_t* rowp = O + (size_t)(row0 + ai * HALF + m * 16) * ldc + col0;
#pragma unroll
                for (int bj = 0; bj < 2; ++bj) { const f32x4 v0 = acc[ai][bj][m][0], v1 = acc[ai][bj][m][1];
                    u32x4 w; w.x = cvt_pk_bf16(v0[0], v0[1]); w.y = cvt_pk_bf16(v0[2], v0[3]); w.z = cvt_pk_bf16(v1[0], v1[1]); w.w = cvt_pk_bf16(v1[2], v1[3]);
                    *(u32x4*)(rowp + bj * HALF) = w; } }
    }
};

template <class Epi, class Sched, bool ALIGN_EPI = false, bool SP2 = false>
__device__ __forceinline__ void gemm_phase(PG8_LAS unsigned char* lds, const Gemm g, const Sched& S, const Epi& E) {
    const int tid = threadIdx.x, wid = __builtin_amdgcn_readfirstlane(tid >> 6), lane = tid & 63, wr = wid >> 2, wc = wid & 3, fr = lane & 15, fq = lane >> 4;
    const int K = g.K, nt = K / BK;
    unsigned voffA[2], voffB[2];
#pragma unroll
    for (int i = 0; i < 2; ++i) { int R, C; stage_rc(tid * 16 + i * 8192, R, C); const int Rb = Epi::PERM ? ((R & ~31) + perm32(R & 31)) : R;
        voffA[i] = (unsigned)(R * K + C) * 2u; voffB[i] = (unsigned)(Rb * K + C) * 2u; }
    const size_t kstep = (size_t)(BK * 2);
    const size_t hstep = (size_t)HALF * K * 2;
    const size_t tstep = 2 * hstep;
    const unsigned ldsw = (unsigned)wid * 1024u;
    const int aoff = lds_byte(wr * 64 + fr, fq * 8), boff = lds_byte(wc * 32 + fr, fq * 8);
#define PG8_SA(b, h) (((b) * 2 + (h)) * HTB)
#define PG8_SB(b, h) ((4 + (b) * 2 + (h)) * HTB)
#define PG8_STAGE(bufoff, gbase, voff) do { _Pragma("unroll") for (int _i = 0; _i < 2; ++_i) \
        __builtin_amdgcn_global_load_lds((const unsigned*)((const char*)(gbase) + (voff)[_i]), (PG8_LAS unsigned*)(lds + (bufoff) + ldsw + _i * 8192), 16, 0, 0); } while (0)
#define PG8_LDA(dst, b, h) do { _Pragma("unroll") for (int m = 0; m < 4; ++m) _Pragma("unroll") for (int k = 0; k < 2; ++k) dst[m][k] = *(const PG8_LAS bf16x8*)(lds + PG8_SA(b, h) + aoff + m * 2048 + k * 1024); } while (0)
#define PG8_LDB(dst, b, h) do { _Pragma("unroll") for (int n = 0; n < 2; ++n) _Pragma("unroll") for (int k = 0; k < 2; ++k) dst[n][k] = *(const PG8_LAS bf16x8*)(lds + PG8_SB(b, h) + boff + n * 2048 + k * 1024); } while (0)
#define PG8_MMA(ai, bj, At, Bt) do { __builtin_amdgcn_s_setprio(1); _Pragma("unroll") for (int m = 0; m < 4; ++m) _Pragma("unroll") for (int n = 0; n < 2; ++n) _Pragma("unroll") for (int k = 0; k < 2; ++k) \
        acc[ai][bj][m][n] = __builtin_amdgcn_mfma_f32_16x16x32_bf16(Bt[n][k], At[m][k], acc[ai][bj][m][n], 0, 0, 0); __builtin_amdgcn_s_setprio(0); } while (0)
#define PG8_WAIT_V(n) asm volatile("s_waitcnt vmcnt(" #n ")" ::: "memory")
#define PG8_WAIT_L(n) asm volatile("s_waitcnt lgkmcnt(" #n ")" ::: "memory")
#define PG8_BAR __builtin_amdgcn_s_barrier()
#define PG8_SCHED __builtin_amdgcn_sched_barrier(0)
    Unit cur, nxt; int ui = 0;
    if (!S.next(0, cur)) return;
    f32x4 acc[2][2][4][2];
#pragma unroll
    for (int a = 0; a < 2; ++a)
#pragma unroll
        for (int b = 0; b < 2; ++b)
#pragma unroll
            for (int m = 0; m < 4; ++m)
#pragma unroll
                for (int n = 0; n < 2; ++n) acc[a][b][m][n] = (f32x4){0.f, 0.f, 0.f, 0.f};
    bf16x8 At[4][2], B0[2][2], B1[2][2];
    const char* cA = (const char*)g.A + (size_t)cur.pm * tstep; const char* cB = (const char*)g.Bt + (size_t)cur.pn * tstep;
    S.a_ready(cur);
    if constexpr (SP2) {
        PG8_STAGE(PG8_SB(0, 0), cB, voffB); PG8_STAGE(PG8_SB(0, 1), cB + hstep, voffB); PG8_STAGE(PG8_SA(0, 0), cA, voffA); PG8_STAGE(PG8_SA(0, 1), cA + hstep, voffA);
        if (wr == 1) PG8_BAR;
        PG8_WAIT_V(2); PG8_BAR;
        PG8_STAGE(PG8_SB(1, 0), cB + kstep, voffB); PG8_STAGE(PG8_SA(1, 0), cA + kstep, voffA); PG8_STAGE(PG8_SB(1, 1), cB + hstep + kstep, voffB);
        PG8_WAIT_V(6); PG8_BAR;
    } else {
        PG8_STAGE(PG8_SB(0, 0), cB, voffB); PG8_STAGE(PG8_SA(0, 0), cA, voffA); PG8_STAGE(PG8_SB(0, 1), cB + hstep, voffB); PG8_STAGE(PG8_SA(0, 1), cA + hstep, voffA);
        if (wr == 1) PG8_BAR;
        PG8_WAIT_V(4); PG8_BAR;
        PG8_STAGE(PG8_SB(1, 0), cB + kstep, voffB); PG8_STAGE(PG8_SA(1, 0), cA + kstep, voffA); PG8_STAGE(PG8_SB(1, 1), cB + hstep + kstep, voffB);
        PG8_WAIT_V(6); PG8_BAR;
    }
    for (;;) {
        const bool has_next = S.next(ui + 1, nxt);
        const char* nA = has_next ? (const char*)g.A + (size_t)nxt.pm * tstep : cA; const char* nB = has_next ? (const char*)g.Bt + (size_t)nxt.pn * tstep : cB;
        for (int t = 0; t < nt; t += 2) {
            const bool last = (t == nt - 2);
            const char* a1 = cA + (size_t)(t + 1) * kstep;
            const char* a2 = last ? nA : cA + (size_t)(t + 2) * kstep; const char* b2 = last ? nB : cB + (size_t)(t + 2) * kstep;
            const char* a3 = a2 + kstep; const char* b3 = b2 + kstep;
            if (last && has_next) S.a_ready(nxt);
            if constexpr (SP2) {
            PG8_LDB(B0, 0, 0); PG8_LDB(B1, 0, 1); PG8_SCHED; PG8_LDA(At, 0, 0); PG8_STAGE(PG8_SA(1, 1), a1 + hstep, voffA);
            PG8_WAIT_V(8); PG8_WAIT_L(0); PG8_BAR; PG8_MMA(0, 0, At, B0); PG8_MMA(0, 1, At, B1); PG8_BAR; PG8_SCHED;
            PG8_LDA(At, 0, 1); PG8_STAGE(PG8_SB(0, 0), b2, voffB); PG8_STAGE(PG8_SB(0, 1), b2 + hstep, voffB); PG8_STAGE(PG8_SA(0, 0), a2, voffA);
            PG8_WAIT_V(8); PG8_WAIT_L(0); PG8_BAR; PG8_MMA(1, 0, At, B0); PG8_MMA(1, 1, At, B1); PG8_BAR; PG8_SCHED;
            PG8_LDB(B0, 1, 0); PG8_LDB(B1, 1, 1); PG8_SCHED; PG8_LDA(At, 1, 0); PG8_STAGE(PG8_SA(0, 1), a2 + hstep, voffA);
            PG8_WAIT_V(8); PG8_WAIT_L(0); PG8_BAR; PG8_MMA(0, 0, At, B0); PG8_MMA(0, 1, At, B1); PG8_BAR; PG8_SCHED;
            PG8_LDA(At, 1, 1); PG8_STAGE(PG8_SB(1, 0), b3, voffB); PG8_STAGE(PG8_SB(1, 1), b3 + hstep, voffB); PG8_STAGE(PG8_SA(1, 0), a3, voffA);
            PG8_WAIT_V(8); PG8_WAIT_L(0); PG8_BAR; PG8_MMA(1, 0, At, B0); PG8_MMA(1, 1, At, B1); PG8_BAR; PG8_SCHED;
            } else {
            PG8_LDB(B0, 0, 0); PG8_SCHED; PG8_LDA(At, 0, 0); PG8_STAGE(PG8_SA(1, 1), a1 + hstep, voffA);
            PG8_WAIT_L(8); PG8_BAR; PG8_WAIT_L(0); PG8_MMA(0, 0, At, B0); PG8_BAR; PG8_SCHED;
            PG8_LDB(B1, 0, 1); PG8_STAGE(PG8_SB(0, 0), b2, voffB);
            PG8_BAR; PG8_WAIT_L(0); PG8_MMA(0, 1, At, B1); PG8_BAR;
            PG8_LDA(At, 0, 1); PG8_STAGE(PG8_SA(0, 0), a2, voffA);
            PG8_BAR; PG8_WAIT_L(0); PG8_MMA(1, 0, At, B0); PG8_BAR; PG8_SCHED;
            PG8_STAGE(PG8_SB(0, 1), b2 + hstep, voffB);
            PG8_WAIT_V(6); PG8_BAR; PG8_MMA(1, 1, At, B1); PG8_BAR;
            PG8_LDB(B0, 1, 0); PG8_SCHED; PG8_LDA(At, 1, 0); PG8_STAGE(PG8_SA(0, 1), a2 + hstep, voffA);
            PG8_WAIT_L(8); PG8_BAR; PG8_WAIT_L(0); PG8_MMA(0, 0, At, B0); PG8_BAR; PG8_SCHED;
            PG8_LDB(B1, 1, 1); PG8_STAGE(PG8_SB(1, 0), b3, voffB);
            PG8_BAR; PG8_WAIT_L(0); PG8_MMA(0, 1, At, B1); PG8_BAR;
            PG8_LDA(At, 1, 1); PG8_STAGE(PG8_SA(1, 0), a3, voffA);
            PG8_BAR; PG8_WAIT_L(0); PG8_MMA(1, 0, At, B0); PG8_BAR; PG8_SCHED;
            PG8_STAGE(PG8_SB(1, 1), b3 + hstep, voffB);
            PG8_WAIT_V(6); PG8_BAR; PG8_MMA(1, 1, At, B1); PG8_BAR;
            }
        }
        if constexpr (ALIGN_EPI) { if (wr == 0) PG8_BAR; }
        if constexpr (!Epi::AFTER_DRAIN) { E(acc, cur, wr, wc, fr, fq); S.done(cur); }
        if (!has_next) break;
#pragma unroll
        for (int a = 0; a < 2; ++a)
#pragma unroll
            for (int b = 0; b < 2; ++b)
#pragma unroll
                for (int m = 0; m < 4; ++m)
#pragma unroll
                    for (int n = 0; n < 2; ++n) acc[a][b][m][n] = (f32x4){0.f, 0.f, 0.f, 0.f};
        cur = nxt; cA = nA; cB = nB; ++ui;
        if constexpr (ALIGN_EPI) { if (wr == 1) PG8_BAR; }
    }
    PG8_WAIT_V(0);
    if constexpr (!ALIGN_EPI) { if (wr == 0) PG8_BAR; }
    PG8_BAR;
    if constexpr (Epi::AFTER_DRAIN) { E.fused(acc, cur, wr, wc, fr, fq, lds, wid, lane); S.done(cur); }
#undef PG8_SA
#undef PG8_SB
#undef PG8_STAGE
#undef PG8_LDA
#undef PG8_LDB
#undef PG8_MMA
#undef PG8_WAIT_V
#undef PG8_WAIT_L
#undef PG8_BAR
#undef PG8_SCHED
}
}

#define GAS __attribute__((address_space(1)))
#define LAS __attribute__((address_space(3)))
typedef unsigned short bf16;
typedef unsigned v4u __attribute__((ext_vector_type(4)));
typedef unsigned v2u __attribute__((ext_vector_type(2)));
typedef float f32x4 __attribute__((ext_vector_type(4)));
typedef float f32x2 __attribute__((ext_vector_type(2)));
typedef short bf16x8 __attribute__((ext_vector_type(8)));
typedef _Float16 h2 __attribute__((ext_vector_type(2)));
#define LDS_WAIT() asm volatile("s_waitcnt lgkmcnt(0)" ::: "memory")

constexpr int NWAVES = 8;
constexpr int NTOK = 24576, SEQ = 8192, DM = 2048, DR = 1024, DFF = 8192;
constexpr int ZLD = 5632, ZC_CA = 3072, ZC_CB = 4096, ZC_L = 5120;
constexpr int ZMLD = 3584, ZM_L = 3072, ZCLD = 2048;
constexpr size_t MiB = 1u << 20;
constexpr size_t WS_WIN = 0, WS_WOUT = 22 * MiB, WS_WUP = 30 * MiB, WS_WDN = 62 * MiB, WS_SMALL = 94 * MiB, WS_XL = 95 * MiB, WS_XG = 107 * MiB,
                 WS_BONUS = 115 * MiB, WS_H = 118 * MiB, WS_ZC = 214 * MiB, WS_ZM = 310 * MiB, WS_END = 502 * MiB;
constexpr size_t SM_G2T = 0, SM_W2TF = 384 * 1024, SM_W2TB = 512 * 1024, SM_A2TF = 640 * 1024, SM_A2TB = 768 * 1024;
constexpr size_t WS_YF = WS_ZM, WS_YB = WS_ZM + 96 * MiB, WS_MIX = WS_ZC, WS_U = WS_ZC, WS_FF = WS_ZC + 128 * MiB;
constexpr size_t OUT_RS = 0, OUT_KS = 48 * MiB, OUT_VS = 96 * MiB, OUT_KK = 144 * MiB;
constexpr int LDS_BYTES = 147456, MISC_OFF = 131072 + 320;
constexpr size_t WS_CTL = 117 * MiB, CTL_BYTES = 16384;

struct Args { const float* in[30]; float* out; unsigned char* ws; int ph_lo, ph_hi; };

__device__ __forceinline__ float lo2f(unsigned u) { return __uint_as_float(u << 16); }
__device__ __forceinline__ float hi2f(unsigned u) { return __uint_as_float(u & 0xffff0000u); }
__device__ __forceinline__ unsigned f2bf(float f) { unsigned u = __float_as_uint(f); return (u + 0x7fffu + ((u >> 16) & 1u)) >> 16; }
__device__ __forceinline__ unsigned pk2(float lo, float hi) { unsigned r; asm volatile("v_cvt_pk_bf16_f32 %0, %1, %2" : "=v"(r) : "v"(lo), "v"(hi)); return r; }
__device__ __forceinline__ float fsigmoid(float x) { return __builtin_amdgcn_rcpf(1.f + __builtin_amdgcn_exp2f(-1.44269504f * x)); }
__device__ __forceinline__ float ftanh(float x) { return 1.f - 2.f * __builtin_amdgcn_rcpf(1.f + __builtin_amdgcn_exp2f(2.88539008f * x)); }
__device__ __forceinline__ float wave_sum(float v) {
#pragma unroll
    for (int o = 1; o < 64; o <<= 1) v += __shfl_xor(v, o);
    return v;
}
template <int CTRL> __device__ __forceinline__ float dppf(float x) { return __int_as_float(__builtin_amdgcn_update_dpp(0, __float_as_int(x), CTRL, 0xF, 0xF, true)); }
__device__ __forceinline__ float red8(float x) { x += dppf<0xB1>(x); x += dppf<0x4E>(x); x += dppf<0x141>(x); return x; }
__device__ __forceinline__ const float* xrow(const Args& a, int m) { return m < 16384 ? a.in[0] + (size_t)m * DM : a.in[1] + (size_t)(m - 16384) * DM; }

__device__ __forceinline__ void tr_item(const float* W, int ldw, int k0, int sc0, bf16* WT, int ldt, int dr0, LAS float* scr, int lane) {
#pragma unroll 8
    for (int i = 0; i < 32; ++i) { const int kk = 2 * i + (lane >> 5); scr[kk * 33 + (lane & 31)] = W[(size_t)(k0 + kk) * ldw + sc0 + (lane & 31)]; }
    LDS_WAIT(); asm volatile("" ::: "memory");
    const int c = lane & 7;
#pragma unroll
    for (int j = 0; j < 4; ++j) { const int n = (lane >> 3) + 8 * j; const LAS float* s = scr + (8 * c) * 33 + n;
        v4u o; o.x = pk2(s[0 * 33], s[1 * 33]); o.y = pk2(s[2 * 33], s[3 * 33]); o.z = pk2(s[4 * 33], s[5 * 33]); o.w = pk2(s[6 * 33], s[7 * 33]);
        *(v4u*)(WT + (size_t)(dr0 + n) * ldt + k0 + 8 * c) = o; }
    LDS_WAIT(); asm volatile("" ::: "memory");
}
__device__ __forceinline__ void rms_row_bf16(const float* xr_, const float* g, bf16* orow, int lane) {
    const f32x4* xr = (const f32x4*)xr_ + lane; const f32x4* gr = (const f32x4*)g + lane;
    f32x4 v[8]; float s = 0.f;
#pragma unroll
    for (int j = 0; j < 8; ++j) { v[j] = xr[64 * j]; s += (v[j].x * v[j].x + v[j].y * v[j].y) + (v[j].z * v[j].z + v[j].w * v[j].w); }
    const float rstd = 1.f / sqrtf(wave_sum(s) * (1.f / DM) + 1e-6f);
    v2u* o8 = (v2u*)orow + lane;
#pragma unroll
    for (int j = 0; j < 8; ++j) { const f32x4 gg = gr[64 * j]; v2u o; o.x = pk2(v[j].x * rstd * gg.x, v[j].y * rstd * gg.y); o.y = pk2(v[j].z * rstd * gg.z, v[j].w * rstd * gg.w); o8[64 * j] = o; }
}
__device__ __forceinline__ void p0_prologue(const Args& a, LAS unsigned char* lds, int gw, int NGW, int wave, int lane) {
    unsigned char* ws = a.ws;
    LAS float* scr = (LAS float*)(lds + wave * 16384);
    bf16* WIN = (bf16*)(ws + WS_WIN); bf16* WOUT = (bf16*)(ws + WS_WOUT);
    constexpr int I_IN = 32 * 173, I_OUT = 32 * 64, I_S = 32;
    constexpr int NITEMS = I_IN + I_OUT + 4 * I_S;
    for (int it = gw; it < NITEMS; it += NGW) {
        int r = it;
        if (r < I_IN) { const int kb = r / 173, nb = r % 173, sc0 = nb * 32; const int dr0 = sc0 < 3072 ? sc0 : (sc0 < 3488 ? ZC_L + (sc0 - 3072) : ZC_CA + (sc0 - 3488));
            tr_item(a.in[3], 5536, kb * 64, sc0, WIN, DM, dr0, scr, lane); continue; } r -= I_IN;
        if (r < I_OUT) { tr_item(a.in[24], DM, (r / 64) * 64, (r % 64) * 32, WOUT, DM, (r % 64) * 32, scr, lane); continue; } r -= I_OUT;
        { const int which = r / I_S, nb = r % I_S; const float* src = which == 0 ? a.in[7] : which == 1 ? a.in[9] : which == 2 ? a.in[11] : a.in[13];
          bf16* dst = (bf16*)(ws + WS_SMALL + (which == 0 ? SM_W2TF : which == 1 ? SM_W2TB : which == 2 ? SM_A2TF : SM_A2TB));
          tr_item(src, DR, 0, nb * 32, dst, 64, nb * 32, scr, lane); }
    }
    { const int gt = gw * 64 + lane, NGT = NGW * 64;
      v4u zz = {0u, 0u, 0u, 0u}; v4u* zp = (v4u*)(WIN + (size_t)5536 * DM);
      for (int i = gt; i < 96 * DM / 8; i += NGT) zp[i] = zz;
      bf16* G2T = (bf16*)(ws + WS_SMALL + SM_G2T); const float* g2 = a.in[14];
      for (int i = gt; i < 160 * 1024; i += NGT) { const int k = i >> 10, n = i & 1023; G2T[n * 160 + k] = (bf16)f2bf(g2[i]); } }
    bf16* H = (bf16*)(ws + WS_H);
    for (int m = gw; m < NTOK; m += NGW) rms_row_bf16(xrow(a, m), a.in[2], H + (size_t)m * DM, lane);
}
__device__ __forceinline__ void p0_mlp_weights(const Args& a, LAS unsigned char* lds, int gw, int NGW, int wave, int lane) {
    unsigned char* ws = a.ws;
    LAS float* scr = (LAS float*)(lds + wave * 16384);
    bf16* WUP = (bf16*)(ws + WS_WUP); bf16* WDN = (bf16*)(ws + WS_WDN);
    constexpr int I_UP = 32 * 256, I_DN = 128 * 64;
    for (int it = gw; it < I_UP + I_DN; it += NGW) {
        int r = it;
        if (r < I_UP) { tr_item(a.in[27], DFF, (r / 256) * 64, (r % 256) * 32, WUP, DM, (r % 256) * 32, scr, lane); continue; } r -= I_UP;
        tr_item(a.in[28], DM, (r / 64) * 64, (r % 64) * 32, WDN, DFF, (r % 64) * 32, scr, lane);
    }
}

__device__ __forceinline__ void shift_phase(const Args& a, int gw, int NGW, int lane) {
    unsigned char* ws = a.ws;
    const bf16* Z = (const bf16*)(ws + WS_ZM);
    bf16* RS = (bf16*)((unsigned char*)a.out + OUT_RS); bf16* KS = (bf16*)((unsigned char*)a.out + OUT_KS);
    bf16* VS = (bf16*)((unsigned char*)a.out + OUT_VS); bf16* KK = (bf16*)((unsigned char*)a.out + OUT_KK);
    bf16* XL = (bf16*)(ws + WS_XL); bf16* XG = (bf16*)(ws + WS_XG); float* BONUS = (float*)(ws + WS_BONUS);
    const float* mup = a.in[4]; const float* mun = a.in[5]; const float* k_k = a.in[15]; const float* r_k = a.in[17];
    const int hp2 = lane >> 5, n2 = (lane & 31) * 2;
    for (int m = gw; m < NTOK; m += NGW) {
        const int t = m & (SEQ - 1); const bool hp = t > 0, hn = t < SEQ - 1;
        const bf16* z0 = Z + (size_t)m * ZMLD; const bf16* zp = z0 - ZMLD; const bf16* zn = z0 + ZMLD;
#pragma unroll 2
        for (int hh = 0; hh < 8; ++hh) {
            const int c = (hh * 2 + hp2) * 64 + n2;
            float s[3][2];
#pragma unroll
            for (int ar = 0; ar < 3; ++ar) { const int col = ar * 1024 + c;
                const unsigned zc = *(const unsigned*)(z0 + col); const unsigned zpv = hp ? *(const unsigned*)(zp + col) : 0u; const unsigned znv = hn ? *(const unsigned*)(zn + col) : 0u;
                const f32x2 mp = *(const f32x2*)(mup + col), mn = *(const f32x2*)(mun + col);
                const float x0 = lo2f(zc), x1 = hi2f(zc);
                s[ar][0] = x0 + mp.x * (lo2f(zpv) - x0) + mn.x * (lo2f(znv) - x0);
                s[ar][1] = x1 + mp.y * (hi2f(zpv) - x1) + mn.y * (hi2f(znv) - x1); }
            const f32x2 kkw = *(const f32x2*)(k_k + c), rkw = *(const f32x2*)(r_k + c);
            const float kr0 = s[1][0] * kkw.x, kr1 = s[1][1] * kkw.y;
            float ss = kr0 * kr0 + kr1 * kr1, bs = s[0][0] * s[1][0] * rkw.x + s[0][1] * s[1][1] * rkw.y;
#pragma unroll
            for (int o = 1; o < 32; o <<= 1) { ss += __shfl_xor(ss, o); bs += __shfl_xor(bs, o); }
            const float inv = 1.f / fmaxf(sqrtf(ss), 1e-12f);
            const size_t o = (size_t)m * DR + c;
            *(unsigned*)(RS + o) = pk2(s[0][0], s[0][1]); *(unsigned*)(KS + o) = pk2(s[1][0], s[1][1]);
            *(unsigned*)(VS + o) = pk2(s[2][0], s[2][1]); *(unsigned*)(KK + o) = pk2(kr0 * inv, kr1 * inv);
            if ((lane & 31) == 0) BONUS[m * 16 + hh * 2 + hp2] = bs;
        }
#pragma unroll
        for (int p = 0; p < 7; ++p) { const int j = p * 64 + lane;
            if (j < 416) { const int col = ZM_L + j, og = 3072 + j;
                const float x0 = lo2f(z0[col]); const float xp = hp ? lo2f(zp[col]) : 0.f; const float xn = hn ? lo2f(zn[col]) : 0.f;
                const float sv = x0 + mup[og] * (xp - x0) + mun[og] * (xn - x0);
                if (j < 128) XL[(size_t)m * 256 + j] = (bf16)f2bf(ftanh(sv));
                else if (j < 256) XL[(size_t)m * 256 + j] = (bf16)f2bf(sv);
                else XG[(size_t)m * 160 + (j - 256)] = (bf16)f2bf(fsigmoid(sv)); } }
    }
}

#define TR_STAGE(D_, N_) { const bool up_ = (lane & (D_)) != 0; _Pragma("unroll") for (int i_ = 0; i_ < (N_) / 2; ++i_) { \
    const float keep_ = up_ ? vals[i_ + (N_) / 2] : vals[i_]; const float send_ = up_ ? vals[i_] : vals[i_ + (N_) / 2]; vals[i_] = keep_ + __shfl_xor(send_, (D_)); } }
__device__ __forceinline__ void conv_phase(const Args& a, unsigned char* lds, int tid, int wave, int lane, int u0, int ustride) {
    unsigned char* ws = a.ws;
    const bf16* Z = (const bf16*)(ws + WS_ZC); bf16* MIXIN = (bf16*)(ws + WS_H);
    h2* utile = (h2*)lds;
    float* part = (float*)(lds + 126976);
    f32x2* stats = (f32x2*)(lds + 126976 + 2048);
    const float* dw_w = a.in[20]; const float* dw_b = a.in[21]; const float* cln_w = a.in[22]; const float* cln_b = a.in[23];
    const int cp = tid;
    for (int unit = u0; unit < NTOK / 32; unit += ustride) {
        const int m0 = unit * 32, t0 = m0 & (SEQ - 1);
        for (int idx = tid; idx < 62 * 512; idx += 512) { const int row = idx >> 9, c2 = idx & 511; const int t = t0 - 15 + row;
            h2 u = {(_Float16)0.f, (_Float16)0.f};
            if (t >= 0 && t < SEQ) { const bf16* zr = Z + (size_t)(m0 - 15 + row) * ZCLD; const unsigned za = *(const unsigned*)(zr + 2 * c2), zb = *(const unsigned*)(zr + 1024 + 2 * c2);
                u.x = (_Float16)(lo2f(za) * fsigmoid(lo2f(zb))); u.y = (_Float16)(hi2f(za) * fsigmoid(hi2f(zb))); }
            utile[idx] = u; }
        __syncthreads();
        f32x2 w[31];
#pragma unroll
        for (int j = 0; j < 31; ++j) w[j] = *(const f32x2*)(dw_w + j * 1024 + 2 * cp);
        const f32x2 bias = *(const f32x2*)(dw_b + 2 * cp);
        f32x2 out[32];
#pragma unroll
        for (int tb = 0; tb < 4; ++tb) {
            f32x2 acc[8];
#pragma unroll
            for (int o = 0; o < 8; ++o) acc[o] = bias;
#pragma unroll
            for (int jj = 0; jj < 38; ++jj) { const h2 uh = utile[(tb * 8 + jj) * 512 + cp]; const f32x2 u = {(float)uh.x, (float)uh.y};
#pragma unroll
                for (int o = 0; o < 8; ++o) { const int j = jj - o; if (j >= 0 && j < 31) acc[o] = u * w[j] + acc[o]; } }
#pragma unroll
            for (int o = 0; o < 8; ++o) out[tb * 8 + o] = acc[o];
            asm volatile("" ::: "memory");
        }
        float vals[64];
#pragma unroll
        for (int t = 0; t < 32; ++t) { vals[2 * t] = out[t].x + out[t].y; vals[2 * t + 1] = out[t].x * out[t].x + out[t].y * out[t].y; }
        TR_STAGE(32, 64) TR_STAGE(16, 32) TR_STAGE(8, 16) TR_STAGE(4, 8) TR_STAGE(2, 4) TR_STAGE(1, 2)
        part[wave * 64 + lane] = vals[0];
        __syncthreads();
        if (tid < 32) { float s = 0.f, q = 0.f;
#pragma unroll
            for (int wv = 0; wv < 8; ++wv) { s += part[wv * 64 + 2 * tid]; q += part[wv * 64 + 2 * tid + 1]; }
            const float mean = s * (1.f / 1024.f); const float var = q * (1.f / 1024.f) - mean * mean;
            stats[tid] = (f32x2){mean, 1.f / sqrtf(var + 1e-5f)}; }
        __syncthreads();
        const f32x2 lw = *(const f32x2*)(cln_w + 2 * cp), lb = *(const f32x2*)(cln_b + 2 * cp);
#pragma unroll
        for (int t = 0; t < 32; ++t) { const f32x2 st = stats[t];
            const float y0 = (out[t].x - st.x) * st.y * lw.x + lb.x, y1 = (out[t].y - st.x) * st.y * lw.y + lb.y;
            *(unsigned*)(MIXIN + (size_t)(m0 + t) * DM + DR + 2 * cp) = pk2(y0 * fsigmoid(y0), y1 * fsigmoid(y1)); }
        __syncthreads();
    }
}

constexpr int SC_LD = 68, SC_ARR = 32 * SC_LD, SC_ARR4 = SC_ARR / 4, SC_BUF = (5 * SC_ARR + SC_LD) * 4;
struct ScanOps { f32x4 q0, q1, a0, a1, m0, m1, r0, r1; float vv; };
__device__ __forceinline__ void ld_ops(ScanOps& o, const float* cb, int i, int ks, int rr) {
    const f32x4* p = (const f32x4*)(cb + i * SC_LD + ks * 8);
    o.q0 = p[0]; o.q1 = p[1]; o.a0 = p[SC_ARR4]; o.a1 = p[SC_ARR4 + 1]; o.m0 = p[2 * SC_ARR4]; o.m1 = p[2 * SC_ARR4 + 1]; o.r0 = p[3 * SC_ARR4]; o.r1 = p[3 * SC_ARR4 + 1];
    o.vv = cb[4 * SC_ARR + i * SC_LD + rr];
}
__device__ __forceinline__ void scan_phase(const Args& a, unsigned char* lds, int wave, int lane) {
    if (blockIdx.x >= 192) {
        const int wi = blockIdx.x - 192, nw = gridDim.x - 192;
        conv_phase(a, lds, threadIdx.x, wave, lane, wi, nw);
        p0_mlp_weights(a, (LAS unsigned char*)lds, wi * NWAVES + wave, nw * NWAVES, wave, lane);
        return;
    }
    unsigned char* ws = a.ws;
    const int scan = blockIdx.x >> 1, half = blockIdx.x & 1, dir = scan & 1, sh = scan >> 1, seq = sh >> 4, h = sh & 15;
    const size_t row0 = (size_t)seq * SEQ;
    const bf16* RS = (const bf16*)((unsigned char*)a.out + OUT_RS); const bf16* KS = (const bf16*)((unsigned char*)a.out + OUT_KS);
    const bf16* VS = (const bf16*)((unsigned char*)a.out + OUT_VS); const bf16* KK = (const bf16*)((unsigned char*)a.out + OUT_KK);
    const bf16* XL = (const bf16*)(ws + WS_XL);
    float* Y = (float*)(ws + (dir ? WS_YB : WS_YF));
    constexpr int NCH = SEQ / 32;
    const int ks = lane & 7, rr = half * 32 + (wave & 3) * 8 + (lane >> 3);
    f32x2 S0 = {0.f, 0.f}, S1 = S0, S2 = S0, S3 = S0;
    float* ybase = Y + row0 * DR + h * 64 + rr;
    const int pw = wave & 3, fr = lane & 15, fq = lane >> 4, cl = pw * 16 + fq * 4, gcol = h * 64 + cl;
    bf16x8 Bw0, Bw1, Ba0, Ba1; f32x4 w0v, a0v, kav;
    {
        const bf16* W2T = (const bf16*)(ws + WS_SMALL + (dir ? SM_W2TB : SM_W2TF)); const bf16* A2T = (const bf16*)(ws + WS_SMALL + (dir ? SM_A2TB : SM_A2TF));
        const size_t bo = (size_t)(h * 64 + pw * 16 + fr) * 64 + fq * 8;
        Bw0 = *(const bf16x8*)(W2T + bo); Bw1 = *(const bf16x8*)(W2T + bo + 32); Ba0 = *(const bf16x8*)(A2T + bo); Ba1 = *(const bf16x8*)(A2T + bo + 32);
        w0v = *(const f32x4*)((dir ? a.in[8] : a.in[6]) + gcol); a0v = *(const f32x4*)((dir ? a.in[12] : a.in[10]) + gcol); kav = *(const f32x4*)(a.in[16] + gcol);
    }
    for (int c = 0; c <= NCH; ++c) {
        if (wave >= 4) {
            if (c < NCH) {
                float* cb = (float*)(lds + (c & 1) * SC_BUF);
                f32x4 off = {0.f, 0.f, 0.f, 0.f};
#pragma unroll
                for (int mt = 0; mt < 2; ++mt) {
                    const int i = mt * 16 + fr, step = c * 32 + i, t = dir ? (SEQ - 1 - step) : step; const size_t m = row0 + t;
                    const bf16* xl = XL + m * 256 + dir * 64 + fq * 8;
                    const bf16x8 At0 = *(const bf16x8*)(xl), At1 = *(const bf16x8*)(xl + 32), Aa0 = *(const bf16x8*)(xl + 128), Aa1 = *(const bf16x8*)(xl + 160);
                    const size_t go = m * DR + gcol;
                    const v2u r4 = *(const v2u*)(RS + go), k4 = *(const v2u*)(KS + go), v4 = *(const v2u*)(VS + go), q4 = *(const v2u*)(KK + go);
                    f32x4 aw = {0.f, 0.f, 0.f, 0.f}, aa = aw;
                    aw = __builtin_amdgcn_mfma_f32_16x16x32_bf16(Bw0, At0, aw, 0, 0, 0); aw = __builtin_amdgcn_mfma_f32_16x16x32_bf16(Bw1, At1, aw, 0, 0, 0);
                    aa = __builtin_amdgcn_mfma_f32_16x16x32_bf16(Ba0, Aa0, aa, 0, 0, 0); aa = __builtin_amdgcn_mfma_f32_16x16x32_bf16(Ba1, Aa1, aa, 0, 0, 0);
                    const f32x4 rv = {lo2f(r4.x), hi2f(r4.x), lo2f(r4.y), hi2f(r4.y)}, kv = {lo2f(k4.x), hi2f(k4.x), lo2f(k4.y), hi2f(k4.y)};
                    const f32x4 vv = {lo2f(v4.x), hi2f(v4.x), lo2f(v4.y), hi2f(v4.y)}, qv = {lo2f(q4.x), hi2f(q4.x), lo2f(q4.y), hi2f(q4.y)};
                    f32x4 lw, cum, av, pm1, pin, pp;
#pragma unroll
                    for (int j = 0; j < 4; ++j) {
                        lw[j] = -0.87500596f * fsigmoid(w0v[j] + aw[j]); av[j] = fsigmoid(a0v[j] + aa[j]);
                        float x = lw[j]; x += dppf<0x111>(x); x += dppf<0x112>(x); x += dppf<0x114>(x); x += dppf<0x118>(x);
                        cum[j] = x + off[j];
                        pm1[j] = __builtin_amdgcn_exp2f(cum[j] - lw[j]); pin[j] = __builtin_amdgcn_exp2f(-cum[j]); pp[j] = __builtin_amdgcn_exp2f(cum[j]);
                    }
                    if (mt == 0) {
#pragma unroll
                        for (int j = 0; j < 4; ++j) off[j] = __shfl(cum[j], (lane & 48) | 15);
                    }
                    f32x4* dst = (f32x4*)(cb + i * SC_LD + cl);
                    dst[0] = qv * pm1; dst[SC_ARR4] = qv * av * pin; dst[2 * SC_ARR4] = kv * (1.f + (av - 1.f) * kav) * pin; dst[3 * SC_ARR4] = rv * pp; dst[4 * SC_ARR4] = vv;
                    if (i == 31) *(f32x4*)(cb + 5 * SC_ARR + cl) = pp;
                }
            }
        } else if (c > 0) {
            const float* cb = (const float*)(lds + ((c - 1) & 1) * SC_BUF);
            const int cbase = (c - 1) * 32;
            ScanOps o[2]; ld_ops(o[0], cb, 0, ks, rr);
#pragma unroll
            for (int g = 0; g < 4; ++g) {
                float ysel = 0.f;
#pragma unroll
                for (int j = 0; j < 8; ++j) {
                    const int i = g * 8 + j;
                    if (i + 1 < 32) ld_ops(o[(i + 1) & 1], cb, i + 1, ks, rr);
                    const ScanOps& x = o[i & 1];
                    f32x2 acc = S0 * x.q0.xy, acc2 = S1 * x.q0.zw; acc = S2 * x.q1.xy + acc; acc2 = S3 * x.q1.zw + acc2; acc = acc + acc2;
                    const float sa = red8(acc.x + acc.y);
                    const f32x2 sav = {sa, sa}, vv2 = {x.vv, x.vv};
                    S0 = vv2 * x.m0.xy + S0; S1 = vv2 * x.m0.zw + S1; S2 = vv2 * x.m1.xy + S2; S3 = vv2 * x.m1.zw + S3;
                    S0 = S0 - sav * x.a0.xy; S1 = S1 - sav * x.a0.zw; S2 = S2 - sav * x.a1.xy; S3 = S3 - sav * x.a1.zw;
                    f32x2 yq = S0 * x.r0.xy, yq2 = S1 * x.r0.zw; yq = S2 * x.r1.xy + yq; yq2 = S3 * x.r1.zw + yq2; yq = yq + yq2;
                    const float y = red8(yq.x + yq.y);
                    ysel = (ks == j) ? y : ysel;
                }
                const int step = cbase + g * 8 + ks, t = dir ? (SEQ - 1 - step) : step;
                ybase[(size_t)t * DR] = ysel;
            }
            const f32x4* pe = (const f32x4*)(cb + 5 * SC_ARR + ks * 8);
            const f32x4 pe0 = pe[0], pe1 = pe[1];
            S0 = S0 * pe0.xy; S1 = S1 * pe0.zw; S2 = S2 * pe1.xy; S3 = S3 * pe1.zw;
        }
        __syncthreads();
    }
}

__device__ __forceinline__ void post_phase(const Args& a, int wave, int lane) {
    unsigned char* ws = a.ws;
    const bf16* XG = (const bf16*)(ws + WS_XG); const bf16* G2T = (const bf16*)(ws + WS_SMALL + SM_G2T);
    const float* YF = (const float*)(ws + WS_YF); const float* YB = (const float*)(ws + WS_YB); const float* BONUS = (const float*)(ws + WS_BONUS);
    const bf16* VS = (const bf16*)((unsigned char*)a.out + OUT_VS); bf16* MIXIN = (bf16*)(ws + WS_H);
    const float* gn_w = a.in[18]; const float* gn_b = a.in[19];
    const int fr = lane & 15, fq = lane >> 4, n0 = wave * 128;
    for (int unit = blockIdx.x; unit < NTOK / 32; unit += gridDim.x) {
        const int m0 = unit * 32;
        f32x4 acc[2][8];
#pragma unroll
        for (int mt = 0; mt < 2; ++mt)
#pragma unroll
            for (int nt = 0; nt < 8; ++nt) acc[mt][nt] = (f32x4){0.f, 0.f, 0.f, 0.f};
#pragma unroll
        for (int kq = 0; kq < 5; ++kq) {
            bf16x8 A[2];
#pragma unroll
            for (int mt = 0; mt < 2; ++mt) A[mt] = *(const bf16x8*)(XG + (size_t)(m0 + mt * 16 + fr) * 160 + kq * 32 + fq * 8);
#pragma unroll
            for (int nt = 0; nt < 8; ++nt) { const bf16x8 B = *(const bf16x8*)(G2T + (size_t)(n0 + nt * 16 + fr) * 160 + kq * 32 + fq * 8);
#pragma unroll
                for (int mt = 0; mt < 2; ++mt) acc[mt][nt] = __builtin_amdgcn_mfma_f32_16x16x32_bf16(B, A[mt], acc[mt][nt], 0, 0, 0); }
        }
#pragma unroll
        for (int mt = 0; mt < 2; ++mt) { const size_t m = (size_t)(m0 + mt * 16 + fr);
#pragma unroll
            for (int hh = 0; hh < 2; ++hh) { const int hd = wave * 2 + hh;
                f32x4 y[4]; float s = 0.f;
#pragma unroll
                for (int q = 0; q < 4; ++q) { const size_t o = m * DR + n0 + (hh * 4 + q) * 16 + fq * 4; y[q] = *(const f32x4*)(YF + o) + *(const f32x4*)(YB + o); s += (y[q].x + y[q].y) + (y[q].z + y[q].w); }
                s += __shfl_xor(s, 16); s += __shfl_xor(s, 32);
                const float mean = s * (1.f / 64.f); float ss = 0.f;
#pragma unroll
                for (int q = 0; q < 4; ++q) { y[q] = y[q] - mean; ss += (y[q].x * y[q].x + y[q].y * y[q].y) + (y[q].z * y[q].z + y[q].w * y[q].w); }
                ss += __shfl_xor(ss, 16); ss += __shfl_xor(ss, 32);
                const float rstd = 1.f / sqrtf(ss * (1.f / 64.f) + 64e-5f); const float bs = BONUS[m * 16 + hd];
#pragma unroll
                for (int q = 0; q < 4; ++q) { const int c = n0 + (hh * 4 + q) * 16 + fq * 4; const f32x4 gw4 = *(const f32x4*)(gn_w + c), gb4 = *(const f32x4*)(gn_b + c);
                    const v2u v4 = *(const v2u*)(VS + m * DR + c); const f32x4 vv = {lo2f(v4.x), hi2f(v4.x), lo2f(v4.y), hi2f(v4.y)};
                    const f32x4 o = (y[q] * rstd * gw4 + gb4 + bs * vv) * acc[mt][hh * 4 + q];
                    v2u ov; ov.x = pk2(o.x, o.y); ov.y = pk2(o.z, o.w); *(v2u*)(MIXIN + m * DM + c) = ov; }
            }
        }
    }
}

__device__ __forceinline__ void mid_rows(const Args& a, int gw, int NGW, int lane) {
    unsigned char* ws = a.ws; const bf16* MIX = (const bf16*)(ws + WS_MIX); bf16* H = (bf16*)(ws + WS_H);
    const f32x4* g1 = (const f32x4*)a.in[25] + lane; const f32x4* g2 = (const f32x4*)a.in[26] + lane;
    for (int m = gw; m < NTOK; m += NGW) {
        const v2u* mr = (const v2u*)(MIX + (size_t)m * DM) + lane; const f32x4* xr = (const f32x4*)xrow(a, m) + lane;
        f32x4 v[8]; float s = 0.f;
#pragma unroll
        for (int j = 0; j < 8; ++j) { const v2u u = mr[64 * j]; v[j] = (f32x4){lo2f(u.x), hi2f(u.x), lo2f(u.y), hi2f(u.y)}; s += (v[j].x * v[j].x + v[j].y * v[j].y) + (v[j].z * v[j].z + v[j].w * v[j].w); }
        const float rstd = 1.f / sqrtf(wave_sum(s) * (1.f / DM) + 1e-6f); float s1 = 0.f;
        f32x4* orow = (f32x4*)(a.out + (size_t)m * DM) + lane;
#pragma unroll
        for (int j = 0; j < 8; ++j) { v[j] = xr[64 * j] + v[j] * rstd * g1[64 * j]; orow[64 * j] = v[j]; s1 += (v[j].x * v[j].x + v[j].y * v[j].y) + (v[j].z * v[j].z + v[j].w * v[j].w); }
        const float rstd1 = 1.f / sqrtf(wave_sum(s1) * (1.f / DM) + 1e-6f);
        v2u* hr = (v2u*)(H + (size_t)m * DM) + lane;
#pragma unroll
        for (int j = 0; j < 8; ++j) { const f32x4 gg = g2[64 * j]; v2u o; o.x = pk2(v[j].x * rstd1 * gg.x, v[j].y * rstd1 * gg.y); o.y = pk2(v[j].z * rstd1 * gg.z, v[j].w * rstd1 * gg.w); hr[64 * j] = o; }
    }
}
__device__ __forceinline__ void final_rows(const Args& a, int gw, int NGW, int lane) {
    unsigned char* ws = a.ws; const bf16* FF = (const bf16*)(ws + WS_FF);
    const f32x4* g1 = (const f32x4*)a.in[29] + lane;
    for (int m = gw; m < NTOK; m += NGW) {
        const v2u* mr = (const v2u*)(FF + (size_t)m * DM) + lane;
        f32x4 v[8]; float s = 0.f;
#pragma unroll
        for (int j = 0; j < 8; ++j) { const v2u u = mr[64 * j]; v[j] = (f32x4){lo2f(u.x), hi2f(u.x), lo2f(u.y), hi2f(u.y)}; s += (v[j].x * v[j].x + v[j].y * v[j].y) + (v[j].z * v[j].z + v[j].w * v[j].w); }
        const float rstd = 1.f / sqrtf(wave_sum(s) * (1.f / DM) + 1e-6f);
        f32x4* orow = (f32x4*)(a.out + (size_t)m * DM) + lane;
#pragma unroll
        for (int j = 0; j < 8; ++j) orow[64 * j] = orow[64 * j] + v[j] * rstd * g1[64 * j];
    }
}

typedef GAS unsigned gu32;
#define XB_TMO      128
#define XB_XCNT(j)  (256  + 64 * (j))
#define XB_XSUB(j)  (1280 + 64 * (j))
#define XB_XGEN(j)  (2304 + 64 * (j))
#define XB_TOP      3328
#define XB_TOPGEN   3392
#define XCD_BAR_WORDS 3456
#define XB_SPIN_CAP (1u << 18)

__device__ __forceinline__ unsigned xb_ld(unsigned* p)              { return __hip_atomic_load(p, __ATOMIC_RELAXED, __HIP_MEMORY_SCOPE_AGENT); }
__device__ __forceinline__ unsigned xb_add(unsigned* p, unsigned v) { return __hip_atomic_fetch_add(p, v, __ATOMIC_RELAXED, __HIP_MEMORY_SCOPE_AGENT); }
__device__ __forceinline__ unsigned xb_xcc_id() { return (unsigned)__builtin_amdgcn_s_getreg((3 << 11) | 20) & 0xFu; }
#define XB_SPIN(cond, bar) do { unsigned _sp = 0; while (cond) { __builtin_amdgcn_s_sleep(1); \
    if ((++_sp & 255u) == 0u) { if (xb_ld(&(bar)[XB_TMO])) break; if (_sp > XB_SPIN_CAP) { atomicAdd(&(bar)[XB_TMO], 1u); break; } } } } while (0)

struct XcdBarrier {
    unsigned* bar; unsigned x;
    volatile LAS unsigned* st;
};

__device__ __forceinline__ XcdBarrier xcd_barrier_post(unsigned* bar, volatile LAS unsigned* st) {
    XcdBarrier b; b.bar = bar; b.x = xb_xcc_id(); b.st = st;
    if (threadIdx.x == 0) (void)xb_add(&bar[XB_XCNT(b.x)], 1u);
    return b;
}
__device__ __forceinline__ void xcd_barrier_complete(unsigned* bar, unsigned x, unsigned& nloc, unsigned& nx) {
    const unsigned G = gridDim.x * gridDim.y * gridDim.z;
    unsigned sum, cnt, mine, sp = 0u;
    for (;;) {
        sum = 0u; cnt = 0u; mine = 0u;
#pragma unroll
        for (unsigned j = 0; j < 16; ++j) { const unsigned c = xb_ld(&bar[XB_XCNT(j)]); sum += c; cnt += (c > 0u) ? 1u : 0u; mine = (j == x) ? c : mine; }
        if (sum == G) break;
        __builtin_amdgcn_s_sleep(1);
        if ((++sp & 255u) == 0u) { if (xb_ld(&bar[XB_TMO])) break; if (sp > XB_SPIN_CAP) { atomicAdd(&bar[XB_TMO], 1u); break; } }
    }
    nloc = mine > 0u ? mine : 1u; nx = cnt > 0u ? cnt : 1u;
}

__device__ __forceinline__ void xcd_barrier(const XcdBarrier& b) {
    asm volatile("s_waitcnt vmcnt(0)" ::: "memory");
    __syncthreads();
    if (threadIdx.x == 0) {
        unsigned* bar = b.bar;
        __builtin_amdgcn_s_waitcnt(0);
        unsigned nloc = b.st[0], nx = b.st[1];
        if (nloc == 0u) { xcd_barrier_complete(bar, b.x, nloc, nx); b.st[0] = nloc; b.st[1] = nx; }
        const unsigned old = xb_add(&bar[XB_XSUB(b.x)], 1u);
        const unsigned gen = old / nloc;
        if (old + 1u == (gen + 1u) * nloc) {
            __builtin_amdgcn_fence(__ATOMIC_RELEASE, "agent");
            asm volatile("s_waitcnt vmcnt(0)" ::: "memory");
            const unsigned og = xb_add(&bar[XB_TOP], 1u);
            const unsigned tg = og / nx;
            if (og + 1u == (tg + 1u) * nx) xb_add(&bar[XB_TOPGEN], 1u);
            else XB_SPIN(xb_ld(&bar[XB_TOPGEN]) == tg, bar);
            __builtin_amdgcn_fence(__ATOMIC_ACQUIRE, "agent");
            xb_add(&bar[XB_XGEN(b.x)], 1u);
            asm volatile("s_waitcnt vmcnt(0)" ::: "memory");
        } else {
            XB_SPIN(xb_ld(&bar[XB_XGEN(b.x)]) == gen, bar);
            __builtin_amdgcn_fence(__ATOMIC_ACQUIRE, "agent");
            asm volatile("s_waitcnt vmcnt(0)" ::: "memory");
        }
    }
    __syncthreads();
}

__global__ void __launch_bounds__(NWAVES * 64, 2) hymba_fwd(Args args) {
    extern __shared__ __attribute__((aligned(16))) unsigned char lds[];
    cg::grid_group grid = cg::this_grid();
    LAS unsigned char* ldsl = (LAS unsigned char*)lds;
    const int tid = threadIdx.x, lane = tid & 63, wave = __builtin_amdgcn_readfirstlane(tid >> 6);
    const int G = gridDim.x, gw = blockIdx.x * NWAVES + wave, NGW = G * NWAVES;
    unsigned char* ws = args.ws;
    const int lo = args.ph_lo, hi = args.ph_hi;
    if (tid < 32) ((volatile LAS unsigned*)(ldsl + MISC_OFF))[tid] = 0u;
    __syncthreads();
    const XcdBarrier xbar = xcd_barrier_post((unsigned*)(ws + WS_CTL), (volatile LAS unsigned*)(ldsl + MISC_OFF) + 8);
#define IN(k) (lo <= (k) && (k) < hi)
#define SEAM(k) do { if (IN(k) && IN((k) + 1)) { if ((k) == 0) grid.sync(); else xcd_barrier(xbar); } } while (0)
    typedef pg8::EpiBf16<0> E0; typedef pg8::EpiBf16<2> E2;
    if (IN(0)) { p0_prologue(args, ldsl, gw, NGW, wave, lane); }
    SEAM(0);
#ifndef NO_G1
    if (IN(1)) { pg8::Gemm g{(const bf16*)(ws + WS_H), (const bf16*)(ws + WS_WIN), NTOK, ZLD, DM}; pg8::StaticOrder S; S.init(NTOK, ZLD, G, (int)blockIdx.x);
        pg8::EpiZ E{(bf16*)(ws + WS_ZM), (bf16*)(ws + WS_ZC)}; pg8::gemm_phase<pg8::EpiZ, pg8::StaticOrder, true, true>(ldsl, g, S, E); }
#endif
    SEAM(1);
    if (IN(2)) {
#ifndef NO_SHIFT
 shift_phase(args, gw, NGW, lane);
#endif
 }
    SEAM(2);
    if (IN(3)) {
#ifndef NO_SCAN
 scan_phase(args, lds, wave, lane);
#ifdef PROBE_SCAN2
 __syncthreads(); scan_phase(args, lds, wave, lane);
#endif
#endif
 }
    SEAM(3);
    if (IN(4)) {
#ifndef NO_POST
 post_phase(args, wave, lane);
#endif
 }
    SEAM(4);
#ifndef NO_G5
    if (IN(5)) { pg8::Gemm g{(const bf16*)(ws + WS_H), (const bf16*)(ws + WS_WOUT), NTOK, DM, DM}; pg8::StaticOrder S; S.init(NTOK, DM, G, (int)blockIdx.x);
        E0 E{(bf16*)(ws + WS_MIX), DM}; pg8::gemm_phase<E0, pg8::StaticOrder, true, true>(ldsl, g, S, E); }
#endif
    SEAM(5);
    if (IN(6)) { mid_rows(args, gw, NGW, lane); }
    SEAM(6);
#ifndef NO_G7
    if (IN(7)) {
#pragma unroll
        for (int s = 0; s < 3; ++s) {
            { pg8::Gemm g{(const bf16*)(ws + WS_H) + (size_t)s * SEQ * DM, (const bf16*)(ws + WS_WUP), SEQ, DFF, DM}; pg8::StaticOrder S; S.init(SEQ, DFF, G, (int)blockIdx.x);
              E2 E{(bf16*)(ws + WS_U), DFF}; pg8::gemm_phase<E2, pg8::StaticOrder, true, true>(ldsl, g, S, E); }
            xcd_barrier(xbar);
            { pg8::Gemm g{(const bf16*)(ws + WS_U), (const bf16*)(ws + WS_WDN), SEQ, DM, DFF}; pg8::StaticOrder S; S.init(SEQ, DM, G, (int)blockIdx.x);
              E0 E{(bf16*)(ws + WS_FF) + (size_t)s * SEQ * DM, DM}; pg8::gemm_phase<E0, pg8::StaticOrder, true, true>(ldsl, g, S, E); }
            if (s < 2) xcd_barrier(xbar);
        }
    }
#endif
    SEAM(7);
    if (IN(8)) { final_rows(args, gw, NGW, lane); }
#undef IN
#undef SEAM
}

extern "C" void kernel_launch(void* const* d_in, const int* in_sizes, int n_in, void* d_out, int out_size, void* d_ws, size_t ws_size, hipStream_t stream) {
    static int grid = 0;
    if (grid == 0) {
        if (n_in != 30 || ws_size < WS_END) { fprintf(stderr, "kernel_launch: unexpected n_in %d / ws %zu\n", n_in, ws_size); grid = -1; return; }
        int dev = 0, cus = 0, per_cu = 0;
        hipGetDevice(&dev); hipDeviceGetAttribute(&cus, hipDeviceAttributeMultiprocessorCount, dev);
        if (hipFuncSetAttribute((const void*)hymba_fwd, hipFuncAttributeMaxDynamicSharedMemorySize, LDS_BYTES) != hipSuccess) { fprintf(stderr, "kernel_launch: hipFuncSetAttribute failed\n"); grid = -1; return; }
        hipOccupancyMaxActiveBlocksPerMultiprocessor(&per_cu, (const void*)hymba_fwd, NWAVES * 64, LDS_BYTES);
        (void)hipGetLastError();
        if (per_cu < 1) per_cu = 1;
        grid = cus * 1;
        if (grid < 192) { fprintf(stderr, "kernel_launch: grid %d too small\n", grid); grid = -1; return; }
    }
    if (grid < 0) return;
    if (hipMemsetAsync((char*)d_ws + WS_CTL, 0, CTL_BYTES, stream) != hipSuccess) { fprintf(stderr, "kernel_launch: memset failed\n"); return; }
    Args a{};
    for (int i = 0; i < 30; ++i) a.in[i] = (const float*)d_in[i];
    a.out = (float*)d_out; a.ws = (unsigned char*)d_ws;
#ifndef N_LAUNCH_SPLIT
    a.ph_lo = 0; a.ph_hi = 9;
    void* kargs[] = {&a};
    hipError_t e = hipLaunchCooperativeKernel((const void*)hymba_fwd, dim3(grid), dim3(NWAVES * 64), kargs, LDS_BYTES, stream);
    if (e != hipSuccess) fprintf(stderr, "cooperative launch failed: %s (grid %d)\n", hipGetErrorString(e), grid);
#else
    for (int p = 0; p < 9; ++p) { a.ph_lo = p; a.ph_hi = p + 1; void* kargs[] = {&a};
        hipError_t e = hipLaunchCooperativeKernel((const void*)hymba_fwd, dim3(grid), dim3(NWAVES * 64), kargs, LDS_BYTES, stream);
        if (e != hipSuccess) fprintf(stderr, "cooperative launch %d failed: %s (grid %d)\n", p, hipGetErrorString(e), grid); }
#endif
}
```

```cpp
#include <hip/hip_runtime.h>
#include <hip/hip_cooperative_groups.h>
#include <cstdio>
#include <cstdint>
namespace cg = cooperative_groups;
namespace pg8 {
#define PG8_LAS __attribute__((address_space(3)))
typedef unsigned short bf16_t;
typedef short bf16x8 __attribute__((ext_vector_type(8)));
typedef float f32x4 __attribute__((ext_vector_type(4)));
typedef unsigned u32x4 __attribute__((ext_vector_type(4)));
constexpr int BM = 256, BK = 64, HALF = 128, HTB = HALF * BK * 2  , STAGE_BYTES = 8 * HTB, NXCD = 8, WGM = 8;

__host__ __device__ __forceinline__ int lds_byte(int r, int c) { const int st = (r >> 4) * 2 + (c >> 5), rr = r & 15, cc = c & 31, ob = rr * 64 + cc * 2; return st * 1024 + (ob ^ (((ob >> 9) & 1) << 5)); }
__host__ __device__ __forceinline__ void stage_rc(int b, int& R, int& C) { const int st = b / 1024, sb = b % 1024, swz = sb ^ (((sb >> 9) & 1) << 5); R = (st >> 1) * 16 + swz / 64; C = (st & 1) * 32 + (swz % 64) / 2; }
__host__ __device__ __forceinline__ int perm32(int rho) { const int n = rho >> 4, i = rho & 15; return 8 * (i >> 2) + 4 * n + (i & 3); }

struct Unit { int pm, pn; };
struct Gemm { const bf16_t* A; const bf16_t* Bt; int M, N, K; };

struct StaticOrder {
    int nM, nN, nwg, G, c;
    __host__ __device__ void init(int M, int N, int G_, int c_) { nM = M / BM; nN = N / BM; nwg = nM * nN; G = G_; c = c_; }
    __host__ __device__ bool next(int i, Unit& u) const {
        const long L = (long)i * G + c; if (L >= nwg) return false;
        int wgid = (int)L; { const int q = nwg / NXCD, r = nwg % NXCD, xcd = wgid % NXCD, off = wgid / NXCD; wgid = (xcd < r ? xcd * (q + 1) : r * (q + 1) + (xcd - r) * q) + off; }
        const int nig = WGM * nN, gid = wgid / nig, fm = gid * WGM, gsz = (nM - fm) < WGM ? (nM - fm) : WGM;
        u.pm = fm + ((wgid % nig) % gsz); u.pn = (wgid % nig) / gsz; return true;
    }
    __device__ __forceinline__ void a_ready(const Unit&) const {}
    __device__ __forceinline__ void done(const Unit&) const {}
};

__device__ __forceinline__ unsigned cvt_pk_bf16(float lo, float hi) { unsigned r; asm volatile("v_cvt_pk_bf16_f32 %0, %1, %2" : "=v"(r) : "v"(lo), "v"(hi)); return r; }
typedef float f32x2 __attribute__((ext_vector_type(2)));
template <int ACT> struct EpiBf16 {
    static constexpr bool PERM = true, AFTER_DRAIN = false;
    bf16_t* O; int ldc;
    __device__ __forceinline__ void operator()(const f32x4 (&acc)[2][2][4][2], const Unit& u, int wr, int wc, int fr, int fq) const {
        const int row0 = u.pm * BM + wr * 64 + fr; const int col0 = u.pn * BM + wc * 32 + 8 * fq;
#pragma unroll
        for (int ai = 0; ai < 2; ++ai)
#pragma unroll
            for (int m = 0; m < 4; ++m) { bf16_t* rowp = O + (size_t)(row0 + ai * HALF + m * 16) * ldc + col0;
#pragma unroll
                for (int bj = 0; bj < 2; ++bj) { f32x4 v0 = acc[ai][bj][m][0], v1 = acc[ai][bj][m][1];
                    if (ACT == 2) { const f32x4 z = (f32x4){0.f, 0.f, 0.f, 0.f}; v0 = __builtin_elementwise_max(v0, z); v1 = __builtin_elementwise_max(v1, z); v0 = v0 * v0; v1 = v1 * v1; }
                    u32x4 w; w.x = cvt_pk_bf16(v0[0], v0[1]); w.y = cvt_pk_bf16(v0[2], v0[3]); w.z = cvt_pk_bf16(v1[0], v1[1]); w.w = cvt_pk_bf16(v1[2], v1[3]);
                    *(u32x4*)(rowp + bj * HALF) = w; } }
    }
};


struct EpiZ {
    static constexpr bool PERM = true, AFTER_DRAIN = false;
    bf16_t* ZM; bf16_t* ZC;
    __device__ __forceinline__ void operator()(const f32x4 (&acc)[2][2][4][2], const Unit& u, int wr, int wc, int fr, int fq) const {
        const int pn = u.pn; bf16_t* O; int ldc, colt;
        if (pn < 12) { O = ZM; ldc = 3584; colt = pn * BM; } else if (pn < 20) { O = ZC; ldc = 2048; colt = (pn - 12) * BM; } else { O = ZM; ldc = 3584; colt = 3072 + (pn - 20) * BM; }
        const int row0 = u.pm * BM + wr * 64 + fr; const int col0 = colt + wc * 32 + 8 * fq;
#pragma unroll
        for (int ai = 0; ai < 2; ++ai)
#pragma unroll
            for (int m = 0; m < 4; ++m) { bf16_t* rowp = O + (size_t)(row0 + ai * HALF + m * 16) * ldc + col0;
#pragma unroll
                for (int bj = 0; bj < 2; ++bj) { const f32x4 v0 = acc[ai][bj][m][0], v1 = acc[ai][bj][m][1];
                    u32x4 w; w.x = cvt_pk_bf16(v0[0], v0[1]); w.y = cvt_pk_bf16(v0[2], v0[3]); w.z = cvt_pk_bf16(v1[0], v1[1]); w.w = cvt_pk_bf16(v1[2], v1[3]);
                    *(u32x4*)(rowp + bj * HALF) = w; } }
    }
};

template <class Epi, class Sched, bool ALIGN_EPI = false, bool SP2 = false>
__device__ __forceinline__ void gemm_phase(PG8_LAS unsigned char* lds, const Gemm g, const Sched& S, const Epi& E) {
    const int tid = threadIdx.x, wid = __builtin_amdgcn_readfirstlane(tid >> 6), lane = tid & 63, wr = wid >> 2, wc = wid & 3, fr = lane & 15, fq = lane >> 4;
    const int K = g.K, nt = K / BK;
    unsigned voffA[2], voffB[2];
#pragma unroll
    for (int i = 0; i < 2; ++i) { int R, C; stage_rc(tid * 16 + i * 8192, R, C); const int Rb = Epi::PERM ? ((R & ~31) + perm32(R & 31)) : R;
        voffA[i] = (unsigned)(R * K + C) * 2u; voffB[i] = (unsigned)(Rb * K + C) * 2u; }
    const size_t kstep = (size_t)(BK * 2);
    const size_t hstep = (size_t)HALF * K * 2;
    const size_t tstep = 2 * hstep;
    const unsigned ldsw = (unsigned)wid * 1024u;
    const int aoff = lds_byte(wr * 64 + fr, fq * 8), boff = lds_byte(wc * 32 + fr, fq * 8);
#define PG8_SA(b, h) (((b) * 2 + (h)) * HTB)
#define PG8_SB(b, h) ((4 + (b) * 2 + (h)) * HTB)
#define PG8_STAGE(bufoff, gbase, voff) do { _Pragma("unroll") for (int _i = 0; _i < 2; ++_i) \
        __builtin_amdgcn_global_load_lds((const unsigned*)((const char*)(gbase) + (voff)[_i]), (PG8_LAS unsigned*)(lds + (bufoff) + ldsw + _i * 8192), 16, 0, 0); } while (0)
#define PG8_LDA(dst, b, h) do { _Pragma("unroll") for (int m = 0; m < 4; ++m) _Pragma("unroll") for (int k = 0; k < 2; ++k) dst[m][k] = *(const PG8_LAS bf16x8*)(lds + PG8_SA(b, h) + aoff + m * 2048 + k * 1024); } while (0)
#define PG8_LDB(dst, b, h) do { _Pragma("unroll") for (int n = 0; n < 2; ++n) _Pragma("unroll") for (int k = 0; k < 2; ++k) dst[n][k] = *(const PG8_LAS bf16x8*)(lds + PG8_SB(b, h) + boff + n * 2048 + k * 1024); } while (0)
#define PG8_MMA(ai, bj, At, Bt) do { __builtin_amdgcn_s_setprio(1); _Pragma("unroll") for (int m = 0; m < 4; ++m) _Pragma("unroll") for (int n = 0; n < 2; ++n) _Pragma("unroll") for (int k = 0; k < 2; ++k) \
        acc[ai][bj][m][n] = __builtin_amdgcn_mfma_f32_16x16x32_bf16(Bt[n][k], At[m][k], acc[ai][bj][m][n], 0, 0, 0); __builtin_amdgcn_s_setprio(0); } while (0)
#define PG8_WAIT_V(n) asm volatile("s_waitcnt vmcnt(" #n ")" ::: "memory")
#define PG8_WAIT_L(n) asm volatile("s_waitcnt lgkmcnt(" #n ")" ::: "memory")
#define PG8_BAR __builtin_amdgcn_s_barrier()
#define PG8_SCHED __builtin_amdgcn_sched_barrier(0)
    Unit cur, nxt; int ui = 0;
    if (!S.next(0, cur)) return;
    f32x4 acc[2][2][4][2];
#pragma unroll
    for (int a = 0; a < 2; ++a)
#pragma unroll
        for (int b = 0; b < 2; ++b)
#pragma unroll
            for (int m = 0; m < 4; ++m)
#pragma unroll
                for (int n = 0; n < 2; ++n) acc[a][b][m][n] = (f32x4){0.f, 0.f, 0.f, 0.f};
    bf16x8 At[4][2], B0[2][2], B1[2][2];
    const char* cA = (const char*)g.A + (size_t)cur.pm * tstep; const char* cB = (const char*)g.Bt + (size_t)cur.pn * tstep;
    S.a_ready(cur);
    if constexpr (SP2) {
        PG8_STAGE(PG8_SB(0, 0), cB, voffB); PG8_STAGE(PG8_SB(0, 1), cB + hstep, voffB); PG8_STAGE(PG8_SA(0, 0), cA, voffA); PG8_STAGE(PG8_SA(0, 1), cA + hstep, voffA);
        if (wr == 1) PG8_BAR;
        PG8_WAIT_V(2); PG8_BAR;
        PG8_STAGE(PG8_SB(1, 0), cB + kstep, voffB); PG8_STAGE(PG8_SA(1, 0), cA + kstep, voffA); PG8_STAGE(PG8_SB(1, 1), cB + hstep + kstep, voffB);
        PG8_WAIT_V(6); PG8_BAR;
    } else {
        PG8_STAGE(PG8_SB(0, 0), cB, voffB); PG8_STAGE(PG8_SA(0, 0), cA, voffA); PG8_STAGE(PG8_SB(0, 1), cB + hstep, voffB); PG8_STAGE(PG8_SA(0, 1), cA + hstep, voffA);
        if (wr == 1) PG8_BAR;
        PG8_WAIT_V(4); PG8_BAR;
        PG8_STAGE(PG8_SB(1, 0), cB + kstep, voffB); PG8_STAGE(PG8_SA(1, 0), cA + kstep, voffA); PG8_STAGE(PG8_SB(1, 1), cB + hstep + kstep, voffB);
        PG8_WAIT_V(6); PG8_BAR;
    }
    for (;;) {
        const bool has_next = S.next(ui + 1, nxt);
        const char* nA = has_next ? (const char*)g.A + (size_t)nxt.pm * tstep : cA; const char* nB = has_next ? (const char*)g.Bt + (size_t)nxt.pn * tstep : cB;
        for (int t = 0; t < nt; t += 2) {
            const bool last = (t == nt - 2);
            const char* a1 = cA + (size_t)(t + 1) * kstep;
            const char* a2 = last ? nA : cA + (size_t)(t + 2) * kstep; const char* b2 = last ? nB : cB + (size_t)(t + 2) * kstep;
            const char* a3 = a2 + kstep; const char* b3 = b2 + kstep;
            if (last && has_next) S.a_ready(nxt);
            if constexpr (SP2) {
            PG8_LDB(B0, 0, 0); PG8_LDB(B1, 0, 1); PG8_SCHED; PG8_LDA(At, 0, 0); PG8_STAGE(PG8_SA(1, 1), a1 + hstep, voffA);
            PG8_WAIT_V(8); PG8_WAIT_L(0); PG8_BAR; PG8_MMA(0, 0, At, B0); PG8_MMA(0, 1, At, B1); PG8_BAR; PG8_SCHED;
            PG8_LDA(At, 0, 1); PG8_STAGE(PG8_SB(0, 0), b2, voffB); PG8_STAGE(PG8_SB(0, 1), b2 + hstep, voffB); PG8_STAGE(PG8_SA(0, 0), a2, voffA);
            PG8_WAIT_V(8); PG8_WAIT_L(0); PG8_BAR; PG8_MMA(1, 0, At, B0); PG8_MMA(1, 1, At, B1); PG8_BAR; PG8_SCHED;
            PG8_LDB(B0, 1, 0); PG8_LDB(B1, 1, 1); PG8_SCHED; PG8_LDA(At, 1, 0); PG8_STAGE(PG8_SA(0, 1), a2 + hstep, voffA);
            PG8_WAIT_V(8); PG8_WAIT_L(0); PG8_BAR; PG8_MMA(0, 0, At, B0); PG8_MMA(0, 1, At, B1); PG8_BAR; PG8_SCHED;
            PG8_LDA(At, 1, 1); PG8_STAGE(PG8_SB(1, 0), b3, voffB); PG8_STAGE(PG8_SB(1, 1), b3 + hstep, voffB); PG8_STAGE(PG8_SA(1, 0), a3, voffA);
            PG8_WAIT_V(8); PG8_WAIT_L(0); PG8_BAR; PG8_MMA(1, 0, At, B0); PG8_MMA(1, 1, At, B1); PG8_BAR; PG8_SCHED;
            } else {
            PG8_LDB(B0, 0, 0); PG8_SCHED; PG8_LDA(At, 0, 0); PG8_STAGE(PG8_SA(1, 1), a1 + hstep, voffA);
            PG8_WAIT_L(8); PG8_BAR; PG8_WAIT_L(0); PG8_MMA(0, 0, At, B0); PG8_BAR; PG8_SCHED;
            PG8_LDB(B1, 0, 1); PG8_STAGE(PG8_SB(0, 0), b2, voffB);
            PG8_BAR; PG8_WAIT_L(0); PG8_MMA(0, 1, At, B1); PG8_BAR;
            PG8_LDA(At, 0, 1); PG8_STAGE(PG8_SA(0, 0), a2, voffA);
            PG8_BAR; PG8_WAIT_L(0); PG8_MMA(1, 0, At, B0); PG8_BAR; PG8_SCHED;
            PG8_STAGE(PG8_SB(0, 1), b2 + hstep, voffB);
            PG8_WAIT_V(6); PG8_BAR; PG8_MMA(1, 1, At, B1); PG8_BAR;
            PG8_LDB(B0, 1, 0); PG8_SCHED; PG8_LDA(At, 1, 0); PG8_STAGE(PG8_SA(0, 1), a2 + hstep, voffA);
            PG8_WAIT_L(8); PG8_BAR; PG8_WAIT_L(0); PG8_MMA(0, 0, At, B0); PG8_BAR; PG8_SCHED;
            PG8_LDB(B1, 1, 1); PG8_STAGE(PG8_SB(1, 0), b3, voffB);
            PG8_BAR; PG8_WAIT_L(0); PG8_MMA(0, 1, At, B1); PG8_BAR;
            PG8_LDA(At, 1, 1); PG8_STAGE(PG8_SA(1, 0), a3, voffA);
            PG8_BAR; PG8_WAIT_L(0); PG8_MMA(1, 0, At, B0); PG8_BAR; PG8_SCHED;
            PG8_STAGE(PG8_SB(1, 1), b3 + hstep, voffB);
            PG8_WAIT_V(6); PG8_BAR; PG8_MMA(1, 1, At, B1); PG8_BAR;
            }
        }
        if constexpr (ALIGN_EPI) { if (wr == 0) PG8_BAR; }
        if constexpr (!Epi::AFTER_DRAIN) { E(acc, cur, wr, wc, fr, fq); S.done(cur); }
        if (!has_next) break;
#pragma unroll
        for (int a = 0; a < 2; ++a)
#pragma unroll
            for (int b = 0; b < 2; ++b)
#pragma unroll
                for (int m = 0; m < 4; ++m)
#pragma unroll
                    for (int n = 0; n < 2; ++n) acc[a][b][m][n] = (f32x4){0.f, 0.f, 0.f, 0.f};
        cur = nxt; cA = nA; cB = nB; ++ui;
        if constexpr (ALIGN_EPI) { if (wr == 1) PG8_BAR; }
    }
    PG8_WAIT_V(0);
    if constexpr (!ALIGN_EPI) { if (wr == 0) PG8_BAR; }
    PG8_BAR;
    if constexpr (Epi::AFTER_DRAIN) { E.fused(acc, cur, wr, wc, fr, fq, lds, wid, lane); S.done(cur); }
#undef PG8_SA
#undef PG8_SB
#undef PG8_STAGE
#undef PG8_LDA
#undef PG8_LDB
#undef PG8_MMA
#undef PG8_WAIT_V
#undef PG8_WAIT_L
#undef PG8_BAR
#undef PG8_SCHED
}
}

#define GAS __attribute__((address_space(1)))
#define LAS __attribute__((address_space(3)))
typedef unsigned short bf16;
typedef unsigned v4u __attribute__((ext_vector_type(4)));
typedef unsigned v2u __attribute__((ext_vector_type(2)));
typedef float f32x4 __attribute__((ext_vector_type(4)));
typedef float f32x2 __attribute__((ext_vector_type(2)));
typedef short bf16x8 __attribute__((ext_vector_type(8)));
typedef _Float16 h2 __attribute__((ext_vector_type(2)));
#define LDS_WAIT() asm volatile("s_waitcnt lgkmcnt(0)" ::: "memory")

constexpr int NWAVES = 8;
constexpr int NTOK = 24576, SEQ = 8192, DM = 2048, DR = 1024, DFF = 8192;
constexpr int ZLD = 5632, ZC_CA = 3072, ZC_CB = 4096, ZC_L = 5120;
constexpr int ZMLD = 3584, ZM_L = 3072, ZCLD = 2048;
constexpr size_t MiB = 1u << 20;
constexpr size_t WS_WIN = 0, WS_WOUT = 22 * MiB, WS_WUP = 30 * MiB, WS_WDN = 62 * MiB, WS_SMALL = 94 * MiB, WS_XL = 95 * MiB, WS_XG = 107 * MiB,
                 WS_BONUS = 115 * MiB, WS_H = 118 * MiB, WS_ZC = 214 * MiB, WS_ZM = 310 * MiB, WS_END = 502 * MiB;
constexpr size_t SM_G2T = 0, SM_W2TF = 384 * 1024, SM_W2TB = 512 * 1024, SM_A2TF = 640 * 1024, SM_A2TB = 768 * 1024;
constexpr size_t WS_YF = WS_ZM, WS_YB = WS_ZM + 96 * MiB, WS_MIX = WS_ZC, WS_U = WS_ZC, WS_FF = WS_ZC + 128 * MiB;
constexpr size_t OUT_RS = 0, OUT_KS = 48 * MiB, OUT_VS = 96 * MiB, OUT_KK = 144 * MiB;
constexpr int LDS_BYTES = 147456, MISC_OFF = 131072 + 320;
constexpr size_t WS_CTL = 117 * MiB, CTL_BYTES = 16384;

struct Args { const float* in[30]; float* out; unsigned char* ws; int ph_lo, ph_hi; };

__device__ __forceinline__ float lo2f(unsigned u) { return __uint_as_float(u << 16); }
__device__ __forceinline__ float hi2f(unsigned u) { return __uint_as_float(u & 0xffff0000u); }
__device__ __forceinline__ unsigned f2bf(float f) { unsigned u = __float_as_uint(f); return (u + 0x7fffu + ((u >> 16) & 1u)) >> 16; }
__device__ __forceinline__ unsigned pk2(float lo, float hi) { unsigned r; asm volatile("v_cvt_pk_bf16_f32 %0, %1, %2" : "=v"(r) : "v"(lo), "v"(hi)); return r; }
__device__ __forceinline__ float fsigmoid(float x) { return __builtin_amdgcn_rcpf(1.f + __builtin_amdgcn_exp2f(-1.44269504f * x)); }
__device__ __forceinline__ float ftanh(float x) { return 1.f - 2.f * __builtin_amdgcn_rcpf(1.f + __builtin_amdgcn_exp2f(2.88539008f * x)); }
__device__ __forceinline__ float wave_sum(float v) {
#pragma unroll
    for (int o = 1; o < 64; o <<= 1) v += __shfl_xor(v, o);
    return v;
}
template <int CTRL> __device__ __forceinline__ float dppf(float x) { return __int_as_float(__builtin_amdgcn_update_dpp(0, __float_as_int(x), CTRL, 0xF, 0xF, true)); }
__device__ __forceinline__ float red8(float x) { x += dppf<0xB1>(x); x += dppf<0x4E>(x); x += dppf<0x141>(x); return x; }
__device__ __forceinline__ const float* xrow(const Args& a, int m) { return m < 16384 ? a.in[0] + (size_t)m * DM : a.in[1] + (size_t)(m - 16384) * DM; }

__device__ __forceinline__ void tr_item(const float* W, int ldw, int k0, int sc0, bf16* WT, int ldt, int dr0, LAS float* scr, int lane) {
#pragma unroll 8
    for (int i = 0; i < 32; ++i) { const int kk = 2 * i + (lane >> 5); scr[kk * 33 + (lane & 31)] = W[(size_t)(k0 + kk) * ldw + sc0 + (lane & 31)]; }
    LDS_WAIT(); asm volatile("" ::: "memory");
    const int c = lane & 7;
#pragma unroll
    for (int j = 0; j < 4; ++j) { const int n = (lane >> 3) + 8 * j; const LAS float* s = scr + (8 * c) * 33 + n;
        v4u o; o.x = pk2(s[0 * 33], s[1 * 33]); o.y = pk2(s[2 * 33], s[3 * 33]); o.z = pk2(s[4 * 33], s[5 * 33]); o.w = pk2(s[6 * 33], s[7 * 33]);
        *(v4u*)(WT + (size_t)(dr0 + n) * ldt + k0 + 8 * c) = o; }
    LDS_WAIT(); asm volatile("" ::: "memory");
}
__device__ __forceinline__ void rms_row_bf16(const float* xr_, const float* g, bf16* orow, int lane) {
    const f32x4* xr = (const f32x4*)xr_ + lane; const f32x4* gr = (const f32x4*)g + lane;
    f32x4 v[8]; float s = 0.f;
#pragma unroll
    for (int j = 0; j < 8; ++j) { v[j] = xr[64 * j]; s += (v[j].x * v[j].x + v[j].y * v[j].y) + (v[j].z * v[j].z + v[j].w * v[j].w); }
    const float rstd = 1.f / sqrtf(wave_sum(s) * (1.f / DM) + 1e-6f);
    v2u* o8 = (v2u*)orow + lane;
#pragma unroll
    for (int j = 0; j < 8; ++j) { const f32x4 gg = gr[64 * j]; v2u o; o.x = pk2(v[j].x * rstd * gg.x, v[j].y * rstd * gg.y); o.y = pk2(v[j].z * rstd * gg.z, v[j].w * rstd * gg.w); o8[64 * j] = o; }
}
__device__ __forceinline__ void p0_prologue(const Args& a, LAS unsigned char* lds, int gw, int NGW, int wave, int lane) {
    unsigned char* ws = a.ws;
    LAS float* scr = (LAS float*)(lds + wave * 16384);
    bf16* WIN = (bf16*)(ws + WS_WIN); bf16* WOUT = (bf16*)(ws + WS_WOUT);
    constexpr int I_IN = 32 * 173, I_OUT = 32 * 64, I_S = 32;
    constexpr int NITEMS = I_IN + I_OUT + 4 * I_S;
    for (int it = gw; it < NITEMS; it += NGW) {
        int r = it;
        if (r < I_IN) { const int kb = r / 173, nb = r % 173, sc0 = nb * 32; const int dr0 = sc0 < 3072 ? sc0 : (sc0 < 3488 ? ZC_L + (sc0 - 3072) : ZC_CA + (sc0 - 3488));
            tr_item(a.in[3], 5536, kb * 64, sc0, WIN, DM, dr0, scr, lane); continue; } r -= I_IN;
        if (r < I_OUT) { tr_item(a.in[24], DM, (r / 64) * 64, (r % 64) * 32, WOUT, DM, (r % 64) * 32, scr, lane); continue; } r -= I_OUT;
        { const int which = r / I_S, nb = r % I_S; const float* src = which == 0 ? a.in[7] : which == 1 ? a.in[9] : which == 2 ? a.in[11] : a.in[13];
          bf16* dst = (bf16*)(ws + WS_SMALL + (which == 0 ? SM_W2TF : which == 1 ? SM_W2TB : which == 2 ? SM_A2TF : SM_A2TB));
          tr_item(src, DR, 0, nb * 32, dst, 64, nb * 32, scr, lane); }
    }
    { const int gt = gw * 64 + lane, NGT = NGW * 64;
      v4u zz = {0u, 0u, 0u, 0u}; v4u* zp = (v4u*)(WIN + (size_t)5536 * DM);
      for (int i = gt; i < 96 * DM / 8; i += NGT) zp[i] = zz;
      bf16* G2T = (bf16*)(ws + WS_SMALL + SM_G2T); const float* g2 = a.in[14];
      for (int i = gt; i < 160 * 1024; i += NGT) { const int k = i >> 10, n = i & 1023; G2T[n * 160 + k] = (bf16)f2bf(g2[i]); } }
    bf16* H = (bf16*)(ws + WS_H);
    for (int m = gw; m < NTOK; m += NGW) rms_row_bf16(xrow(a, m), a.in[2], H + (size_t)m * DM, lane);
}
__device__ __forceinline__ void p0_mlp_weights(const Args& a, LAS unsigned char* lds, int gw, int NGW, int wave, int lane) {
    unsigned char* ws = a.ws;
    LAS float* scr = (LAS float*)(lds + wave * 16384);
    bf16* WUP = (bf16*)(ws + WS_WUP); bf16* WDN = (bf16*)(ws + WS_WDN);
    constexpr int I_UP = 32 * 256, I_DN = 128 * 64;
    for (int it = gw; it < I_UP + I_DN; it += NGW) {
        int r = it;
        if (r < I_UP) { tr_item(a.in[27], DFF, (r / 256) * 64, (r % 256) * 32, WUP, DM, (r % 256) * 32, scr, lane); continue; } r -= I_UP;
        tr_item(a.in[28], DM, (r / 64) * 64, (r % 64) * 32, WDN, DFF, (r % 64) * 32, scr, lane);
    }
}

__device__ __forceinline__ void shift_phase(const Args& a, int gw, int NGW, int lane) {
    unsigned char* ws = a.ws;
    const bf16* Z = (const bf16*)(ws + WS_ZM);
    bf16* RS = (bf16*)((unsigned char*)a.out + OUT_RS); bf16* KS = (bf16*)((unsigned char*)a.out + OUT_KS);
    bf16* VS = (bf16*)((unsigned char*)a.out + OUT_VS); bf16* KK = (bf16*)((unsigned char*)a.out + OUT_KK);
    bf16* XL = (bf16*)(ws + WS_XL); bf16* XG = (bf16*)(ws + WS_XG); float* BONUS = (float*)(ws + WS_BONUS);
    const float* mup = a.in[4]; const float* mun = a.in[5]; const float* k_k = a.in[15]; const float* r_k = a.in[17];
    const int hp2 = lane >> 5, n2 = (lane & 31) * 2;
    for (int m = gw; m < NTOK; m += NGW) {
        const int t = m & (SEQ - 1); const bool hp = t > 0, hn = t < SEQ - 1;
        const bf16* z0 = Z + (size_t)m * ZMLD; const bf16* zp = z0 - ZMLD; const bf16* zn = z0 + ZMLD;
#pragma unroll 2
        for (int hh = 0; hh < 8; ++hh) {
            const int c = (hh * 2 + hp2) * 64 + n2;
            float s[3][2];
#pragma unroll
            for (int ar = 0; ar < 3; ++ar) { const int col = ar * 1024 + c;
                const unsigned zc = *(const unsigned*)(z0 + col); const unsigned zpv = hp ? *(const unsigned*)(zp + col) : 0u; const unsigned znv = hn ? *(const unsigned*)(zn + col) : 0u;
                const f32x2 mp = *(const f32x2*)(mup + col), mn = *(const f32x2*)(mun + col);
                const float x0 = lo2f(zc), x1 = hi2f(zc);
                s[ar][0] = x0 + mp.x * (lo2f(zpv) - x0) + mn.x * (lo2f(znv) - x0);
                s[ar][1] = x1 + mp.y * (hi2f(zpv) - x1) + mn.y * (hi2f(znv) - x1); }
            const f32x2 kkw = *(const f32x2*)(k_k + c), rkw = *(const f32x2*)(r_k + c);
            const float kr0 = s[1][0] * kkw.x, kr1 = s[1][1] * kkw.y;
            float ss = kr0 * kr0 + kr1 * kr1, bs = s[0][0] * s[1][0] * rkw.x + s[0][1] * s[1][1] * rkw.y;
#pragma unroll
            for (int o = 1; o < 32; o <<= 1) { ss += __shfl_xor(ss, o); bs += __shfl_xor(bs, o); }
            const float inv = 1.f / fmaxf(sqrtf(ss), 1e-12f);
            const size_t o = (size_t)m * DR + c;
            *(unsigned*)(RS + o) = pk2(s[0][0], s[0][1]); *(unsigned*)(KS + o) = pk2(s[1][0], s[1][1]);
            *(unsigned*)(VS + o) = pk2(s[2][0], s[2][1]); *(unsigned*)(KK + o) = pk2(kr0 * inv, kr1 * inv);
            if ((lane & 31) == 0) BONUS[m * 16 + hh * 2 + hp2] = bs;
        }
#pragma unroll
        for (int p = 0; p < 7; ++p) { const int j = p * 64 + lane;
            if (j < 416) { const int col = ZM_L + j, og = 3072 + j;
                const float x0 = lo2f(z0[col]); const float xp = hp ? lo2f(zp[col]) : 0.f; const float xn = hn ? lo2f(zn[col]) : 0.f;
                const float sv = x0 + mup[og] * (xp - x0) + mun[og] * (xn - x0);
                if (j < 128) XL[(size_t)m * 256 + j] = (bf16)f2bf(ftanh(sv));
                else if (j < 256) XL[(size_t)m * 256 + j] = (bf16)f2bf(sv);
                else XG[(size_t)m * 160 + (j - 256)] = (bf16)f2bf(fsigmoid(sv)); } }
    }
}

#define TR_STAGE(D_, N_) { const bool up_ = (lane & (D_)) != 0; _Pragma("unroll") for (int i_ = 0; i_ < (N_) / 2; ++i_) { \
    const float keep_ = up_ ? vals[i_ + (N_) / 2] : vals[i_]; const float send_ = up_ ? vals[i_] : vals[i_ + (N_) / 2]; vals[i_] = keep_ + __shfl_xor(send_, (D_)); } }
__device__ __forceinline__ void conv_phase(const Args& a, unsigned char* lds, int tid, int wave, int lane, int u0, int ustride) {
    unsigned char* ws = a.ws;
    const bf16* Z = (const bf16*)(ws + WS_ZC); bf16* MIXIN = (bf16*)(ws + WS_H);
    h2* utile = (h2*)lds;
    float* part = (float*)(lds + 126976);
    f32x2* stats = (f32x2*)(lds + 126976 + 2048);
    const float* dw_w = a.in[20]; const float* dw_b = a.in[21]; const float* cln_w = a.in[22]; const float* cln_b = a.in[23];
    const int cp = tid;
    for (int unit = u0; unit < NTOK / 32; unit += ustride) {
        const int m0 = unit * 32, t0 = m0 & (SEQ - 1);
        for (int idx = tid; idx < 62 * 512; idx += 512) { const int row = idx >> 9, c2 = idx & 511; const int t = t0 - 15 + row;
            h2 u = {(_Float16)0.f, (_Float16)0.f};
            if (t >= 0 && t < SEQ) { const bf16* zr = Z + (size_t)(m0 - 15 + row) * ZCLD; const unsigned za = *(const unsigned*)(zr + 2 * c2), zb = *(const unsigned*)(zr + 1024 + 2 * c2);
                u.x = (_Float16)(lo2f(za) * fsigmoid(lo2f(zb))); u.y = (_Float16)(hi2f(za) * fsigmoid(hi2f(zb))); }
            utile[idx] = u; }
        __syncthreads();
        f32x2 w[31];
#pragma unroll
        for (int j = 0; j < 31; ++j) w[j] = *(const f32x2*)(dw_w + j * 1024 + 2 * cp);
        const f32x2 bias = *(const f32x2*)(dw_b + 2 * cp);
        f32x2 out[32];
#pragma unroll
        for (int tb = 0; tb < 4; ++tb) {
            f32x2 acc[8];
#pragma unroll
            for (int o = 0; o < 8; ++o) acc[o] = bias;
#pragma unroll
            for (int jj = 0; jj < 38; ++jj) { const h2 uh = utile[(tb * 8 + jj) * 512 + cp]; const f32x2 u = {(float)uh.x, (float)uh.y};
#pragma unroll
                for (int o = 0; o < 8; ++o) { const int j = jj - o; if (j >= 0 && j < 31) acc[o] = u * w[j] + acc[o]; } }
#pragma unroll
            for (int o = 0; o < 8; ++o) out[tb * 8 + o] = acc[o];
            asm volatile("" ::: "memory");
        }
        float vals[64];
#pragma unroll
        for (int t = 0; t < 32; ++t) { vals[2 * t] = out[t].x + out[t].y; vals[2 * t + 1] = out[t].x * out[t].x + out[t].y * out[t].y; }
        TR_STAGE(32, 64) TR_STAGE(16, 32) TR_STAGE(8, 16) TR_STAGE(4, 8) TR_STAGE(2, 4) TR_STAGE(1, 2)
        part[wave * 64 + lane] = vals[0];
        __syncthreads();
        if (tid < 32) { float s = 0.f, q = 0.f;
#pragma unroll
            for (int wv = 0; wv < 8; ++wv) { s += part[wv * 64 + 2 * tid]; q += part[wv * 64 + 2 * tid + 1]; }
            const float mean = s * (1.f / 1024.f); const float var = q * (1.f / 1024.f) - mean * mean;
            stats[tid] = (f32x2){mean, 1.f / sqrtf(var + 1e-5f)}; }
        __syncthreads();
        const f32x2 lw = *(const f32x2*)(cln_w + 2 * cp), lb = *(const f32x2*)(cln_b + 2 * cp);
#pragma unroll
        for (int t = 0; t < 32; ++t) { const f32x2 st = stats[t];
            const float y0 = (out[t].x - st.x) * st.y * lw.x + lb.x, y1 = (out[t].y - st.x) * st.y * lw.y + lb.y;
            *(unsigned*)(MIXIN + (size_t)(m0 + t) * DM + DR + 2 * cp) = pk2(y0 * fsigmoid(y0), y1 * fsigmoid(y1)); }
        __syncthreads();
    }
}

constexpr int SC_LD = 68, SC_ARR = 32 * SC_LD, SC_ARR4 = SC_ARR / 4, SC_BUF = (5 * SC_ARR + SC_LD) * 4;
struct ScanOps { f32x4 q0, q1, a0, a1, m0, m1, r0, r1; float vv; };
__device__ __forceinline__ void ld_ops(ScanOps& o, const float* cb, int i, int ks, int rr) {
    const f32x4* p = (const f32x4*)(cb + i * SC_LD + ks * 8);
    o.q0 = p[0]; o.q1 = p[1]; o.a0 = p[SC_ARR4]; o.a1 = p[SC_ARR4 + 1]; o.m0 = p[2 * SC_ARR4]; o.m1 = p[2 * SC_ARR4 + 1]; o.r0 = p[3 * SC_ARR4]; o.r1 = p[3 * SC_ARR4 + 1];
    o.vv = cb[4 * SC_ARR + i * SC_LD + rr];
}
__device__ __forceinline__ void scan_phase(const Args& a, unsigned char* lds, int wave, int lane) {
    if (blockIdx.x >= 192) {
        const int wi = blockIdx.x - 192, nw = gridDim.x - 192;
        conv_phase(a, lds, threadIdx.x, wave, lane, wi, nw);
        p0_mlp_weights(a, (LAS unsigned char*)lds, wi * NWAVES + wave, nw * NWAVES, wave, lane);
        return;
    }
    unsigned char* ws = a.ws;
    const int scan = blockIdx.x >> 1, half = blockIdx.x & 1, dir = scan & 1, sh = scan >> 1, seq = sh >> 4, h = sh & 15;
    const size_t row0 = (size_t)seq * SEQ;
    const bf16* RS = (const bf16*)((unsigned char*)a.out + OUT_RS); const bf16* KS = (const bf16*)((unsigned char*)a.out + OUT_KS);
    const bf16* VS = (const bf16*)((unsigned char*)a.out + OUT_VS); const bf16* KK = (const bf16*)((unsigned char*)a.out + OUT_KK);
    const bf16* XL = (const bf16*)(ws + WS_XL);
    float* Y = (float*)(ws + (dir ? WS_YB : WS_YF));
    constexpr int NCH = SEQ / 32;
    const int ks = lane & 7, rr = half * 32 + (wave & 3) * 8 + (lane >> 3);
    f32x2 S0 = {0.f, 0.f}, S1 = S0, S2 = S0, S3 = S0;
    float* ybase = Y + row0 * DR + h * 64 + rr;
    const int pw = wave & 3, fr = lane & 15, fq = lane >> 4, cl = pw * 16 + fq * 4, gcol = h * 64 + cl;
    bf16x8 Bw0, Bw1, Ba0, Ba1; f32x4 w0v, a0v, kav;
    {
        const bf16* W2T = (const bf16*)(ws + WS_SMALL + (dir ? SM_W2TB : SM_W2TF)); const bf16* A2T = (const bf16*)(ws + WS_SMALL + (dir ? SM_A2TB : SM_A2TF));
        const size_t bo = (size_t)(h * 64 + pw * 16 + fr) * 64 + fq * 8;
        Bw0 = *(const bf16x8*)(W2T + bo); Bw1 = *(const bf16x8*)(W2T + bo + 32); Ba0 = *(const bf16x8*)(A2T + bo); Ba1 = *(const bf16x8*)(A2T + bo + 32);
        w0v = *(const f32x4*)((dir ? a.in[8] : a.in[6]) + gcol); a0v = *(const f32x4*)((dir ? a.in[12] : a.in[10]) + gcol); kav = *(const f32x4*)(a.in[16] + gcol);
    }
    for (int c = 0; c <= NCH; ++c) {
        if (wave >= 4) {
            if (c < NCH) {
                float* cb = (float*)(lds + (c & 1) * SC_BUF);
                f32x4 off = {0.f, 0.f, 0.f, 0.f};
#pragma unroll
                for (int mt = 0; mt < 2; ++mt) {
                    const int i = mt * 16 + fr, step = c * 32 + i, t = dir ? (SEQ - 1 - step) : step; const size_t m = row0 + t;
                    const bf16* xl = XL + m * 256 + dir * 64 + fq * 8;
                    const bf16x8 At0 = *(const bf16x8*)(xl), At1 = *(const bf16x8*)(xl + 32), Aa0 = *(const bf16x8*)(xl + 128), Aa1 = *(const bf16x8*)(xl + 160);
                    const size_t go = m * DR + gcol;
                    const v2u r4 = *(const v2u*)(RS + go), k4 = *(const v2u*)(KS + go), v4 = *(const v2u*)(VS + go), q4 = *(const v2u*)(KK + go);
                    f32x4 aw = {0.f, 0.f, 0.f, 0.f}, aa = aw;
                    aw = __builtin_amdgcn_mfma_f32_16x16x32_bf16(Bw0, At0, aw, 0, 0, 0); aw = __builtin_amdgcn_mfma_f32_16x16x32_bf16(Bw1, At1, aw, 0, 0, 0);
                    aa = __builtin_amdgcn_mfma_f32_16x16x32_bf16(Ba0, Aa0, aa, 0, 0, 0); aa = __builtin_amdgcn_mfma_f32_16x16x32_bf16(Ba1, Aa1, aa, 0, 0, 0);
                    const f32x4 rv = {lo2f(r4.x), hi2f(r4.x), lo2f(r4.y), hi2f(r4.y)}, kv = {lo2f(k4.x), hi2f(k4.x), lo2f(k4.y), hi2f(k4.y)};
                    const f32x4 vv = {lo2f(v4.x), hi2f(v4.x), lo2f(v4.y), hi2f(v4.y)}, qv = {lo2f(q4.x), hi2f(q4.x), lo2f(q4.y), hi2f(q4.y)};
                    f32x4 lw, cum, av, pm1, pin, pp;
#pragma unroll
                    for (int j = 0; j < 4; ++j) {
                        lw[j] = -0.87500596f * fsigmoid(w0v[j] + aw[j]); av[j] = fsigmoid(a0v[j] + aa[j]);
                        float x = lw[j]; x += dppf<0x111>(x); x += dppf<0x112>(x); x += dppf<0x114>(x); x += dppf<0x118>(x);
                        cum[j] = x + off[j];
                        pm1[j] = __builtin_amdgcn_exp2f(cum[j] - lw[j]); pin[j] = __builtin_amdgcn_exp2f(-cum[j]); pp[j] = __builtin_amdgcn_exp2f(cum[j]);
                    }
                    if (mt == 0) {
#pragma unroll
                        for (int j = 0; j < 4; ++j) off[j] = __shfl(cum[j], (lane & 48) | 15);
                    }
                    f32x4* dst = (f32x4*)(cb + i * SC_LD + cl);
                    dst[0] = qv * pm1; dst[SC_ARR4] = qv * av * pin; dst[2 * SC_ARR4] = kv * (1.f + (av - 1.f) * kav) * pin; dst[3 * SC_ARR4] = rv * pp; dst[4 * SC_ARR4] = vv;
                    if (i == 31) *(f32x4*)(cb + 5 * SC_ARR + cl) = pp;
                }
            }
        } else if (c > 0) {
            const float* cb = (const float*)(lds + ((c - 1) & 1) * SC_BUF);
            const int cbase = (c - 1) * 32;
            ScanOps o[3]; ld_ops(o[0], cb, 0, ks, rr); ld_ops(o[1], cb, 1, ks, rr);
#pragma unroll
            for (int g = 0; g < 4; ++g) {
                float ysel = 0.f;
#pragma unroll
                for (int j = 0; j < 8; ++j) {
                    const int i = g * 8 + j;
                    if (i + 2 < 32) ld_ops(o[(i + 2) % 3], cb, i + 2, ks, rr);
                    const ScanOps& x = o[i % 3];
                    f32x2 acc = S0 * x.q0.xy, acc2 = S1 * x.q0.zw; acc = S2 * x.q1.xy + acc; acc2 = S3 * x.q1.zw + acc2; acc = acc + acc2;
                    const float sa = red8(acc.x + acc.y);
                    const f32x2 sav = {sa, sa}, vv2 = {x.vv, x.vv};
                    S0 = vv2 * x.m0.xy + S0; S1 = vv2 * x.m0.zw + S1; S2 = vv2 * x.m1.xy + S2; S3 = vv2 * x.m1.zw + S3;
                    S0 = S0 - sav * x.a0.xy; S1 = S1 - sav * x.a0.zw; S2 = S2 - sav * x.a1.xy; S3 = S3 - sav * x.a1.zw;
                    f32x2 yq = S0 * x.r0.xy, yq2 = S1 * x.r0.zw; yq = S2 * x.r1.xy + yq; yq2 = S3 * x.r1.zw + yq2; yq = yq + yq2;
                    const float y = red8(yq.x + yq.y);
                    ysel = (ks == j) ? y : ysel;
                }
                const int step = cbase + g * 8 + ks, t = dir ? (SEQ - 1 - step) : step;
                ybase[(size_t)t * DR] = ysel;
            }
            const f32x4* pe = (const f32x4*)(cb + 5 * SC_ARR + ks * 8);
            const f32x4 pe0 = pe[0], pe1 = pe[1];
            S0 = S0 * pe0.xy; S1 = S1 * pe0.zw; S2 = S2 * pe1.xy; S3 = S3 * pe1.zw;
        }
        __syncthreads();
    }
}

__device__ __forceinline__ void post_phase(const Args& a, int wave, int lane) {
    unsigned char* ws = a.ws;
    const bf16* XG = (const bf16*)(ws + WS_XG); const bf16* G2T = (const bf16*)(ws + WS_SMALL + SM_G2T);
    const float* YF = (const float*)(ws + WS_YF); const float* YB = (const float*)(ws + WS_YB); const float* BONUS = (const float*)(ws + WS_BONUS);
    const bf16* VS = (const bf16*)((unsigned char*)a.out + OUT_VS); bf16* MIXIN = (bf16*)(ws + WS_H);
    const float* gn_w = a.in[18]; const float* gn_b = a.in[19];
    const int fr = lane & 15, fq = lane >> 4, n0 = wave * 128;
    for (int unit = blockIdx.x; unit < NTOK / 32; unit += gridDim.x) {
        const int m0 = unit * 32;
        f32x4 acc[2][8];
#pragma unroll
        for (int mt = 0; mt < 2; ++mt)
#pragma unroll
            for (int nt = 0; nt < 8; ++nt) acc[mt][nt] = (f32x4){0.f, 0.f, 0.f, 0.f};
#pragma unroll
        for (int kq = 0; kq < 5; ++kq) {
            bf16x8 A[2];
#pragma unroll
            for (int mt = 0; mt < 2; ++mt) A[mt] = *(const bf16x8*)(XG + (size_t)(m0 + mt * 16 + fr) * 160 + kq * 32 + fq * 8);
#pragma unroll
            for (int nt = 0; nt < 8; ++nt) { const bf16x8 B = *(const bf16x8*)(G2T + (size_t)(n0 + nt * 16 + fr) * 160 + kq * 32 + fq * 8);
#pragma unroll
                for (int mt = 0; mt < 2; ++mt) acc[mt][nt] = __builtin_amdgcn_mfma_f32_16x16x32_bf16(B, A[mt], acc[mt][nt], 0, 0, 0); }
        }
#pragma unroll
        for (int mt = 0; mt < 2; ++mt) { const size_t m = (size_t)(m0 + mt * 16 + fr);
#pragma unroll
            for (int hh = 0; hh < 2; ++hh) { const int hd = wave * 2 + hh;
                f32x4 y[4]; float s = 0.f;
#pragma unroll
                for (int q = 0; q < 4; ++q) { const size_t o = m * DR + n0 + (hh * 4 + q) * 16 + fq * 4; y[q] = *(const f32x4*)(YF + o) + *(const f32x4*)(YB + o); s += (y[q].x + y[q].y) + (y[q].z + y[q].w); }
                s += __shfl_xor(s, 16); s += __shfl_xor(s, 32);
                const float mean = s * (1.f / 64.f); float ss = 0.f;
#pragma unroll
                for (int q = 0; q < 4; ++q) { y[q] = y[q] - mean; ss += (y[q].x * y[q].x + y[q].y * y[q].y) + (y[q].z * y[q].z + y[q].w * y[q].w); }
                ss += __shfl_xor(ss, 16); ss += __shfl_xor(ss, 32);
                const float rstd = 1.f / sqrtf(ss * (1.f / 64.f) + 64e-5f); const float bs = BONUS[m * 16 + hd];
#pragma unroll
                for (int q = 0; q < 4; ++q) { const int c = n0 + (hh * 4 + q) * 16 + fq * 4; const f32x4 gw4 = *(const f32x4*)(gn_w + c), gb4 = *(const f32x4*)(gn_b + c);
                    const v2u v4 = *(const v2u*)(VS + m * DR + c); const f32x4 vv = {lo2f(v4.x), hi2f(v4.x), lo2f(v4.y), hi2f(v4.y)};
                    const f32x4 o = (y[q] * rstd * gw4 + gb4 + bs * vv) * acc[mt][hh * 4 + q];
                    v2u ov; ov.x = pk2(o.x, o.y); ov.y = pk2(o.z, o.w); *(v2u*)(MIXIN + m * DM + c) = ov; }
            }
        }
    }
}

__device__ __forceinline__ void mid_rows(const Args& a, int gw, int NGW, int lane) {
    unsigned char* ws = a.ws; const bf16* MIX = (const bf16*)(ws + WS_MIX); bf16* H = (bf16*)(ws + WS_H);
    const f32x4* g1 = (const f32x4*)a.in[25] + lane; const f32x4* g2 = (const f32x4*)a.in[26] + lane;
    for (int m = gw; m < NTOK; m += NGW) {
        const v2u* mr = (const v2u*)(MIX + (size_t)m * DM) + lane; const f32x4* xr = (const f32x4*)xrow(a, m) + lane;
        f32x4 v[8]; float s = 0.f;
#pragma unroll
        for (int j = 0; j < 8; ++j) { const v2u u = mr[64 * j]; v[j] = (f32x4){lo2f(u.x), hi2f(u.x), lo2f(u.y), hi2f(u.y)}; s += (v[j].x * v[j].x + v[j].y * v[j].y) + (v[j].z * v[j].z + v[j].w * v[j].w); }
        const float rstd = 1.f / sqrtf(wave_sum(s) * (1.f / DM) + 1e-6f); float s1 = 0.f;
        f32x4* orow = (f32x4*)(a.out + (size_t)m * DM) + lane;
#pragma unroll
        for (int j = 0; j < 8; ++j) { v[j] = xr[64 * j] + v[j] * rstd * g1[64 * j]; orow[64 * j] = v[j]; s1 += (v[j].x * v[j].x + v[j].y * v[j].y) + (v[j].z * v[j].z + v[j].w * v[j].w); }
        const float rstd1 = 1.f / sqrtf(wave_sum(s1) * (1.f / DM) + 1e-6f);
        v2u* hr = (v2u*)(H + (size_t)m * DM) + lane;
#pragma unroll
        for (int j = 0; j < 8; ++j) { const f32x4 gg = g2[64 * j]; v2u o; o.x = pk2(v[j].x * rstd1 * gg.x, v[j].y * rstd1 * gg.y); o.y = pk2(v[j].z * rstd1 * gg.z, v[j].w * rstd1 * gg.w); hr[64 * j] = o; }
    }
}
__device__ __forceinline__ void final_rows(const Args& a, int gw, int NGW, int lane) {
    unsigned char* ws = a.ws; const bf16* FF = (const bf16*)(ws + WS_FF);
    const f32x4* g1 = (const f32x4*)a.in[29] + lane;
    for (int m = gw; m < NTOK; m += NGW) {
        const v2u* mr = (const v2u*)(FF + (size_t)m * DM) + lane;
        f32x4 v[8]; float s = 0.f;
#pragma unroll
        for (int j = 0; j < 8; ++j) { const v2u u = mr[64 * j]; v[j] = (f32x4){lo2f(u.x), hi2f(u.x), lo2f(u.y), hi2f(u.y)}; s += (v[j].x * v[j].x + v[j].y * v[j].y) + (v[j].z * v[j].z + v[j].w * v[j].w); }
        const float rstd = 1.f / sqrtf(wave_sum(s) * (1.f / DM) + 1e-6f);
        f32x4* orow = (f32x4*)(a.out + (size_t)m * DM) + lane;
#pragma unroll
        for (int j = 0; j < 8; ++j) orow[64 * j] = orow[64 * j] + v[j] * rstd * g1[64 * j];
    }
}

typedef GAS unsigned gu32;
#define XB_TMO      128
#define XB_XCNT(j)  (256  + 64 * (j))
#define XB_XSUB(j)  (1280 + 64 * (j))
#define XB_XGEN(j)  (2304 + 64 * (j))
#define XB_TOP      3328
#define XB_TOPGEN   3392
#define XCD_BAR_WORDS 3456
#define XB_SPIN_CAP (1u << 18)

__device__ __forceinline__ unsigned xb_ld(unsigned* p)              { return __hip_atomic_load(p, __ATOMIC_RELAXED, __HIP_MEMORY_SCOPE_AGENT); }
__device__ __forceinline__ unsigned xb_add(unsigned* p, unsigned v) { return __hip_atomic_fetch_add(p, v, __ATOMIC_RELAXED, __HIP_MEMORY_SCOPE_AGENT); }
__device__ __forceinline__ unsigned xb_xcc_id() { return (unsigned)__builtin_amdgcn_s_getreg((3 << 11) | 20) & 0xFu; }
#define XB_SPIN(cond, bar) do { unsigned _sp = 0; while (cond) { __builtin_amdgcn_s_sleep(1); \
    if ((++_sp & 255u) == 0u) { if (xb_ld(&(bar)[XB_TMO])) break; if (_sp > XB_SPIN_CAP) { atomicAdd(&(bar)[XB_TMO], 1u); break; } } } } while (0)

struct XcdBarrier {
    unsigned* bar; unsigned x;
    volatile LAS unsigned* st;
};

__device__ __forceinline__ XcdBarrier xcd_barrier_post(unsigned* bar, volatile LAS unsigned* st) {
    XcdBarrier b; b.bar = bar; b.x = xb_xcc_id(); b.st = st;
    if (threadIdx.x == 0) (void)xb_add(&bar[XB_XCNT(b.x)], 1u);
    return b;
}
__device__ __forceinline__ void xcd_barrier_complete(unsigned* bar, unsigned x, unsigned& nloc, unsigned& nx) {
    const unsigned G = gridDim.x * gridDim.y * gridDim.z;
    unsigned sum, cnt, mine, sp = 0u;
    for (;;) {
        sum = 0u; cnt = 0u; mine = 0u;
#pragma unroll
        for (unsigned j = 0; j < 16; ++j) { const unsigned c = xb_ld(&bar[XB_XCNT(j)]); sum += c; cnt += (c > 0u) ? 1u : 0u; mine = (j == x) ? c : mine; }
        if (sum == G) break;
        __builtin_amdgcn_s_sleep(1);
        if ((++sp & 255u) == 0u) { if (xb_ld(&bar[XB_TMO])) break; if (sp > XB_SPIN_CAP) { atomicAdd(&bar[XB_TMO], 1u); break; } }
    }
    nloc = mine > 0u ? mine : 1u; nx = cnt > 0u ? cnt : 1u;
}

__device__ __forceinline__ void xcd_barrier(const XcdBarrier& b) {
    asm volatile("s_waitcnt vmcnt(0)" ::: "memory");
    __syncthreads();
    if (threadIdx.x == 0) {
        unsigned* bar = b.bar;
        __builtin_amdgcn_s_waitcnt(0);
        unsigned nloc = b.st[0], nx = b.st[1];
        if (nloc == 0u) { xcd_barrier_complete(bar, b.x, nloc, nx); b.st[0] = nloc; b.st[1] = nx; }
        const unsigned old = xb_add(&bar[XB_XSUB(b.x)], 1u);
        const unsigned gen = old / nloc;
        if (old + 1u == (gen + 1u) * nloc) {
            __builtin_amdgcn_fence(__ATOMIC_RELEASE, "agent");
            asm volatile("s_waitcnt vmcnt(0)" ::: "memory");
            const unsigned og = xb_add(&bar[XB_TOP], 1u);
            const unsigned tg = og / nx;
            if (og + 1u == (tg + 1u) * nx) xb_add(&bar[XB_TOPGEN], 1u);
            else XB_SPIN(xb_ld(&bar[XB_TOPGEN]) == tg, bar);
            __builtin_amdgcn_fence(__ATOMIC_ACQUIRE, "agent");
            xb_add(&bar[XB_XGEN(b.x)], 1u);
            asm volatile("s_waitcnt vmcnt(0)" ::: "memory");
        } else {
            XB_SPIN(xb_ld(&bar[XB_XGEN(b.x)]) == gen, bar);
            __builtin_amdgcn_fence(__ATOMIC_ACQUIRE, "agent");
            asm volatile("s_waitcnt vmcnt(0)" ::: "memory");
        }
    }
    __syncthreads();
}

__global__ void __launch_bounds__(NWAVES * 64, 2) hymba_fwd(Args args) {
    extern __shared__ __attribute__((aligned(16))) unsigned char lds[];
    cg::grid_group grid = cg::this_grid();
    LAS unsigned char* ldsl = (LAS unsigned char*)lds;
    const int tid = threadIdx.x, lane = tid & 63, wave = __builtin_amdgcn_readfirstlane(tid >> 6);
    const int G = gridDim.x, gw = blockIdx.x * NWAVES + wave, NGW = G * NWAVES;
    unsigned char* ws = args.ws;
    const int lo = args.ph_lo, hi = args.ph_hi;
    if (tid < 32) ((volatile LAS unsigned*)(ldsl + MISC_OFF))[tid] = 0u;
    __syncthreads();
    const XcdBarrier xbar = xcd_barrier_post((unsigned*)(ws + WS_CTL), (volatile LAS unsigned*)(ldsl + MISC_OFF) + 8);
#define IN(k) (lo <= (k) && (k) < hi)
#define SEAM(k) do { if (IN(k) && IN((k) + 1)) { if ((k) == 0) grid.sync(); else xcd_barrier(xbar); } } while (0)
    typedef pg8::EpiBf16<0> E0; typedef pg8::EpiBf16<2> E2;
    if (IN(0)) { p0_prologue(args, ldsl, gw, NGW, wave, lane); }
    SEAM(0);
#ifndef NO_G1
    if (IN(1)) { pg8::Gemm g{(const bf16*)(ws + WS_H), (const bf16*)(ws + WS_WIN), NTOK, ZLD, DM}; pg8::StaticOrder S; S.init(NTOK, ZLD, G, (int)blockIdx.x);
        pg8::EpiZ E{(bf16*)(ws + WS_ZM), (bf16*)(ws + WS_ZC)}; pg8::gemm_phase<pg8::EpiZ, pg8::StaticOrder, true, true>(ldsl, g, S, E); }
#endif
    SEAM(1);
    if (IN(2)) {
#ifndef NO_SHIFT
 shift_phase(args, gw, NGW, lane);
#endif
 }
    SEAM(2);
    if (IN(3)) {
#ifndef NO_SCAN
 scan_phase(args, lds, wave, lane);
#ifdef PROBE_SCAN2
 __syncthreads(); scan_phase(args, lds, wave, lane);
#endif
#endif
 }
    SEAM(3);
    if (IN(4)) {
#ifndef NO_POST
 post_phase(args, wave, lane);
#endif
 }
    SEAM(4);
#ifndef NO_G5
    if (IN(5)) { pg8::Gemm g{(const bf16*)(ws + WS_H), (const bf16*)(ws + WS_WOUT), NTOK, DM, DM}; pg8::StaticOrder S; S.init(NTOK, DM, G, (int)blockIdx.x);
        E0 E{(bf16*)(ws + WS_MIX), DM}; pg8::gemm_phase<E0, pg8::StaticOrder, true, true>(ldsl, g, S, E); }
#endif
    SEAM(5);
    if (IN(6)) { mid_rows(args, gw, NGW, lane); }
    SEAM(6);
#ifndef NO_G7
    if (IN(7)) {
#pragma unroll
        for (int s = 0; s < 3; ++s) {
            { pg8::Gemm g{(const bf16*)(ws + WS_H) + (size_t)s * SEQ * DM, (const bf16*)(ws + WS_WUP), SEQ, DFF, DM}; pg8::StaticOrder S; S.init(SEQ, DFF, G, (int)blockIdx.x);
              E2 E{(bf16*)(ws + WS_U), DFF}; pg8::gemm_phase<E2, pg8::StaticOrder, true, true>(ldsl, g, S, E); }
            xcd_barrier(xbar);
            { pg8::Gemm g{(const bf16*)(ws + WS_U), (const bf16*)(ws + WS_WDN), SEQ, DM, DFF}; pg8::StaticOrder S; S.init(SEQ, DM, G, (int)blockIdx.x);
              E0 E{(bf16*)(ws + WS_FF) + (size_t)s * SEQ * DM, DM}; pg8::gemm_phase<E0, pg8::StaticOrder, true, true>(ldsl, g, S, E); }
            if (s < 2) xcd_barrier(xbar);
        }
    }
#endif
    SEAM(7);
    if (IN(8)) { final_rows(args, gw, NGW, lane); }
#undef IN
#undef SEAM
}

extern "C" void kernel_launch(void* const* d_in, const int* in_sizes, int n_in, void* d_out, int out_size, void* d_ws, size_t ws_size, hipStream_t stream) {
    static int grid = 0;
    if (grid == 0) {
        if (n_in != 30 || ws_size < WS_END) { fprintf(stderr, "kernel_launch: unexpected n_in %d / ws %zu\n", n_in, ws_size); grid = -1; return; }
        int dev = 0, cus = 0, per_cu = 0;
        hipGetDevice(&dev); hipDeviceGetAttribute(&cus, hipDeviceAttributeMultiprocessorCount, dev);
        if (hipFuncSetAttribute((const void*)hymba_fwd, hipFuncAttributeMaxDynamicSharedMemorySize, LDS_BYTES) != hipSuccess) { fprintf(stderr, "kernel_launch: hipFuncSetAttribute failed\n"); grid = -1; return; }
        hipOccupancyMaxActiveBlocksPerMultiprocessor(&per_cu, (const void*)hymba_fwd, NWAVES * 64, LDS_BYTES);
        (void)hipGetLastError();
        if (per_cu < 1) per_cu = 1;
        grid = cus * 1;
        if (grid < 192) { fprintf(stderr, "kernel_launch: grid %d too small\n", grid); grid = -1; return; }
    }
    if (grid < 0) return;
    if (hipMemsetAsync((char*)d_ws + WS_CTL, 0, CTL_BYTES, stream) != hipSuccess) { fprintf(stderr, "kernel_launch: memset failed\n"); return; }
    Args a{};
    for (int i = 0; i < 30; ++i) a.in[i] = (const float*)d_in[i];
    a.out = (float*)d_out; a.ws = (unsigned char*)d_ws;
#ifndef N_LAUNCH_SPLIT
    a.ph_lo = 0; a.ph_hi = 9;
    void* kargs[] = {&a};
    hipError_t e = hipLaunchCooperativeKernel((const void*)hymba_fwd, dim3(grid), dim3(NWAVES * 64), kargs, LDS_BYTES, stream);
    if (e != hipSuccess) fprintf(stderr, "cooperative launch failed: %s (grid %d)\n", hipGetErrorString(e), grid);
#else
    for (int p = 0; p < 9; ++p) { a.ph_lo = p; a.ph_hi = p + 1; void* kargs[] = {&a};
        hipError_t e = hipLaunchCooperativeKernel((const void*)hymba_fwd, dim3(grid), dim3(NWAVES * 64), kargs, LDS_BYTES, stream);
        if (e != hipSuccess) fprintf(stderr, "cooperative launch %d failed: %s (grid %d)\n", p, hipGetErrorString(e), grid); }
#endif
}
```

```cpp
#include <hip/hip_runtime.h>
#include <hip/hip_cooperative_groups.h>
#include <cstdio>
#include <cstdint>
namespace cg = cooperative_groups;
namespace pg8 {
#define PG8_LAS __attribute__((address_space(3)))
typedef unsigned short bf16_t;
typedef short bf16x8 __attribute__((ext_vector_type(8)));
typedef float f32x4 __attribute__((ext_vector_type(4)));
typedef unsigned u32x4 __attribute__((ext_vector_type(4)));
constexpr int BM = 256, BK = 64, HALF = 128, HTB = HALF * BK * 2  , STAGE_BYTES = 8 * HTB, NXCD = 8, WGM = 8;

__host__ __device__ __forceinline__ int lds_byte(int r, int c) { const int st = (r >> 4) * 2 + (c >> 5), rr = r & 15, cc = c & 31, ob = rr * 64 + cc * 2; return st * 1024 + (ob ^ (((ob >> 9) & 1) << 5)); }
__host__ __device__ __forceinline__ void stage_rc(int b, int& R, int& C) { const int st = b / 1024, sb = b % 1024, swz = sb ^ (((sb >> 9) & 1) << 5); R = (st >> 1) * 16 + swz / 64; C = (st & 1) * 32 + (swz % 64) / 2; }
__host__ __device__ __forceinline__ int perm32(int rho) { const int n = rho >> 4, i = rho & 15; return 8 * (i >> 2) + 4 * n + (i & 3); }

struct Unit { int pm, pn; };
struct Gemm { const bf16_t* A; const bf16_t* Bt; int M, N, K; };

struct StaticOrder {
    int nM, nN, nwg, G, c;
    __host__ __device__ void init(int M, int N, int G_, int c_) { nM = M / BM; nN = N / BM; nwg = nM * nN; G = G_; c = c_; }
    __host__ __device__ bool next(int i, Unit& u) const {
        const long L = (long)i * G + c; if (L >= nwg) return false;
        int wgid = (int)L; { const int q = nwg / NXCD, r = nwg % NXCD, xcd = wgid % NXCD, off = wgid / NXCD; wgid = (xcd < r ? xcd * (q + 1) : r * (q + 1) + (xcd - r) * q) + off; }
        const int nig = WGM * nN, gid = wgid / nig, fm = gid * WGM, gsz = (nM - fm) < WGM ? (nM - fm) : WGM;
        u.pm = fm + ((wgid % nig) % gsz); u.pn = (wgid % nig) / gsz; return true;
    }
    __device__ __forceinline__ void a_ready(const Unit&) const {}
    __device__ __forceinline__ void done(const Unit&) const {}
};

__device__ __forceinline__ unsigned cvt_pk_bf16(float lo, float hi) { unsigned r; asm volatile("v_cvt_pk_bf16_f32 %0, %1, %2" : "=v"(r) : "v"(lo), "v"(hi)); return r; }
typedef float f32x2 __attribute__((ext_vector_type(2)));
template <int ACT> struct EpiBf16 {
    static constexpr bool PERM = true, AFTER_DRAIN = false;
    bf16_t* O; int ldc;
    __device__ __forceinline__ void operator()(const f32x4 (&acc)[2][2][4][2], const Unit& u, int wr, int wc, int fr, int fq) const {
        const int row0 = u.pm * BM + wr * 64 + fr; const int col0 = u.pn * BM + wc * 32 + 8 * fq;
#pragma unroll
        for (int ai = 0; ai < 2; ++ai)
#pragma unroll
            for (int m = 0; m < 4; ++m) { bf16_t* rowp = O + (size_t)(row0 + ai * HALF + m * 16) * ldc + col0;
#pragma unroll
                for (int bj = 0; bj < 2; ++bj) { f32x4 v0 = acc[ai][bj][m][0], v1 = acc[ai][bj][m][1];
                    if (ACT == 2) { const f32x4 z = (f32x4){0.f, 0.f, 0.f, 0.f}; v0 = __builtin_elementwise_max(v0, z); v1 = __builtin_elementwise_max(v1, z); v0 = v0 * v0; v1 = v1 * v1; }
                    u32x4 w; w.x = cvt_pk_bf16(v0[0], v0[1]); w.y = cvt_pk_bf16(v0[2], v0[3]); w.z = cvt_pk_bf16(v1[0], v1[1]); w.w = cvt_pk_bf16(v1[2], v1[3]);
                    *(u32x4*)(rowp + bj * HALF) = w; } }
    }
};


struct EpiZ {
    static constexpr bool PERM = true, AFTER_DRAIN = false;
    bf16_t* ZM; bf16_t* ZC;
    __device__ __forceinline__ void operator()(const f32x4 (&acc)[2][2][4][2], const Unit& u, int wr, int wc, int fr, int fq) const {
        const int pn = u.pn; bf16_t* O; int ldc, colt;
        if (pn < 12) { O = ZM; ldc = 3584; colt = pn * BM; } else if (pn < 20) { O = ZC; ldc = 2048; colt = (pn - 12) * BM; } else { O = ZM; ldc = 3584; colt = 3072 + (pn - 20) * BM; }
        const int row0 = u.pm * BM + wr * 64 + fr; const int col0 = colt + wc * 32 + 8 * fq;
#pragma unroll
        for (int ai = 0; ai < 2; ++ai)
#pragma unroll
            for (int m = 0; m < 4; ++m) { bf16_t* rowp = O + (size_t)(row0 + ai * HALF + m * 16) * ldc + col0;
#pragma unroll
                for (int bj = 0; bj < 2; ++bj) { const f32x4 v0 = acc[ai][bj][m][0], v1 = acc[ai][bj][m][1];
                    u32x4 w; w.x = cvt_pk_bf16(v0[0], v0[1]); w.y = cvt_pk_bf16(v0[2], v0[3]); w.z = cvt_pk_bf16(v1[0], v1[1]); w.w = cvt_pk_bf16(v1[2], v1[3]);
                    *(u32x4*)(rowp + bj * HALF) = w; } }
    }
};

template <class Epi, class Sched, bool ALIGN_EPI = false, bool SP2 = false>
__device__ __forceinline__ void gemm_phase(PG8_LAS unsigned char* lds, const Gemm g, const Sched& S, const Epi& E) {
    const int tid = threadIdx.x, wid = __builtin_amdgcn_readfirstlane(tid >> 6), lane = tid & 63, wr = wid >> 2, wc = wid & 3, fr = lane & 15, fq = lane >> 4;
    const int K = g.K, nt = K / BK;
    unsigned voffA[2], voffB[2];
#pragma unroll
    for (int i = 0; i < 2; ++i) { int R, C; stage_rc(tid * 16 + i * 8192, R, C); const int Rb = Epi::PERM ? ((R & ~31) + perm32(R & 31)) : R;
        voffA[i] = (unsigned)(R * K + C) * 2u; voffB[i] = (unsigned)(Rb * K + C) * 2u; }
    const size_t kstep = (size_t)(BK * 2);
    const size_t hstep = (size_t)HALF * K * 2;
    const size_t tstep = 2 * hstep;
    const unsigned ldsw = (unsigned)wid * 1024u;
    const int aoff = lds_byte(wr * 64 + fr, fq * 8), boff = lds_byte(wc * 32 + fr, fq * 8);
#define PG8_SA(b, h) (((b) * 2 + (h)) * HTB)
#define PG8_SB(b, h) ((4 + (b) * 2 + (h)) * HTB)
#define PG8_STAGE(bufoff, gbase, voff) do { _Pragma("unroll") for (int _i = 0; _i < 2; ++_i) \
        __builtin_amdgcn_global_load_lds((const unsigned*)((const char*)(gbase) + (voff)[_i]), (PG8_LAS unsigned*)(lds + (bufoff) + ldsw + _i * 8192), 16, 0, 0); } while (0)
#define PG8_LDA(dst, b, h) do { _Pragma("unroll") for (int m = 0; m < 4; ++m) _Pragma("unroll") for (int k = 0; k < 2; ++k) dst[m][k] = *(const PG8_LAS bf16x8*)(lds + PG8_SA(b, h) + aoff + m * 2048 + k * 1024); } while (0)
#define PG8_LDB(dst, b, h) do { _Pragma("unroll") for (int n = 0; n < 2; ++n) _Pragma("unroll") for (int k = 0; k < 2; ++k) dst[n][k] = *(const PG8_LAS bf16x8*)(lds + PG8_SB(b, h) + boff + n * 2048 + k * 1024); } while (0)
#define PG8_MMA(ai, bj, At, Bt) do { __builtin_amdgcn_s_setprio(1); _Pragma("unroll") for (int m = 0; m < 4; ++m) _Pragma("unroll") for (int n = 0; n < 2; ++n) _Pragma("unroll") for (int k = 0; k < 2; ++k) \
        acc[ai][bj][m][n] = __builtin_amdgcn_mfma_f32_16x16x32_bf16(Bt[n][k], At[m][k], acc[ai][bj][m][n], 0, 0, 0); __builtin_amdgcn_s_setprio(0); } while (0)
#define PG8_WAIT_V(n) asm volatile("s_waitcnt vmcnt(" #n ")" ::: "memory")
#define PG8_WAIT_L(n) asm volatile("s_waitcnt lgkmcnt(" #n ")" ::: "memory")
#define PG8_BAR __builtin_amdgcn_s_barrier()
#define PG8_SCHED __builtin_amdgcn_sched_barrier(0)
    Unit cur, nxt; int ui = 0;
    if (!S.next(0, cur)) return;
    f32x4 acc[2][2][4][2];
#pragma unroll
    for (int a = 0; a < 2; ++a)
#pragma unroll
        for (int b = 0; b < 2; ++b)
#pragma unroll
            for (int m = 0; m < 4; ++m)
#pragma unroll
                for (int n = 0; n < 2; ++n) acc[a][b][m][n] = (f32x4){0.f, 0.f, 0.f, 0.f};
    bf16x8 At[4][2], B0[2][2], B1[2][2];
    const char* cA = (const char*)g.A + (size_t)cur.pm * tstep; const char* cB = (const char*)g.Bt + (size_t)cur.pn * tstep;
    S.a_ready(cur);
    if constexpr (SP2) {
        PG8_STAGE(PG8_SB(0, 0), cB, voffB); PG8_STAGE(PG8_SB(0, 1), cB + hstep, voffB); PG8_STAGE(PG8_SA(0, 0), cA, voffA); PG8_STAGE(PG8_SA(0, 1), cA + hstep, voffA);
        if (wr == 1) PG8_BAR;
        PG8_WAIT_V(2); PG8_BAR;
        PG8_STAGE(PG8_SB(1, 0), cB + kstep, voffB); PG8_STAGE(PG8_SA(1, 0), cA + kstep, voffA); PG8_STAGE(PG8_SB(1, 1), cB + hstep + kstep, voffB);
        PG8_WAIT_V(6); PG8_BAR;
    } else {
        PG8_STAGE(PG8_SB(0, 0), cB, voffB); PG8_STAGE(PG8_SA(0, 0), cA, voffA); PG8_STAGE(PG8_SB(0, 1), cB + hstep, voffB); PG8_STAGE(PG8_SA(0, 1), cA + hstep, voffA);
        if (wr == 1) PG8_BAR;
        PG8_WAIT_V(4); PG8_BAR;
        PG8_STAGE(PG8_SB(1, 0), cB + kstep, voffB); PG8_STAGE(PG8_SA(1, 0), cA + kstep, voffA); PG8_STAGE(PG8_SB(1, 1), cB + hstep + kstep, voffB);
        PG8_WAIT_V(6); PG8_BAR;
    }
    for (;;) {
        const bool has_next = S.next(ui + 1, nxt);
        const char* nA = has_next ? (const char*)g.A + (size_t)nxt.pm * tstep : cA; const char* nB = has_next ? (const char*)g.Bt + (size_t)nxt.pn * tstep : cB;
        for (int t = 0; t < nt; t += 2) {
            const bool last = (t == nt - 2);
            const char* a1 = cA + (size_t)(t + 1) * kstep;
            const char* a2 = last ? nA : cA + (size_t)(t + 2) * kstep; const char* b2 = last ? nB : cB + (size_t)(t + 2) * kstep;
            const char* a3 = a2 + kstep; const char* b3 = b2 + kstep;
            if (last && has_next) S.a_ready(nxt);
            if constexpr (SP2) {
            PG8_LDB(B0, 0, 0); PG8_LDB(B1, 0, 1); PG8_SCHED; PG8_LDA(At, 0, 0); PG8_STAGE(PG8_SA(1, 1), a1 + hstep, voffA);
            PG8_WAIT_V(8); PG8_WAIT_L(0); PG8_BAR; PG8_MMA(0, 0, At, B0); PG8_MMA(0, 1, At, B1); PG8_BAR; PG8_SCHED;
            PG8_LDA(At, 0, 1); PG8_STAGE(PG8_SB(0, 0), b2, voffB); PG8_STAGE(PG8_SB(0, 1), b2 + hstep, voffB); PG8_STAGE(PG8_SA(0, 0), a2, voffA);
            PG8_WAIT_V(8); PG8_WAIT_L(0); PG8_BAR; PG8_MMA(1, 0, At, B0); PG8_MMA(1, 1, At, B1); PG8_BAR; PG8_SCHED;
            PG8_LDB(B0, 1, 0); PG8_LDB(B1, 1, 1); PG8_SCHED; PG8_LDA(At, 1, 0); PG8_STAGE(PG8_SA(0, 1), a2 + hstep, voffA);
            PG8_WAIT_V(8); PG8_WAIT_L(0); PG8_BAR; PG8_MMA(0, 0, At, B0); PG8_MMA(0, 1, At, B1); PG8_BAR; PG8_SCHED;
            PG8_LDA(At, 1, 1); PG8_STAGE(PG8_SB(1, 0), b3, voffB); PG8_STAGE(PG8_SB(1, 1), b3 + hstep, voffB); PG8_STAGE(PG8_SA(1, 0), a3, voffA);
            PG8_WAIT_V(8); PG8_WAIT_L(0); PG8_BAR; PG8_MMA(1, 0, At, B0); PG8_MMA(1, 1, At, B1); PG8_BAR; PG8_SCHED;
            } else {
            PG8_LDB(B0, 0, 0); PG8_SCHED; PG8_LDA(At, 0, 0); PG8_STAGE(PG8_SA(1, 1), a1 + hstep, voffA);
            PG8_WAIT_L(8); PG8_BAR; PG8_WAIT_L(0); PG8_MMA(0, 0, At, B0); PG8_BAR; PG8_SCHED;
            PG8_LDB(B1, 0, 1); PG8_STAGE(PG8_SB(0, 0), b2, voffB);
            PG8_BAR; PG8_WAIT_L(0); PG8_MMA(0, 1, At, B1); PG8_BAR;
            PG8_LDA(At, 0, 1); PG8_STAGE(PG8_SA(0, 0), a2, voffA);
            PG8_BAR; PG8_WAIT_L(0); PG8_MMA(1, 0, At, B0); PG8_BAR; PG8_SCHED;
            PG8_STAGE(PG8_SB(0, 1), b2 + hstep, voffB);
            PG8_WAIT_V(6); PG8_BAR; PG8_MMA(1, 1, At, B1); PG8_BAR;
            PG8_LDB(B0, 1, 0); PG8_SCHED; PG8_LDA(At, 1, 0); PG8_STAGE(PG8_SA(0, 1), a2 + hstep, voffA);
            PG8_WAIT_L(8); PG8_BAR; PG8_WAIT_L(0); PG8_MMA(0, 0, At, B0); PG8_BAR; PG8_SCHED;
            PG8_LDB(B1, 1, 1); PG8_STAGE(PG8_SB(1, 0), b3, voffB);
            PG8_BAR; PG8_WAIT_L(0); PG8_MMA(0, 1, At, B1); PG8_BAR;
            PG8_LDA(At, 1, 1); PG8_STAGE(PG8_SA(1, 0), a3, voffA);
            PG8_BAR; PG8_WAIT_L(0); PG8_MMA(1, 0, At, B0); PG8_BAR; PG8_SCHED;
            PG8_STAGE(PG8_SB(1, 1), b3 + hstep, voffB);
            PG8_WAIT_V(6); PG8_BAR; PG8_MMA(1, 1, At, B1); PG8_BAR;
            }
        }
        if constexpr (ALIGN_EPI) { if (wr == 0) PG8_BAR; }
        if constexpr (!Epi::AFTER_DRAIN) { E(acc, cur, wr, wc, fr, fq); S.done(cur); }
        if (!has_next) break;
#pragma unroll
        for (int a = 0; a < 2; ++a)
#pragma unroll
            for (int b = 0; b < 2; ++b)
#pragma unroll
                for (int m = 0; m < 4; ++m)
#pragma unroll
                    for (int n = 0; n < 2; ++n) acc[a][b][m][n] = (f32x4){0.f, 0.f, 0.f, 0.f};
        cur = nxt; cA = nA; cB = nB; ++ui;
        if constexpr (ALIGN_EPI) { if (wr == 1) PG8_BAR; }
    }
    PG8_WAIT_V(0);
    if constexpr (!ALIGN_EPI) { if (wr == 0) PG8_BAR; }
    PG8_BAR;
    if constexpr (Epi::AFTER_DRAIN) { E.fused(acc, cur, wr, wc, fr, fq, lds, wid, lane); S.done(cur); }
#undef PG8_SA
#undef PG8_SB
#undef PG8_STAGE
#undef PG8_LDA
#undef PG8_LDB
#undef PG8_MMA
#undef PG8_WAIT_V
#undef PG8_WAIT_L
#undef PG8_BAR
#undef PG8_SCHED
}
}

#define GAS __attribute__((address_space(1)))
#define LAS __attribute__((address_space(3)))
typedef unsigned short bf16;
typedef unsigned v4u __attribute__((ext_vector_type(4)));
typedef unsigned v2u __attribute__((ext_vector_type(2)));
typedef float f32x4 __attribute__((ext_vector_type(4)));
typedef float f32x2 __attribute__((ext_vector_type(2)));
typedef short bf16x8 __attribute__((ext_vector_type(8)));
typedef _Float16 h2 __attribute__((ext_vector_type(2)));
#define LDS_WAIT() asm volatile("s_waitcnt lgkmcnt(0)" ::: "memory")

constexpr int NWAVES = 8;
constexpr int NTOK = 24576, SEQ = 8192, DM = 2048, DR = 1024, DFF = 8192;
constexpr int ZLD = 5632, ZC_CA = 3072, ZC_CB = 4096, ZC_L = 5120;
constexpr int ZMLD = 3584, ZM_L = 3072, ZCLD = 2048;
constexpr size_t MiB = 1u << 20;
constexpr size_t WS_WIN = 0, WS_WOUT = 22 * MiB, WS_WUP = 30 * MiB, WS_WDN = 62 * MiB, WS_SMALL = 94 * MiB, WS_XL = 95 * MiB, WS_XG = 107 * MiB,
                 WS_BONUS = 115 * MiB, WS_H = 118 * MiB, WS_ZC = 214 * MiB, WS_ZM = 310 * MiB, WS_END = 502 * MiB;
constexpr size_t SM_G2T = 0, SM_W2TF = 384 * 1024, SM_W2TB = 512 * 1024, SM_A2TF = 640 * 1024, SM_A2TB = 768 * 1024;
constexpr size_t WS_YF = WS_ZM, WS_YB = WS_ZM + 96 * MiB, WS_MIX = WS_ZC, WS_U = WS_ZC, WS_FF = WS_ZC + 128 * MiB;
constexpr size_t OUT_RS = 0, OUT_KS = 48 * MiB, OUT_VS = 96 * MiB, OUT_KK = 144 * MiB;
constexpr int LDS_BYTES = 147456, MISC_OFF = 131072 + 320;
constexpr size_t WS_CTL = 117 * MiB, CTL_BYTES = 16384;

struct Args { const float* in[30]; float* out; unsigned char* ws; int ph_lo, ph_hi; };

__device__ __forceinline__ float lo2f(unsigned u) { return __uint_as_float(u << 16); }
__device__ __forceinline__ float hi2f(unsigned u) { return __uint_as_float(u & 0xffff0000u); }
__device__ __forceinline__ unsigned f2bf(float f) { unsigned u = __float_as_uint(f); return (u + 0x7fffu + ((u >> 16) & 1u)) >> 16; }
__device__ __forceinline__ unsigned pk2(float lo, float hi) { unsigned r; asm volatile("v_cvt_pk_bf16_f32 %0, %1, %2" : "=v"(r) : "v"(lo), "v"(hi)); return r; }
__device__ __forceinline__ float fsigmoid(float x) { return __builtin_amdgcn_rcpf(1.f + __builtin_amdgcn_exp2f(-1.44269504f * x)); }
__device__ __forceinline__ float ftanh(float x) { return 1.f - 2.f * __builtin_amdgcn_rcpf(1.f + __builtin_amdgcn_exp2f(2.88539008f * x)); }
__device__ __forceinline__ float wave_sum(float v) {
#pragma unroll
    for (int o = 1; o < 64; o <<= 1) v += __shfl_xor(v, o);
    return v;
}
template <int CTRL> __device__ __forceinline__ float dppf(float x) { return __int_as_float(__builtin_amdgcn_update_dpp(0, __float_as_int(x), CTRL, 0xF, 0xF, true)); }
__device__ __forceinline__ float red8(float x) { x += dppf<0xB1>(x); x += dppf<0x4E>(x); x += dppf<0x141>(x); return x; }
__device__ __forceinline__ const float* xrow(const Args& a, int m) { return m < 16384 ? a.in[0] + (size_t)m * DM : a.in[1] + (size_t)(m - 16384) * DM; }

__device__ __forceinline__ void tr_item(const float* W, int ldw, int k0, int sc0, bf16* WT, int ldt, int dr0, LAS float* scr, int lane) {
#pragma unroll 8
    for (int i = 0; i < 32; ++i) { const int kk = 2 * i + (lane >> 5); scr[kk * 33 + (lane & 31)] = W[(size_t)(k0 + kk) * ldw + sc0 + (lane & 31)]; }
    LDS_WAIT(); asm volatile("" ::: "memory");
    const int c = lane & 7;
#pragma unroll
    for (int j = 0; j < 4; ++j) { const int n = (lane >> 3) + 8 * j; const LAS float* s = scr + (8 * c) * 33 + n;
        v4u o; o.x = pk2(s[0 * 33], s[1 * 33]); o.y = pk2(s[2 * 33], s[3 * 33]); o.z = pk2(s[4 * 33], s[5 * 33]); o.w = pk2(s[6 * 33], s[7 * 33]);
        *(v4u*)(WT + (size_t)(dr0 + n) * ldt + k0 + 8 * c) = o; }
    LDS_WAIT(); asm volatile("" ::: "memory");
}
__device__ __forceinline__ void rms_row_bf16(const float* xr_, const float* g, bf16* orow, int lane) {
    const f32x4* xr = (const f32x4*)xr_ + lane; const f32x4* gr = (const f32x4*)g + lane;
    f32x4 v[8]; float s = 0.f;
#pragma unroll
    for (int j = 0; j < 8; ++j) { v[j] = xr[64 * j]; s += (v[j].x * v[j].x + v[j].y * v[j].y) + (v[j].z * v[j].z + v[j].w * v[j].w); }
    const float rstd = 1.f / sqrtf(wave_sum(s) * (1.f / DM) + 1e-6f);
    v2u* o8 = (v2u*)orow + lane;
#pragma unroll
    for (int j = 0; j < 8; ++j) { const f32x4 gg = gr[64 * j]; v2u o; o.x = pk2(v[j].x * rstd * gg.x, v[j].y * rstd * gg.y); o.y = pk2(v[j].z * rstd * gg.z, v[j].w * rstd * gg.w); o8[64 * j] = o; }
}
__device__ __forceinline__ void p0_prologue(const Args& a, LAS unsigned char* lds, int gw, int NGW, int wave, int lane) {
    unsigned char* ws = a.ws;
    LAS float* scr = (LAS float*)(lds + wave * 16384);
    bf16* WIN = (bf16*)(ws + WS_WIN); bf16* WOUT = (bf16*)(ws + WS_WOUT);
    constexpr int I_IN = 32 * 173, I_OUT = 32 * 64, I_S = 32;
    constexpr int NITEMS = I_IN + I_OUT + 4 * I_S;
    for (int it = gw; it < NITEMS; it += NGW) {
        int r = it;
        if (r < I_IN) { const int kb = r / 173, nb = r % 173, sc0 = nb * 32; const int dr0 = sc0 < 3072 ? sc0 : (sc0 < 3488 ? ZC_L + (sc0 - 3072) : ZC_CA + (sc0 - 3488));
            tr_item(a.in[3], 5536, kb * 64, sc0, WIN, DM, dr0, scr, lane); continue; } r -= I_IN;
        if (r < I_OUT) { tr_item(a.in[24], DM, (r / 64) * 64, (r % 64) * 32, WOUT, DM, (r % 64) * 32, scr, lane); continue; } r -= I_OUT;
        { const int which = r / I_S, nb = r % I_S; const float* src = which == 0 ? a.in[7] : which == 1 ? a.in[9] : which == 2 ? a.in[11] : a.in[13];
          bf16* dst = (bf16*)(ws + WS_SMALL + (which == 0 ? SM_W2TF : which == 1 ? SM_W2TB : which == 2 ? SM_A2TF : SM_A2TB));
          tr_item(src, DR, 0, nb * 32, dst, 64, nb * 32, scr, lane); }
    }
    { const int gt = gw * 64 + lane, NGT = NGW * 64;
      v4u zz = {0u, 0u, 0u, 0u}; v4u* zp = (v4u*)(WIN + (size_t)5536 * DM);
      for (int i = gt; i < 96 * DM / 8; i += NGT) zp[i] = zz;
      bf16* G2T = (bf16*)(ws + WS_SMALL + SM_G2T); const float* g2 = a.in[14];
      for (int i = gt; i < 160 * 1024; i += NGT) { const int k = i >> 10, n = i & 1023; G2T[n * 160 + k] = (bf16)f2bf(g2[i]); } }
    bf16* H = (bf16*)(ws + WS_H);
    for (int m = gw; m < NTOK; m += NGW) rms_row_bf16(xrow(a, m), a.in[2], H + (size_t)m * DM, lane);
}
__device__ __forceinline__ void p0_mlp_weights(const Args& a, LAS unsigned char* lds, int gw, int NGW, int wave, int lane) {
    unsigned char* ws = a.ws;
    LAS float* scr = (LAS float*)(lds + wave * 16384);
    bf16* WUP = (bf16*)(ws + WS_WUP); bf16* WDN = (bf16*)(ws + WS_WDN);
    constexpr int I_UP = 32 * 256, I_DN = 128 * 64;
    for (int it = gw; it < I_UP + I_DN; it += NGW) {
        int r = it;
        if (r < I_UP) { tr_item(a.in[27], DFF, (r / 256) * 64, (r % 256) * 32, WUP, DM, (r % 256) * 32, scr, lane); continue; } r -= I_UP;
        tr_item(a.in[28], DM, (r / 64) * 64, (r % 64) * 32, WDN, DFF, (r % 64) * 32, scr, lane);
    }
}

__device__ __forceinline__ void shift_phase(const Args& a, int gw, int NGW, int lane) {
    unsigned char* ws = a.ws;
    const bf16* Z = (const bf16*)(ws + WS_ZM);
    bf16* RS = (bf16*)((unsigned char*)a.out + OUT_RS); bf16* KS = (bf16*)((unsigned char*)a.out + OUT_KS);
    bf16* VS = (bf16*)((unsigned char*)a.out + OUT_VS); bf16* KK = (bf16*)((unsigned char*)a.out + OUT_KK);
    bf16* XL = (bf16*)(ws + WS_XL); bf16* XG = (bf16*)(ws + WS_XG); float* BONUS = (float*)(ws + WS_BONUS);
    const float* mup = a.in[4]; const float* mun = a.in[5]; const float* k_k = a.in[15]; const float* r_k = a.in[17];
    const int hp2 = lane >> 5, n2 = (lane & 31) * 2;
    for (int m = gw; m < NTOK; m += NGW) {
        const int t = m & (SEQ - 1); const bool hp = t > 0, hn = t < SEQ - 1;
        const bf16* z0 = Z + (size_t)m * ZMLD; const bf16* zp = z0 - ZMLD; const bf16* zn = z0 + ZMLD;
#pragma unroll 2
        for (int hh = 0; hh < 8; ++hh) {
            const int c = (hh * 2 + hp2) * 64 + n2;
            float s[3][2];
#pragma unroll
            for (int ar = 0; ar < 3; ++ar) { const int col = ar * 1024 + c;
                const unsigned zc = *(const unsigned*)(z0 + col); const unsigned zpv = hp ? *(const unsigned*)(zp + col) : 0u; const unsigned znv = hn ? *(const unsigned*)(zn + col) : 0u;
                const f32x2 mp = *(const f32x2*)(mup + col), mn = *(const f32x2*)(mun + col);
                const float x0 = lo2f(zc), x1 = hi2f(zc);
                s[ar][0] = x0 + mp.x * (lo2f(zpv) - x0) + mn.x * (lo2f(znv) - x0);
                s[ar][1] = x1 + mp.y * (hi2f(zpv) - x1) + mn.y * (hi2f(znv) - x1); }
            const f32x2 kkw = *(const f32x2*)(k_k + c), rkw = *(const f32x2*)(r_k + c);
            const float kr0 = s[1][0] * kkw.x, kr1 = s[1][1] * kkw.y;
            float ss = kr0 * kr0 + kr1 * kr1, bs = s[0][0] * s[1][0] * rkw.x + s[0][1] * s[1][1] * rkw.y;
#pragma unroll
            for (int o = 1; o < 32; o <<= 1) { ss += __shfl_xor(ss, o); bs += __shfl_xor(bs, o); }
            const float inv = 1.f / fmaxf(sqrtf(ss), 1e-12f);
            const size_t o = (size_t)m * DR + c;
            *(unsigned*)(RS + o) = pk2(s[0][0], s[0][1]); *(unsigned*)(KS + o) = pk2(s[1][0], s[1][1]);
            *(unsigned*)(VS + o) = pk2(s[2][0], s[2][1]); *(unsigned*)(KK + o) = pk2(kr0 * inv, kr1 * inv);
            if ((lane & 31) == 0) BONUS[m * 16 + hh * 2 + hp2] = bs;
        }
#pragma unroll
        for (int p = 0; p < 7; ++p) { const int j = p * 64 + lane;
            if (j < 416) { const int col = ZM_L + j, og = 3072 + j;
                const float x0 = lo2f(z0[col]); const float xp = hp ? lo2f(zp[col]) : 0.f; const float xn = hn ? lo2f(zn[col]) : 0.f;
                const float sv = x0 + mup[og] * (xp - x0) + mun[og] * (xn - x0);
                if (j < 128) XL[(size_t)m * 256 + j] = (bf16)f2bf(ftanh(sv));
                else if (j < 256) XL[(size_t)m * 256 + j] = (bf16)f2bf(sv);
                else XG[(size_t)m * 160 + (j - 256)] = (bf16)f2bf(fsigmoid(sv)); } }
    }
}

#define TR_STAGE(D_, N_) { const bool up_ = (lane & (D_)) != 0; _Pragma("unroll") for (int i_ = 0; i_ < (N_) / 2; ++i_) { \
    const float keep_ = up_ ? vals[i_ + (N_) / 2] : vals[i_]; const float send_ = up_ ? vals[i_] : vals[i_ + (N_) / 2]; vals[i_] = keep_ + __shfl_xor(send_, (D_)); } }
__device__ __forceinline__ void conv_phase(const Args& a, unsigned char* lds, int tid, int wave, int lane, int u0, int ustride) {
    unsigned char* ws = a.ws;
    const bf16* Z = (const bf16*)(ws + WS_ZC); bf16* MIXIN = (bf16*)(ws + WS_H);
    h2* utile = (h2*)lds;
    float* part = (float*)(lds + 126976);
    f32x2* stats = (f32x2*)(lds + 126976 + 2048);
    const float* dw_w = a.in[20]; const float* dw_b = a.in[21]; const float* cln_w = a.in[22]; const float* cln_b = a.in[23];
    const int cp = tid;
    for (int unit = u0; unit < NTOK / 32; unit += ustride) {
        const int m0 = unit * 32, t0 = m0 & (SEQ - 1);
        for (int idx = tid; idx < 62 * 512; idx += 512) { const int row = idx >> 9, c2 = idx & 511; const int t = t0 - 15 + row;
            h2 u = {(_Float16)0.f, (_Float16)0.f};
            if (t >= 0 && t < SEQ) { const bf16* zr = Z + (size_t)(m0 - 15 + row) * ZCLD; const unsigned za = *(const unsigned*)(zr + 2 * c2), zb = *(const unsigned*)(zr + 1024 + 2 * c2);
                u.x = (_Float16)(lo2f(za) * fsigmoid(lo2f(zb))); u.y = (_Float16)(hi2f(za) * fsigmoid(hi2f(zb))); }
            utile[idx] = u; }
        __syncthreads();
        f32x2 w[31];
#pragma unroll
        for (int j = 0; j < 31; ++j) w[j] = *(const f32x2*)(dw_w + j * 1024 + 2 * cp);
        const f32x2 bias = *(const f32x2*)(dw_b + 2 * cp);
        f32x2 out[32];
#pragma unroll
        for (int tb = 0; tb < 4; ++tb) {
            f32x2 acc[8];
#pragma unroll
            for (int o = 0; o < 8; ++o) acc[o] = bias;
#pragma unroll
            for (int jj = 0; jj < 38; ++jj) { const h2 uh = utile[(tb * 8 + jj) * 512 + cp]; const f32x2 u = {(float)uh.x, (float)uh.y};
#pragma unroll
                for (int o = 0; o < 8; ++o) { const int j = jj - o; if (j >= 0 && j < 31) acc[o] = u * w[j] + acc[o]; } }
#pragma unroll
            for (int o = 0; o < 8; ++o) out[tb * 8 + o] = acc[o];
            asm volatile("" ::: "memory");
        }
        float vals[64];
#pragma unroll
        for (int t = 0; t < 32; ++t) { vals[2 * t] = out[t].x + out[t].y; vals[2 * t + 1] = out[t].x * out[t].x + out[t].y * out[t].y; }
        TR_STAGE(32, 64) TR_STAGE(16, 32) TR_STAGE(8, 16) TR_STAGE(4, 8) TR_STAGE(2, 4) TR_STAGE(1, 2)
        part[wave * 64 + lane] = vals[0];
        __syncthreads();
        if (tid < 32) { float s = 0.f, q = 0.f;
#pragma unroll
            for (int wv = 0; wv < 8; ++wv) { s += part[wv * 64 + 2 * tid]; q += part[wv * 64 + 2 * tid + 1]; }
            const float mean = s * (1.f / 1024.f); const float var = q * (1.f / 1024.f) - mean * mean;
            stats[tid] = (f32x2){mean, 1.f / sqrtf(var + 1e-5f)}; }
        __syncthreads();
        const f32x2 lw = *(const f32x2*)(cln_w + 2 * cp), lb = *(const f32x2*)(cln_b + 2 * cp);
#pragma unroll
        for (int t = 0; t < 32; ++t) { const f32x2 st = stats[t];
            const float y0 = (out[t].x - st.x) * st.y * lw.x + lb.x, y1 = (out[t].y - st.x) * st.y * lw.y + lb.y;
            *(unsigned*)(MIXIN + (size_t)(m0 + t) * DM + DR + 2 * cp) = pk2(y0 * fsigmoid(y0), y1 * fsigmoid(y1)); }
        __syncthreads();
    }
}

constexpr int SC_LD = 68, SC_ARR = 32 * SC_LD, SC_ARR4 = SC_ARR / 4, SC_BUF = (5 * SC_ARR + SC_LD) * 4;
struct ScanOps { f32x4 q0, q1, a0, a1, m0, m1, r0, r1; float vv; };
__device__ __forceinline__ void ld_ops(ScanOps& o, const float* cb, int i, int ks, int rr) {
    const f32x4* p = (const f32x4*)(cb + i * SC_LD + ks * 8);
    o.q0 = p[0]; o.q1 = p[1]; o.a0 = p[SC_ARR4]; o.a1 = p[SC_ARR4 + 1]; o.m0 = p[2 * SC_ARR4]; o.m1 = p[2 * SC_ARR4 + 1]; o.r0 = p[3 * SC_ARR4]; o.r1 = p[3 * SC_ARR4 + 1];
    o.vv = cb[4 * SC_ARR + i * SC_LD + rr];
}
__device__ __forceinline__ void scan_phase(const Args& a, unsigned char* lds, int wave, int lane) {
    if (blockIdx.x >= 192) {
        const int wi = blockIdx.x - 192, nw = gridDim.x - 192;
        conv_phase(a, lds, threadIdx.x, wave, lane, wi, nw);
        p0_mlp_weights(a, (LAS unsigned char*)lds, wi * NWAVES + wave, nw * NWAVES, wave, lane);
        return;
    }
    unsigned char* ws = a.ws;
    const int scan = blockIdx.x >> 1, half = blockIdx.x & 1, dir = scan & 1, sh = scan >> 1, seq = sh >> 4, h = sh & 15;
    const size_t row0 = (size_t)seq * SEQ;
    const bf16* RS = (const bf16*)((unsigned char*)a.out + OUT_RS); const bf16* KS = (const bf16*)((unsigned char*)a.out + OUT_KS);
    const bf16* VS = (const bf16*)((unsigned char*)a.out + OUT_VS); const bf16* KK = (const bf16*)((unsigned char*)a.out + OUT_KK);
    const bf16* XL = (const bf16*)(ws + WS_XL);
    float* Y = (float*)(ws + (dir ? WS_YB : WS_YF));
    constexpr int NCH = SEQ / 32;
    const int ks = lane & 7, rr = half * 32 + (wave & 3) * 8 + (lane >> 3);
    f32x2 S0 = {0.f, 0.f}, S1 = S0, S2 = S0, S3 = S0;
    float* ybase = Y + row0 * DR + h * 64 + rr;
    const int pw = wave & 3, fr = lane & 15, fq = lane >> 4, cl = pw * 16 + fq * 4, gcol = h * 64 + cl;
    bf16x8 Bw0, Bw1, Ba0, Ba1; f32x4 w0v, a0v, kav;
    {
        const bf16* W2T = (const bf16*)(ws + WS_SMALL + (dir ? SM_W2TB : SM_W2TF)); const bf16* A2T = (const bf16*)(ws + WS_SMALL + (dir ? SM_A2TB : SM_A2TF));
        const size_t bo = (size_t)(h * 64 + pw * 16 + fr) * 64 + fq * 8;
        Bw0 = *(const bf16x8*)(W2T + bo); Bw1 = *(const bf16x8*)(W2T + bo + 32); Ba0 = *(const bf16x8*)(A2T + bo); Ba1 = *(const bf16x8*)(A2T + bo + 32);
        w0v = *(const f32x4*)((dir ? a.in[8] : a.in[6]) + gcol); a0v = *(const f32x4*)((dir ? a.in[12] : a.in[10]) + gcol); kav = *(const f32x4*)(a.in[16] + gcol);
    }
    for (int c = 0; c <= NCH; ++c) {
        if (wave >= 4) {
            if (c < NCH) {
                float* cb = (float*)(lds + (c & 1) * SC_BUF);
                f32x4 off = {0.f, 0.f, 0.f, 0.f};
#pragma unroll
                for (int mt = 0; mt < 2; ++mt) {
                    const int i = mt * 16 + fr, step = c * 32 + i, t = dir ? (SEQ - 1 - step) : step; const size_t m = row0 + t;
                    const bf16* xl = XL + m * 256 + dir * 64 + fq * 8;
                    const bf16x8 At0 = *(const bf16x8*)(xl), At1 = *(const bf16x8*)(xl + 32), Aa0 = *(const bf16x8*)(xl + 128), Aa1 = *(const bf16x8*)(xl + 160);
                    const size_t go = m * DR + gcol;
                    const v2u r4 = *(const v2u*)(RS + go), k4 = *(const v2u*)(KS + go), v4 = *(const v2u*)(VS + go), q4 = *(const v2u*)(KK + go);
                    f32x4 aw = {0.f, 0.f, 0.f, 0.f}, aa = aw;
                    aw = __builtin_amdgcn_mfma_f32_16x16x32_bf16(Bw0, At0, aw, 0, 0, 0); aw = __builtin_amdgcn_mfma_f32_16x16x32_bf16(Bw1, At1, aw, 0, 0, 0);
                    aa = __builtin_amdgcn_mfma_f32_16x16x32_bf16(Ba0, Aa0, aa, 0, 0, 0); aa = __builtin_amdgcn_mfma_f32_16x16x32_bf16(Ba1, Aa1, aa, 0, 0, 0);
                    const f32x4 rv = {lo2f(r4.x), hi2f(r4.x), lo2f(r4.y), hi2f(r4.y)}, kv = {lo2f(k4.x), hi2f(k4.x), lo2f(k4.y), hi2f(k4.y)};
                    const f32x4 vv = {lo2f(v4.x), hi2f(v4.x), lo2f(v4.y), hi2f(v4.y)}, qv = {lo2f(q4.x), hi2f(q4.x), lo2f(q4.y), hi2f(q4.y)};
                    f32x4 lw, cum, av, pm1, pin, pp;
#pragma unroll
                    for (int j = 0; j < 4; ++j) {
                        lw[j] = -0.87500596f * fsigmoid(w0v[j] + aw[j]); av[j] = fsigmoid(a0v[j] + aa[j]);
                        float x = lw[j]; x += dppf<0x111>(x); x += dppf<0x112>(x); x += dppf<0x114>(x); x += dppf<0x118>(x);
                        cum[j] = x + off[j];
                        pm1[j] = __builtin_amdgcn_exp2f(cum[j] - lw[j]); pin[j] = __builtin_amdgcn_exp2f(-cum[j]); pp[j] = __builtin_amdgcn_exp2f(cum[j]);
                    }
                    if (mt == 0) {
#pragma unroll
                        for (int j = 0; j < 4; ++j) off[j] = __shfl(cum[j], (lane & 48) | 15);
                    }
                    f32x4* dst = (f32x4*)(cb + i * SC_LD + cl);
                    dst[0] = qv * pm1; dst[SC_ARR4] = qv * av * pin; dst[2 * SC_ARR4] = kv * (1.f + (av - 1.f) * kav) * pin; dst[3 * SC_ARR4] = rv * pp; dst[4 * SC_ARR4] = vv;
                    if (i == 31) *(f32x4*)(cb + 5 * SC_ARR + cl) = pp;
                }
            }
        } else if (c > 0) {
            const float* cb = (const float*)(lds + ((c - 1) & 1) * SC_BUF);
            const int cbase = (c - 1) * 32;
            ScanOps o[3]; ld_ops(o[0], cb, 0, ks, rr); ld_ops(o[1], cb, 1, ks, rr);
#pragma unroll
            for (int g = 0; g < 4; ++g) {
                float ysel = 0.f;
#pragma unroll
                for (int j = 0; j < 8; ++j) {
                    const int i = g * 8 + j;
                    if (i + 2 < 32) ld_ops(o[(i + 2) % 3], cb, i + 2, ks, rr);
                    const ScanOps& x = o[i % 3];
                    f32x2 acc = S0 * x.q0.xy, acc2 = S1 * x.q0.zw; acc = S2 * x.q1.xy + acc; acc2 = S3 * x.q1.zw + acc2; acc = acc + acc2;
                    const float sa = red8(acc.x + acc.y);
                    const f32x2 sav = {sa, sa}, vv2 = {x.vv, x.vv};
                    S0 = vv2 * x.m0.xy + S0; S1 = vv2 * x.m0.zw + S1; S2 = vv2 * x.m1.xy + S2; S3 = vv2 * x.m1.zw + S3;
                    S0 = S0 - sav * x.a0.xy; S1 = S1 - sav * x.a0.zw; S2 = S2 - sav * x.a1.xy; S3 = S3 - sav * x.a1.zw;
                    f32x2 yq = S0 * x.r0.xy, yq2 = S1 * x.r0.zw; yq = S2 * x.r1.xy + yq; yq2 = S3 * x.r1.zw + yq2; yq = yq + yq2;
                    const float y = red8(yq.x + yq.y);
                    ysel = (ks == j) ? y : ysel;
                }
                const int step = cbase + g * 8 + ks, t = dir ? (SEQ - 1 - step) : step;
                ybase[(size_t)t * DR] = ysel;
            }
            const f32x4* pe = (const f32x4*)(cb + 5 * SC_ARR + ks * 8);
            const f32x4 pe0 = pe[0], pe1 = pe[1];
            S0 = S0 * pe0.xy; S1 = S1 * pe0.zw; S2 = S2 * pe1.xy; S3 = S3 * pe1.zw;
        }
        __syncthreads();
    }
}

__device__ __forceinline__ void post_phase(const Args& a, int wave, int lane) {
    unsigned char* ws = a.ws;
    const bf16* XG = (const bf16*)(ws + WS_XG); const bf16* G2T = (const bf16*)(ws + WS_SMALL + SM_G2T);
    const float* YF = (const float*)(ws + WS_YF); const float* YB = (const float*)(ws + WS_YB); const float* BONUS = (const float*)(ws + WS_BONUS);
    const bf16* VS = (const bf16*)((unsigned char*)a.out + OUT_VS); bf16* MIXIN = (bf16*)(ws + WS_H);
    const float* gn_w = a.in[18]; const float* gn_b = a.in[19];
    const int fr = lane & 15, fq = lane >> 4, n0 = wave * 128;
    for (int unit = blockIdx.x; unit < NTOK / 32; unit += gridDim.x) {
        const int m0 = unit * 32;
        f32x4 acc[2][8];
#pragma unroll
        for (int mt = 0; mt < 2; ++mt)
#pragma unroll
            for (int nt = 0; nt < 8; ++nt) acc[mt][nt] = (f32x4){0.f, 0.f, 0.f, 0.f};
#pragma unroll
        for (int kq = 0; kq < 5; ++kq) {
            bf16x8 A[2];
#pragma unroll
            for (int mt = 0; mt < 2; ++mt) A[mt] = *(const bf16x8*)(XG + (size_t)(m0 + mt * 16 + fr) * 160 + kq * 32 + fq * 8);
#pragma unroll
            for (int nt = 0; nt < 8; ++nt) { const bf16x8 B = *(const bf16x8*)(G2T + (size_t)(n0 + nt * 16 + fr) * 160 + kq * 32 + fq * 8);
#pragma unroll
                for (int mt = 0; mt < 2; ++mt) acc[mt][nt] = __builtin_amdgcn_mfma_f32_16x16x32_bf16(B, A[mt], acc[mt][nt], 0, 0, 0); }
        }
#pragma unroll
        for (int mt = 0; mt < 2; ++mt) { const size_t m = (size_t)(m0 + mt * 16 + fr);
#pragma unroll
            for (int hh = 0; hh < 2; ++hh) { const int hd = wave * 2 + hh;
                f32x4 y[4]; float s = 0.f;
#pragma unroll
                for (int q = 0; q < 4; ++q) { const size_t o = m * DR + n0 + (hh * 4 + q) * 16 + fq * 4; y[q] = *(const f32x4*)(YF + o) + *(const f32x4*)(YB + o); s += (y[q].x + y[q].y) + (y[q].z + y[q].w); }
                s += __shfl_xor(s, 16); s += __shfl_xor(s, 32);
                const float mean = s * (1.f / 64.f); float ss = 0.f;
#pragma unroll
                for (int q = 0; q < 4; ++q) { y[q] = y[q] - mean; ss += (y[q].x * y[q].x + y[q].y * y[q].y) + (y[q].z * y[q].z + y[q].w * y[q].w); }
                ss += __shfl_xor(ss, 16); ss += __shfl_xor(ss, 32);
                const float rstd = 1.f / sqrtf(ss * (1.f / 64.f) + 64e-5f); const float bs = BONUS[m * 16 + hd];
#pragma unroll
                for (int q = 0; q < 4; ++q) { const int c = n0 + (hh * 4 + q) * 16 + fq * 4; const f32x4 gw4 = *(const f32x4*)(gn_w + c), gb4 = *(const f32x4*)(gn_b + c);
                    const v2u v4 = *(const v2u*)(VS + m * DR + c); const f32x4 vv = {lo2f(v4.x), hi2f(v4.x), lo2f(v4.y), hi2f(v4.y)};
                    const f32x4 o = (y[q] * rstd * gw4 + gb4 + bs * vv) * acc[mt][hh * 4 + q];
                    v2u ov; ov.x = pk2(o.x, o.y); ov.y = pk2(o.z, o.w); *(v2u*)(MIXIN + m * DM + c) = ov; }
            }
        }
    }
}

__device__ __forceinline__ void mid_rows(const Args& a, int gw, int NGW, int lane) {
    unsigned char* ws = a.ws; const bf16* MIX = (const bf16*)(ws + WS_MIX); bf16* H = (bf16*)(ws + WS_H);
    const f32x4* g1 = (const f32x4*)a.in[25] + lane; const f32x4* g2 = (const f32x4*)a.in[26] + lane;
    for (int m = gw; m < NTOK; m += NGW) {
        const v2u* mr = (const v2u*)(MIX + (size_t)m * DM) + lane; const f32x4* xr = (const f32x4*)xrow(a, m) + lane;
        f32x4 v[8], xv[8]; float s = 0.f;
#pragma unroll
        for (int j = 0; j < 8; ++j) xv[j] = __builtin_nontemporal_load(xr + 64 * j);
#pragma unroll
        for (int j = 0; j < 8; ++j) { const v2u u = __builtin_nontemporal_load(mr + 64 * j); v[j] = (f32x4){lo2f(u.x), hi2f(u.x), lo2f(u.y), hi2f(u.y)}; s += (v[j].x * v[j].x + v[j].y * v[j].y) + (v[j].z * v[j].z + v[j].w * v[j].w); }
        const float rstd = 1.f / sqrtf(wave_sum(s) * (1.f / DM) + 1e-6f); float s1 = 0.f;
        f32x4* orow = (f32x4*)(a.out + (size_t)m * DM) + lane;
#pragma unroll
        for (int j = 0; j < 8; ++j) { v[j] = xv[j] + v[j] * rstd * g1[64 * j]; orow[64 * j] = v[j]; s1 += (v[j].x * v[j].x + v[j].y * v[j].y) + (v[j].z * v[j].z + v[j].w * v[j].w); }
        const float rstd1 = 1.f / sqrtf(wave_sum(s1) * (1.f / DM) + 1e-6f);
        v2u* hr = (v2u*)(H + (size_t)m * DM) + lane;
#pragma unroll
        for (int j = 0; j < 8; ++j) { const f32x4 gg = g2[64 * j]; v2u o; o.x = pk2(v[j].x * rstd1 * gg.x, v[j].y * rstd1 * gg.y); o.y = pk2(v[j].z * rstd1 * gg.z, v[j].w * rstd1 * gg.w); hr[64 * j] = o; }
    }
}
__device__ __forceinline__ void final_rows(const Args& a, int gw, int NGW, int lane) {
    unsigned char* ws = a.ws; const bf16* FF = (const bf16*)(ws + WS_FF);
    const f32x4* g1 = (const f32x4*)a.in[29] + lane;
    for (int m = gw; m < NTOK; m += NGW) {
        const v2u* mr = (const v2u*)(FF + (size_t)m * DM) + lane;
        f32x4* orow = (f32x4*)(a.out + (size_t)m * DM) + lane;
        f32x4 v[8], xv[8]; float s = 0.f;
#pragma unroll
        for (int j = 0; j < 8; ++j) xv[j] = orow[64 * j];
#pragma unroll
        for (int j = 0; j < 8; ++j) { const v2u u = __builtin_nontemporal_load(mr + 64 * j); v[j] = (f32x4){lo2f(u.x), hi2f(u.x), lo2f(u.y), hi2f(u.y)}; s += (v[j].x * v[j].x + v[j].y * v[j].y) + (v[j].z * v[j].z + v[j].w * v[j].w); }
        const float rstd = 1.f / sqrtf(wave_sum(s) * (1.f / DM) + 1e-6f);
#pragma unroll
        for (int j = 0; j < 8; ++j) __builtin_nontemporal_store(xv[j] + v[j] * rstd * g1[64 * j], orow + 64 * j);
    }
}

typedef GAS unsigned gu32;
#define XB_TMO      128
#define XB_XCNT(j)  (256  + 64 * (j))
#define XB_XSUB(j)  (1280 + 64 * (j))
#define XB_XGEN(j)  (2304 + 64 * (j))
#define XB_TOP      3328
#define XB_TOPGEN   3392
#define XCD_BAR_WORDS 3456
#define XB_SPIN_CAP (1u << 18)

__device__ __forceinline__ unsigned xb_ld(unsigned* p)              { return __hip_atomic_load(p, __ATOMIC_RELAXED, __HIP_MEMORY_SCOPE_AGENT); }
__device__ __forceinline__ unsigned xb_add(unsigned* p, unsigned v) { return __hip_atomic_fetch_add(p, v, __ATOMIC_RELAXED, __HIP_MEMORY_SCOPE_AGENT); }
__device__ __forceinline__ unsigned xb_xcc_id() { return (unsigned)__builtin_amdgcn_s_getreg((3 << 11) | 20) & 0xFu; }
#define XB_SPIN(cond, bar) do { unsigned _sp = 0; while (cond) { __builtin_amdgcn_s_sleep(1); \
    if ((++_sp & 255u) == 0u) { if (xb_ld(&(bar)[XB_TMO])) break; if (_sp > XB_SPIN_CAP) { atomicAdd(&(bar)[XB_TMO], 1u); break; } } } } while (0)

struct XcdBarrier {
    unsigned* bar; unsigned x;
    volatile LAS unsigned* st;
};

__device__ __forceinline__ XcdBarrier xcd_barrier_post(unsigned* bar, volatile LAS unsigned* st) {
    XcdBarrier b; b.bar = bar; b.x = xb_xcc_id(); b.st = st;
    if (threadIdx.x == 0) (void)xb_add(&bar[XB_XCNT(b.x)], 1u);
    return b;
}
__device__ __forceinline__ void xcd_barrier_complete(unsigned* bar, unsigned x, unsigned& nloc, unsigned& nx) {
    const unsigned G = gridDim.x * gridDim.y * gridDim.z;
    unsigned sum, cnt, mine, sp = 0u;
    for (;;) {
        sum = 0u; cnt = 0u; mine = 0u;
#pragma unroll
        for (unsigned j = 0; j < 16; ++j) { const unsigned c = xb_ld(&bar[XB_XCNT(j)]); sum += c; cnt += (c > 0u) ? 1u : 0u; mine = (j == x) ? c : mine; }
        if (sum == G) break;
        __builtin_amdgcn_s_sleep(1);
        if ((++sp & 255u) == 0u) { if (xb_ld(&bar[XB_TMO])) break; if (sp > XB_SPIN_CAP) { atomicAdd(&bar[XB_TMO], 1u); break; } }
    }
    nloc = mine > 0u ? mine : 1u; nx = cnt > 0u ? cnt : 1u;
}

__device__ __forceinline__ void xcd_barrier(const XcdBarrier& b) {
    asm volatile("s_waitcnt vmcnt(0)" ::: "memory");
    __syncthreads();
    if (threadIdx.x == 0) {
        unsigned* bar = b.bar;
        __builtin_amdgcn_s_waitcnt(0);
        unsigned nloc = b.st[0], nx = b.st[1];
        if (nloc == 0u) { xcd_barrier_complete(bar, b.x, nloc, nx); b.st[0] = nloc; b.st[1] = nx; }
        const unsigned old = xb_add(&bar[XB_XSUB(b.x)], 1u);
        const unsigned gen = old / nloc;
        if (old + 1u == (gen + 1u) * nloc) {
            __builtin_amdgcn_fence(__ATOMIC_RELEASE, "agent");
            asm volatile("s_waitcnt vmcnt(0)" ::: "memory");
            const unsigned og = xb_add(&bar[XB_TOP], 1u);
            const unsigned tg = og / nx;
            if (og + 1u == (tg + 1u) * nx) xb_add(&bar[XB_TOPGEN], 1u);
            else XB_SPIN(xb_ld(&bar[XB_TOPGEN]) == tg, bar);
            __builtin_amdgcn_fence(__ATOMIC_ACQUIRE, "agent");
            xb_add(&bar[XB_XGEN(b.x)], 1u);
            asm volatile("s_waitcnt vmcnt(0)" ::: "memory");
        } else {
            XB_SPIN(xb_ld(&bar[XB_XGEN(b.x)]) == gen, bar);
            __builtin_amdgcn_fence(__ATOMIC_ACQUIRE, "agent");
            asm volatile("s_waitcnt vmcnt(0)" ::: "memory");
        }
    }
    __syncthreads();
}

__global__ void __launch_bounds__(NWAVES * 64, 2) hymba_fwd(Args args) {
    extern __shared__ __attribute__((aligned(16))) unsigned char lds[];
    cg::grid_group grid = cg::this_grid();
    LAS unsigned char* ldsl = (LAS unsigned char*)lds;
    const int tid = threadIdx.x, lane = tid & 63, wave = __builtin_amdgcn_readfirstlane(tid >> 6);
    const int G = gridDim.x, gw = blockIdx.x * NWAVES + wave, NGW = G * NWAVES;
    unsigned char* ws = args.ws;
    const int lo = args.ph_lo, hi = args.ph_hi;
    if (tid < 32) ((volatile LAS unsigned*)(ldsl + MISC_OFF))[tid] = 0u;
    __syncthreads();
    const XcdBarrier xbar = xcd_barrier_post((unsigned*)(ws + WS_CTL), (volatile LAS unsigned*)(ldsl + MISC_OFF) + 8);
#define IN(k) (lo <= (k) && (k) < hi)
#define SEAM(k) do { if (IN(k) && IN((k) + 1)) { if ((k) == 0) grid.sync(); else xcd_barrier(xbar); } } while (0)
    typedef pg8::EpiBf16<0> E0; typedef pg8::EpiBf16<2> E2;
    if (IN(0)) { p0_prologue(args, ldsl, gw, NGW, wave, lane); }
    SEAM(0);
#ifndef NO_G1
    if (IN(1)) { pg8::Gemm g{(const bf16*)(ws + WS_H), (const bf16*)(ws + WS_WIN), NTOK, ZLD, DM}; pg8::StaticOrder S; S.init(NTOK, ZLD, G, (int)blockIdx.x);
        pg8::EpiZ E{(bf16*)(ws + WS_ZM), (bf16*)(ws + WS_ZC)}; pg8::gemm_phase<pg8::EpiZ, pg8::StaticOrder, true, true>(ldsl, g, S, E); }
#endif
    SEAM(1);
    if (IN(2)) {
#ifndef NO_SHIFT
 shift_phase(args, gw, NGW, lane);
#endif
 }
    SEAM(2);
    if (IN(3)) {
#ifndef NO_SCAN
 scan_phase(args, lds, wave, lane);
#ifdef PROBE_SCAN2
 __syncthreads(); scan_phase(args, lds, wave, lane);
#endif
#endif
 }
    SEAM(3);
    if (IN(4)) {
#ifndef NO_POST
 post_phase(args, wave, lane);
#endif
 }
    SEAM(4);
#ifndef NO_G5
    if (IN(5)) { pg8::Gemm g{(const bf16*)(ws + WS_H), (const bf16*)(ws + WS_WOUT), NTOK, DM, DM}; pg8::StaticOrder S; S.init(NTOK, DM, G, (int)blockIdx.x);
        E0 E{(bf16*)(ws + WS_MIX), DM}; pg8::gemm_phase<E0, pg8::StaticOrder, true, true>(ldsl, g, S, E); }
#endif
    SEAM(5);
    if (IN(6)) { mid_rows(args, gw, NGW, lane); }
    SEAM(6);
#ifndef NO_G7
    if (IN(7)) {
#pragma unroll
        for (int s = 0; s < 3; ++s) {
            { pg8::Gemm g{(const bf16*)(ws + WS_H) + (size_t)s * SEQ * DM, (const bf16*)(ws + WS_WUP), SEQ, DFF, DM}; pg8::StaticOrder S; S.init(SEQ, DFF, G, (int)blockIdx.x);
              E2 E{(bf16*)(ws + WS_U), DFF}; pg8::gemm_phase<E2, pg8::StaticOrder, true, true>(ldsl, g, S, E); }
            xcd_barrier(xbar);
            { pg8::Gemm g{(const bf16*)(ws + WS_U), (const bf16*)(ws + WS_WDN), SEQ, DM, DFF}; pg8::StaticOrder S; S.init(SEQ, DM, G, (int)blockIdx.x);
              E0 E{(bf16*)(ws + WS_FF) + (size_t)s * SEQ * DM, DM}; pg8::gemm_phase<E0, pg8::StaticOrder, true, true>(ldsl, g, S, E); }
            if (s < 2) xcd_barrier(xbar);
        }
    }
#endif
    SEAM(7);
    if (IN(8)) { final_rows(args, gw, NGW, lane); }
#undef IN
#undef SEAM
}

extern "C" void kernel_launch(void* const* d_in, const int* in_sizes, int n_in, void* d_out, int out_size, void* d_ws, size_t ws_size, hipStream_t stream) {
    static int grid = 0;
    if (grid == 0) {
        if (n_in != 30 || ws_size < WS_END) { fprintf(stderr, "kernel_launch: unexpected n_in %d / ws %zu\n", n_in, ws_size); grid = -1; return; }
        int dev = 0, cus = 0, per_cu = 0;
        hipGetDevice(&dev); hipDeviceGetAttribute(&cus, hipDeviceAttributeMultiprocessorCount, dev);
        if (hipFuncSetAttribute((const void*)hymba_fwd, hipFuncAttributeMaxDynamicSharedMemorySize, LDS_BYTES) != hipSuccess) { fprintf(stderr, "kernel_launch: hipFuncSetAttribute failed\n"); grid = -1; return; }
        hipOccupancyMaxActiveBlocksPerMultiprocessor(&per_cu, (const void*)hymba_fwd, NWAVES * 64, LDS_BYTES);
        (void)hipGetLastError();
        if (per_cu < 1) per_cu = 1;
        grid = cus * 1;
        if (grid < 192) { fprintf(stderr, "kernel_launch: grid %d too small\n", grid); grid = -1; return; }
    }
    if (grid < 0) return;
    if (hipMemsetAsync((char*)d_ws + WS_CTL, 0, CTL_BYTES, stream) != hipSuccess) { fprintf(stderr, "kernel_launch: memset failed\n"); return; }
    Args a{};
    for (int i = 0; i < 30; ++i) a.in[i] = (const float*)d_in[i];
    a.out = (float*)d_out; a.ws = (unsigned char*)d_ws;
#ifndef N_LAUNCH_SPLIT
    a.ph_lo = 0; a.ph_hi = 9;
    void* kargs[] = {&a};
    hipError_t e = hipLaunchCooperativeKernel((const void*)hymba_fwd, dim3(grid), dim3(NWAVES * 64), kargs, LDS_BYTES, stream);
    if (e != hipSuccess) fprintf(stderr, "cooperative launch failed: %s (grid %d)\n", hipGetErrorString(e), grid);
#else
    for (int p = 0; p < 9; ++p) { a.ph_lo = p; a.ph_hi = p + 1; void* kargs[] = {&a};
        hipError_t e = hipLaunchCooperativeKernel((const void*)hymba_fwd, dim3(grid), dim3(NWAVES * 64), kargs, LDS_BYTES, stream);
        if (e != hipSuccess) fprintf(stderr, "cooperative launch %d failed: %s (grid %d)\n", p, hipGetErrorString(e), grid); }
#endif
}
```

```cpp
#include <hip/hip_runtime.h>
#include <hip/hip_cooperative_groups.h>
#include <cstdio>
#include <cstdint>
namespace cg = cooperative_groups;
namespace pg8 {
#define PG8_LAS __attribute__((address_space(3)))
typedef unsigned short bf16_t;
typedef short bf16x8 __attribute__((ext_vector_type(8)));
typedef float f32x4 __attribute__((ext_vector_type(4)));
typedef unsigned u32x4 __attribute__((ext_vector_type(4)));
constexpr int BM = 256, BK = 64, HALF = 128, HTB = HALF * BK * 2  , STAGE_BYTES = 8 * HTB, NXCD = 8, WGM = 8;

__host__ __device__ __forceinline__ int lds_byte(int r, int c) { const int st = (r >> 4) * 2 + (c >> 5), rr = r & 15, cc = c & 31, ob = rr * 64 + cc * 2; return st * 1024 + (ob ^ (((ob >> 9) & 1) << 5)); }
__host__ __device__ __forceinline__ void stage_rc(int b, int& R, int& C) { const int st = b / 1024, sb = b % 1024, swz = sb ^ (((sb >> 9) & 1) << 5); R = (st >> 1) * 16 + swz / 64; C = (st & 1) * 32 + (swz % 64) / 2; }
__host__ __device__ __forceinline__ int perm32(int rho) { const int n = rho >> 4, i = rho & 15; return 8 * (i >> 2) + 4 * n + (i & 3); }

struct Unit { int pm, pn; };
struct Gemm { const bf16_t* A; const bf16_t* Bt; int M, N, K; };

struct StaticOrder {
    int nM, nN, nwg, G, c;
    __host__ __device__ void init(int M, int N, int G_, int c_) { nM = M / BM; nN = N / BM; nwg = nM * nN; G = G_; c = c_; }
    __host__ __device__ bool next(int i, Unit& u) const {
        const long L = (long)i * G + c; if (L >= nwg) return false;
        int wgid = (int)L; { const int q = nwg / NXCD, r = nwg % NXCD, xcd = wgid % NXCD, off = wgid / NXCD; wgid = (xcd < r ? xcd * (q + 1) : r * (q + 1) + (xcd - r) * q) + off; }
        const int nig = WGM * nN, gid = wgid / nig, fm = gid * WGM, gsz = (nM - fm) < WGM ? (nM - fm) : WGM;
        u.pm = fm + ((wgid % nig) % gsz); u.pn = (wgid % nig) / gsz; return true;
    }
    __device__ __forceinline__ void a_ready(const Unit&) const {}
    __device__ __forceinline__ void done(const Unit&) const {}
};

__device__ __forceinline__ unsigned cvt_pk_bf16(float lo, float hi) { unsigned r; asm volatile("v_cvt_pk_bf16_f32 %0, %1, %2" : "=v"(r) : "v"(lo), "v"(hi)); return r; }
typedef float f32x2 __attribute__((ext_vector_type(2)));
template <int ACT> struct EpiBf16 {
    static constexpr bool PERM = true, AFTER_DRAIN = false;
    bf16_t* O; int ldc;
    __device__ __forceinline__ void operator()(const f32x4 (&acc)[2][2][4][2], const Unit& u, int wr, int wc, int fr, int fq) const {
        const int row0 = u.pm * BM + wr * 64 + fr; const int col0 = u.pn * BM + wc * 32 + 8 * fq;
#pragma unroll
        for (int ai = 0; ai < 2; ++ai)
#pragma unroll
            for (int m = 0; m < 4; ++m) { bf16_t* rowp = O + (size_t)(row0 + ai * HALF + m * 16) * ldc + col0;
#pragma unroll
                for (int bj = 0; bj < 2; ++bj) { f32x4 v0 = acc[ai][bj][m][0], v1 = acc[ai][bj][m][1];
                    if (ACT == 2) { const f32x4 z = (f32x4){0.f, 0.f, 0.f, 0.f}; v0 = __builtin_elementwise_max(v0, z); v1 = __builtin_elementwise_max(v1, z); v0 = v0 * v0; v1 = v1 * v1; }
                    u32x4 w; w.x = cvt_pk_bf16(v0[0], v0[1]); w.y = cvt_pk_bf16(v0[2], v0[3]); w.z = cvt_pk_bf16(v1[0], v1[1]); w.w = cvt_pk_bf16(v1[2], v1[3]);
                    *(u32x4*)(rowp + bj * HALF) = w; } }
    }
};


struct EpiZ {
    static constexpr bool PERM = true, AFTER_DRAIN = false;
    bf16_t* ZM; bf16_t* ZC;
    __device__ __forceinline__ void operator()(const f32x4 (&acc)[2][2][4][2], const Unit& u, int wr, int wc, int fr, int fq) const {
        const int pn = u.pn; bf16_t* O; int ldc, colt;
        if (pn < 12) { O = ZM; ldc = 3584; colt = pn * BM; } else if (pn < 20) { O = ZC; ldc = 2048; colt = (pn - 12) * BM; } else { O = ZM; ldc = 3584; colt = 3072 + (pn - 20) * BM; }
        const int row0 = u.pm * BM + wr * 64 + fr; const int col0 = colt + wc * 32 + 8 * fq;
#pragma unroll
        for (int ai = 0; ai < 2; ++ai)
#pragma unroll
            for (int m = 0; m < 4; ++m) { bf16_t* rowp = O + (size_t)(row0 + ai * HALF + m * 16) * ldc + col0;
#pragma unroll
                for (int bj = 0; bj < 2; ++bj) { const f32x4 v0 = acc[ai][bj][m][0], v1 = acc[ai][bj][m][1];
                    u32x4 w; w.x = cvt_pk_bf16(v0[0], v0[1]); w.y = cvt_pk_bf16(v0[2], v0[3]); w.z = cvt_pk_bf16(v1[0], v1[1]); w.w = cvt_pk_bf16(v1[2], v1[3]);
                    *(u32x4*)(rowp + bj * HALF) = w; } }
    }
};

template <class Epi, class Sched, bool ALIGN_EPI = false, bool SP2 = false>
__device__ __forceinline__ void gemm_phase(PG8_LAS unsigned char* lds, const Gemm g, const Sched& S, const Epi& E) {
    const int tid = threadIdx.x, wid = __builtin_amdgcn_readfirstlane(tid >> 6), lane = tid & 63, wr = wid >> 2, wc = wid & 3, fr = lane & 15, fq = lane >> 4;
    const int K = g.K, nt = K / BK;
    unsigned voffA[2], voffB[2];
#pragma unroll
    for (int i = 0; i < 2; ++i) { int R, C; stage_rc(tid * 16 + i * 8192, R, C); const int Rb = Epi::PERM ? ((R & ~31) + perm32(R & 31)) : R;
        voffA[i] = (unsigned)(R * K + C) * 2u; voffB[i] = (unsigned)(Rb * K + C) * 2u; }
    const size_t kstep = (size_t)(BK * 2);
    const size_t hstep = (size_t)HALF * K * 2;
    const size_t tstep = 2 * hstep;
    const unsigned ldsw = (unsigned)wid * 1024u;
    const int aoff = lds_byte(wr * 64 + fr, fq * 8), boff = lds_byte(wc * 32 + fr, fq * 8);
#define PG8_SA(b, h) (((b) * 2 + (h)) * HTB)
#define PG8_SB(b, h) ((4 + (b) * 2 + (h)) * HTB)
#define PG8_STAGE(bufoff, gbase, voff) do { _Pragma("unroll") for (int _i = 0; _i < 2; ++_i) \
        __builtin_amdgcn_global_load_lds((const unsigned*)((const char*)(gbase) + (voff)[_i]), (PG8_LAS unsigned*)(lds + (bufoff) + ldsw + _i * 8192), 16, 0, 0); } while (0)
#define PG8_LDA(dst, b, h) do { _Pragma("unroll") for (int m = 0; m < 4; ++m) _Pragma("unroll") for (int k = 0; k < 2; ++k) dst[m][k] = *(const PG8_LAS bf16x8*)(lds + PG8_SA(b, h) + aoff + m * 2048 + k * 1024); } while (0)
#define PG8_LDB(dst, b, h) do { _Pragma("unroll") for (int n = 0; n < 2; ++n) _Pragma("unroll") for (int k = 0; k < 2; ++k) dst[n][k] = *(const PG8_LAS bf16x8*)(lds + PG8_SB(b, h) + boff + n * 2048 + k * 1024); } while (0)
#define PG8_MMA(ai, bj, At, Bt) do { __builtin_amdgcn_s_setprio(1); _Pragma("unroll") for (int m = 0; m < 4; ++m) _Pragma("unroll") for (int n = 0; n < 2; ++n) _Pragma("unroll") for (int k = 0; k < 2; ++k) \
        acc[ai][bj][m][n] = __builtin_amdgcn_mfma_f32_16x16x32_bf16(Bt[n][k], At[m][k], acc[ai][bj][m][n], 0, 0, 0); __builtin_amdgcn_s_setprio(0); } while (0)
#define PG8_WAIT_V(n) asm volatile("s_waitcnt vmcnt(" #n ")" ::: "memory")
#define PG8_WAIT_L(n) asm volatile("s_waitcnt lgkmcnt(" #n ")" ::: "memory")
#define PG8_BAR __builtin_amdgcn_s_barrier()
#define PG8_SCHED __builtin_amdgcn_sched_barrier(0)
    Unit cur, nxt; int ui = 0;
    if (!S.next(0, cur)) return;
    f32x4 acc[2][2][4][2];
#pragma unroll
    for (int a = 0; a < 2; ++a)
#pragma unroll
        for (int b = 0; b < 2; ++b)
#pragma unroll
            for (int m = 0; m < 4; ++m)
#pragma unroll
                for (int n = 0; n < 2; ++n) acc[a][b][m][n] = (f32x4){0.f, 0.f, 0.f, 0.f};
    bf16x8 At[4][2], B0[2][2], B1[2][2];
    const char* cA = (const char*)g.A + (size_t)cur.pm * tstep; const char* cB = (const char*)g.Bt + (size_t)cur.pn * tstep;
    S.a_ready(cur);
    if constexpr (SP2) {
        PG8_STAGE(PG8_SB(0, 0), cB, voffB); PG8_STAGE(PG8_SB(0, 1), cB + hstep, voffB); PG8_STAGE(PG8_SA(0, 0), cA, voffA); PG8_STAGE(PG8_SA(0, 1), cA + hstep, voffA);
        if (wr == 1) PG8_BAR;
        PG8_WAIT_V(2); PG8_BAR;
        PG8_STAGE(PG8_SB(1, 0), cB + kstep, voffB); PG8_STAGE(PG8_SA(1, 0), cA + kstep, voffA); PG8_STAGE(PG8_SB(1, 1), cB + hstep + kstep, voffB);
        PG8_WAIT_V(6); PG8_BAR;
    } else {
        PG8_STAGE(PG8_SB(0, 0), cB, voffB); PG8_STAGE(PG8_SA(0, 0), cA, voffA); PG8_STAGE(PG8_SB(0, 1), cB + hstep, voffB); PG8_STAGE(PG8_SA(0, 1), cA + hstep, voffA);
        if (wr == 1) PG8_BAR;
        PG8_WAIT_V(4); PG8_BAR;
        PG8_STAGE(PG8_SB(1, 0), cB + kstep, voffB); PG8_STAGE(PG8_SA(1, 0), cA + kstep, voffA); PG8_STAGE(PG8_SB(1, 1), cB + hstep + kstep, voffB);
        PG8_WAIT_V(6); PG8_BAR;
    }
    for (;;) {
        const bool has_next = S.next(ui + 1, nxt);
        const char* nA = has_next ? (const char*)g.A + (size_t)nxt.pm * tstep : cA; const char* nB = has_next ? (const char*)g.Bt + (size_t)nxt.pn * tstep : cB;
        for (int t = 0; t < nt; t += 2) {
            const bool last = (t == nt - 2);
            const char* a1 = cA + (size_t)(t + 1) * kstep;
            const char* a2 = last ? nA : cA + (size_t)(t + 2) * kstep; const char* b2 = last ? nB : cB + (size_t)(t + 2) * kstep;
            const char* a3 = a2 + kstep; const char* b3 = b2 + kstep;
            if (last && has_next) S.a_ready(nxt);
            if constexpr (SP2) {
            PG8_LDB(B0, 0, 0); PG8_LDB(B1, 0, 1); PG8_SCHED; PG8_LDA(At, 0, 0); PG8_STAGE(PG8_SA(1, 1), a1 + hstep, voffA);
            PG8_WAIT_V(8); PG8_WAIT_L(0); PG8_BAR; PG8_MMA(0, 0, At, B0); PG8_MMA(0, 1, At, B1); PG8_BAR; PG8_SCHED;
            PG8_LDA(At, 0, 1); PG8_STAGE(PG8_SB(0, 0), b2, voffB); PG8_STAGE(PG8_SB(0, 1), b2 + hstep, voffB); PG8_STAGE(PG8_SA(0, 0), a2, voffA);
            PG8_WAIT_V(8); PG8_WAIT_L(0); PG8_BAR; PG8_MMA(1, 0, At, B0); PG8_MMA(1, 1, At, B1); PG8_BAR; PG8_SCHED;
            PG8_LDB(B0, 1, 0); PG8_LDB(B1, 1, 1); PG8_SCHED; PG8_LDA(At, 1, 0); PG8_STAGE(PG8_SA(0, 1), a2 + hstep, voffA);
            PG8_WAIT_V(8); PG8_WAIT_L(0); PG8_BAR; PG8_MMA(0, 0, At, B0); PG8_MMA(0, 1, At, B1); PG8_BAR; PG8_SCHED;
            PG8_LDA(At, 1, 1); PG8_STAGE(PG8_SB(1, 0), b3, voffB); PG8_STAGE(PG8_SB(1, 1), b3 + hstep, voffB); PG8_STAGE(PG8_SA(1, 0), a3, voffA);
            PG8_WAIT_V(8); PG8_WAIT_L(0); PG8_BAR; PG8_MMA(1, 0, At, B0); PG8_MMA(1, 1, At, B1); PG8_BAR; PG8_SCHED;
            } else {
            PG8_LDB(B0, 0, 0); PG8_SCHED; PG8_LDA(At, 0, 0); PG8_STAGE(PG8_SA(1, 1), a1 + hstep, voffA);
            PG8_WAIT_L(8); PG8_BAR; PG8_WAIT_L(0); PG8_MMA(0, 0, At, B0); PG8_BAR; PG8_SCHED;
            PG8_LDB(B1, 0, 1); PG8_STAGE(PG8_SB(0, 0), b2, voffB);
            PG8_BAR; PG8_WAIT_L(0); PG8_MMA(0, 1, At, B1); PG8_BAR;
            PG8_LDA(At, 0, 1); PG8_STAGE(PG8_SA(0, 0), a2, voffA);
            PG8_BAR; PG8_WAIT_L(0); PG8_MMA(1, 0, At, B0); PG8_BAR; PG8_SCHED;
            PG8_STAGE(PG8_SB(0, 1), b2 + hstep, voffB);
            PG8_WAIT_V(6); PG8_BAR; PG8_MMA(1, 1, At, B1); PG8_BAR;
            PG8_LDB(B0, 1, 0); PG8_SCHED; PG8_LDA(At, 1, 0); PG8_STAGE(PG8_SA(0, 1), a2 + hstep, voffA);
            PG8_WAIT_L(8); PG8_BAR; PG8_WAIT_L(0); PG8_MMA(0, 0, At, B0); PG8_BAR; PG8_SCHED;
            PG8_LDB(B1, 1, 1); PG8_STAGE(PG8_SB(1, 0), b3, voffB);
            PG8_BAR; PG8_WAIT_L(0); PG8_MMA(0, 1, At, B1); PG8_BAR;
            PG8_LDA(At, 1, 1); PG8_STAGE(PG8_SA(1, 0), a3, voffA);
            PG8_BAR; PG8_WAIT_L(0); PG8_MMA(1, 0, At, B0); PG8_BAR; PG8_SCHED;
            PG8_STAGE(PG8_SB(1, 1), b3 + hstep, voffB);
            PG8_WAIT_V(6); PG8_BAR; PG8_MMA(1, 1, At, B1); PG8_BAR;
            }
        }
        if constexpr (ALIGN_EPI) { if (wr == 0) PG8_BAR; }
        if constexpr (!Epi::AFTER_DRAIN) { E(acc, cur, wr, wc, fr, fq); S.done(cur); }
        if (!has_next) break;
#pragma unroll
        for (int a = 0; a < 2; ++a)
#pragma unroll
            for (int b = 0; b < 2; ++b)
#pragma unroll
                for (int m = 0; m < 4; ++m)
#pragma unroll
                    for (int n = 0; n < 2; ++n) acc[a][b][m][n] = (f32x4){0.f, 0.f, 0.f, 0.f};
        cur = nxt; cA = nA; cB = nB; ++ui;
        if constexpr (ALIGN_EPI) { if (wr == 1) PG8_BAR; }
    }
    PG8_WAIT_V(0);
    if constexpr (!ALIGN_EPI) { if (wr == 0) PG8_BAR; }
    PG8_BAR;
    if constexpr (Epi::AFTER_DRAIN) { E.fused(acc, cur, wr, wc, fr, fq, lds, wid, lane); S.done(cur); }
#undef PG8_SA
#undef PG8_SB
#undef PG8_STAGE
#undef PG8_LDA
#undef PG8_LDB
#undef PG8_MMA
#undef PG8_WAIT_V
#undef PG8_WAIT_L
#undef PG8_BAR
#undef PG8_SCHED
}
}

#define GAS __attribute__((address_space(1)))
#define LAS __attribute__((address_space(3)))
typedef unsigned short bf16;
typedef unsigned v4u __attribute__((ext_vector_type(4)));
typedef unsigned v2u __attribute__((ext_vector_type(2)));
typedef float f32x4 __attribute__((ext_vector_type(4)));
typedef float f32x2 __attribute__((ext_vector_type(2)));
typedef short bf16x8 __attribute__((ext_vector_type(8)));
typedef _Float16 h2 __attribute__((ext_vector_type(2)));
#define LDS_WAIT() asm volatile("s_waitcnt lgkmcnt(0)" ::: "memory")

constexpr int NWAVES = 8;
constexpr int NTOK = 24576, SEQ = 8192, DM = 2048, DR = 1024, DFF = 8192;
constexpr int ZLD = 5632, ZC_CA = 3072, ZC_CB = 4096, ZC_L = 5120;
constexpr int ZMLD = 3584, ZM_L = 3072, ZCLD = 2048;
constexpr size_t MiB = 1u << 20;
constexpr size_t WS_WIN = 0, WS_WOUT = 22 * MiB, WS_WUP = 30 * MiB, WS_WDN = 62 * MiB, WS_SMALL = 94 * MiB, WS_XL = 95 * MiB, WS_XG = 107 * MiB,
                 WS_BONUS = 115 * MiB, WS_H = 118 * MiB, WS_ZC = 214 * MiB, WS_ZM = 310 * MiB, WS_END = 502 * MiB;
constexpr size_t SM_G2T = 0, SM_W2TF = 384 * 1024, SM_W2TB = 512 * 1024, SM_A2TF = 640 * 1024, SM_A2TB = 768 * 1024;
constexpr size_t WS_YF = WS_ZM, WS_YB = WS_ZM + 96 * MiB, WS_MIX = WS_ZC, WS_U = WS_ZC, WS_FF = WS_ZC + 128 * MiB;
constexpr size_t OUT_RS = 0, OUT_KS = 48 * MiB, OUT_VS = 96 * MiB, OUT_KK = 144 * MiB;
constexpr int LDS_BYTES = 147456, MISC_OFF = 131072 + 320;
constexpr size_t WS_CTL = 117 * MiB, CTL_BYTES = 16384;

struct Args { const float* in[30]; float* out; unsigned char* ws; int ph_lo, ph_hi; };

__device__ __forceinline__ float lo2f(unsigned u) { return __uint_as_float(u << 16); }
__device__ __forceinline__ float hi2f(unsigned u) { return __uint_as_float(u & 0xffff0000u); }
__device__ __forceinline__ unsigned f2bf(float f) { unsigned u = __float_as_uint(f); return (u + 0x7fffu + ((u >> 16) & 1u)) >> 16; }
__device__ __forceinline__ unsigned pk2(float lo, float hi) { unsigned r; asm volatile("v_cvt_pk_bf16_f32 %0, %1, %2" : "=v"(r) : "v"(lo), "v"(hi)); return r; }
__device__ __forceinline__ float fsigmoid(float x) { return __builtin_amdgcn_rcpf(1.f + __builtin_amdgcn_exp2f(-1.44269504f * x)); }
__device__ __forceinline__ float ftanh(float x) { return 1.f - 2.f * __builtin_amdgcn_rcpf(1.f + __builtin_amdgcn_exp2f(2.88539008f * x)); }
__device__ __forceinline__ float wave_sum(float v) {
#pragma unroll
    for (int o = 1; o < 64; o <<= 1) v += __shfl_xor(v, o);
    return v;
}
template <int CTRL> __device__ __forceinline__ float dppf(float x) { return __int_as_float(__builtin_amdgcn_update_dpp(0, __float_as_int(x), CTRL, 0xF, 0xF, true)); }
__device__ __forceinline__ float red8(float x) { x += dppf<0xB1>(x); x += dppf<0x4E>(x); x += dppf<0x141>(x); return x; }
__device__ __forceinline__ const float* xrow(const Args& a, int m) { return m < 16384 ? a.in[0] + (size_t)m * DM : a.in[1] + (size_t)(m - 16384) * DM; }

__device__ __forceinline__ void tr_item(const float* W, int ldw, int k0, int sc0, bf16* WT, int ldt, int dr0, LAS float* scr, int lane) {
#pragma unroll 8
    for (int i = 0; i < 32; ++i) { const int kk = 2 * i + (lane >> 5); scr[kk * 33 + (lane & 31)] = W[(size_t)(k0 + kk) * ldw + sc0 + (lane & 31)]; }
    LDS_WAIT(); asm volatile("" ::: "memory");
    const int c = lane & 7;
#pragma unroll
    for (int j = 0; j < 4; ++j) { const int n = (lane >> 3) + 8 * j; const LAS float* s = scr + (8 * c) * 33 + n;
        v4u o; o.x = pk2(s[0 * 33], s[1 * 33]); o.y = pk2(s[2 * 33], s[3 * 33]); o.z = pk2(s[4 * 33], s[5 * 33]); o.w = pk2(s[6 * 33], s[7 * 33]);
        *(v4u*)(WT + (size_t)(dr0 + n) * ldt + k0 + 8 * c) = o; }
    LDS_WAIT(); asm volatile("" ::: "memory");
}
__device__ __forceinline__ void rms_row_bf16(const float* xr_, const float* g, bf16* orow, int lane) {
    const f32x4* xr = (const f32x4*)xr_ + lane; const f32x4* gr = (const f32x4*)g + lane;
    f32x4 v[8]; float s = 0.f;
#pragma unroll
    for (int j = 0; j < 8; ++j) { v[j] = xr[64 * j]; s += (v[j].x * v[j].x + v[j].y * v[j].y) + (v[j].z * v[j].z + v[j].w * v[j].w); }
    const float rstd = 1.f / sqrtf(wave_sum(s) * (1.f / DM) + 1e-6f);
    v2u* o8 = (v2u*)orow + lane;
#pragma unroll
    for (int j = 0; j < 8; ++j) { const f32x4 gg = gr[64 * j]; v2u o; o.x = pk2(v[j].x * rstd * gg.x, v[j].y * rstd * gg.y); o.y = pk2(v[j].z * rstd * gg.z, v[j].w * rstd * gg.w); o8[64 * j] = o; }
}
__device__ __forceinline__ void p0_prologue(const Args& a, LAS unsigned char* lds, int gw, int NGW, int wave, int lane) {
    unsigned char* ws = a.ws;
    LAS float* scr = (LAS float*)(lds + wave * 16384);
    bf16* WIN = (bf16*)(ws + WS_WIN); bf16* WOUT = (bf16*)(ws + WS_WOUT);
    constexpr int I_IN = 32 * 173, I_OUT = 32 * 64, I_S = 32;
    constexpr int NITEMS = I_IN + I_OUT + 4 * I_S;
    for (int it = gw; it < NITEMS; it += NGW) {
        int r = it;
        if (r < I_IN) { const int kb = r / 173, nb = r % 173, sc0 = nb * 32; const int dr0 = sc0 < 3072 ? sc0 : (sc0 < 3488 ? ZC_L + (sc0 - 3072) : ZC_CA + (sc0 - 3488));
            tr_item(a.in[3], 5536, kb * 64, sc0, WIN, DM, dr0, scr, lane); continue; } r -= I_IN;
        if (r < I_OUT) { tr_item(a.in[24], DM, (r / 64) * 64, (r % 64) * 32, WOUT, DM, (r % 64) * 32, scr, lane); continue; } r -= I_OUT;
        { const int which = r / I_S, nb = r % I_S; const float* src = which == 0 ? a.in[7] : which == 1 ? a.in[9] : which == 2 ? a.in[11] : a.in[13];
          bf16* dst = (bf16*)(ws + WS_SMALL + (which == 0 ? SM_W2TF : which == 1 ? SM_W2TB : which == 2 ? SM_A2TF : SM_A2TB));
          tr_item(src, DR, 0, nb * 32, dst, 64, nb * 32, scr, lane); }
    }
    { const int gt = gw * 64 + lane, NGT = NGW * 64;
      v4u zz = {0u, 0u, 0u, 0u}; v4u* zp = (v4u*)(WIN + (size_t)5536 * DM);
      for (int i = gt; i < 96 * DM / 8; i += NGT) zp[i] = zz;
      bf16* G2T = (bf16*)(ws + WS_SMALL + SM_G2T); const float* g2 = a.in[14];
      for (int i = gt; i < 160 * 1024; i += NGT) { const int k = i >> 10, n = i & 1023; G2T[n * 160 + k] = (bf16)f2bf(g2[i]); } }
    bf16* H = (bf16*)(ws + WS_H);
    for (int m = gw; m < NTOK; m += NGW) rms_row_bf16(xrow(a, m), a.in[2], H + (size_t)m * DM, lane);
}
__device__ __forceinline__ void p0_mlp_weights(const Args& a, LAS unsigned char* lds, int gw, int NGW, int wave, int lane) {
    unsigned char* ws = a.ws;
    LAS float* scr = (LAS float*)(lds + wave * 16384);
    bf16* WUP = (bf16*)(ws + WS_WUP); bf16* WDN = (bf16*)(ws + WS_WDN);
    constexpr int I_UP = 32 * 256, I_DN = 128 * 64;
    for (int it = gw; it < I_UP + I_DN; it += NGW) {
        int r = it;
        if (r < I_UP) { tr_item(a.in[27], DFF, (r / 256) * 64, (r % 256) * 32, WUP, DM, (r % 256) * 32, scr, lane); continue; } r -= I_UP;
        tr_item(a.in[28], DM, (r / 64) * 64, (r % 64) * 32, WDN, DFF, (r % 64) * 32, scr, lane);
    }
}

__device__ __forceinline__ void shift_phase(const Args& a, int gw, int NGW, int lane) {
    unsigned char* ws = a.ws;
    const bf16* Z = (const bf16*)(ws + WS_ZM);
    bf16* RS = (bf16*)((unsigned char*)a.out + OUT_RS); bf16* KS = (bf16*)((unsigned char*)a.out + OUT_KS);
    bf16* VS = (bf16*)((unsigned char*)a.out + OUT_VS); bf16* KK = (bf16*)((unsigned char*)a.out + OUT_KK);
    bf16* XL = (bf16*)(ws + WS_XL); bf16* XG = (bf16*)(ws + WS_XG); float* BONUS = (float*)(ws + WS_BONUS);
    const float* mup = a.in[4]; const float* mun = a.in[5]; const float* k_k = a.in[15]; const float* r_k = a.in[17];
    const int hp2 = lane >> 5, n2 = (lane & 31) * 2;
    for (int m = gw; m < NTOK; m += NGW) {
        const int t = m & (SEQ - 1); const bool hp = t > 0, hn = t < SEQ - 1;
        const bf16* z0 = Z + (size_t)m * ZMLD; const bf16* zp = z0 - ZMLD; const bf16* zn = z0 + ZMLD;
#pragma unroll 2
        for (int hh = 0; hh < 8; ++hh) {
            const int c = (hh * 2 + hp2) * 64 + n2;
            float s[3][2];
#pragma unroll
            for (int ar = 0; ar < 3; ++ar) { const int col = ar * 1024 + c;
                const unsigned zc = *(const unsigned*)(z0 + col); const unsigned zpv = hp ? *(const unsigned*)(zp + col) : 0u; const unsigned znv = hn ? *(const unsigned*)(zn + col) : 0u;
                const f32x2 mp = *(const f32x2*)(mup + col), mn = *(const f32x2*)(mun + col);
                const float x0 = lo2f(zc), x1 = hi2f(zc);
                s[ar][0] = x0 + mp.x * (lo2f(zpv) - x0) + mn.x * (lo2f(znv) - x0);
                s[ar][1] = x1 + mp.y * (hi2f(zpv) - x1) + mn.y * (hi2f(znv) - x1); }
            const f32x2 kkw = *(const f32x2*)(k_k + c), rkw = *(const f32x2*)(r_k + c);
            const float kr0 = s[1][0] * kkw.x, kr1 = s[1][1] * kkw.y;
            float ss = kr0 * kr0 + kr1 * kr1, bs = s[0][0] * s[1][0] * rkw.x + s[0][1] * s[1][1] * rkw.y;
#pragma unroll
            for (int o = 1; o < 32; o <<= 1) { ss += __shfl_xor(ss, o); bs += __shfl_xor(bs, o); }
            const float inv = 1.f / fmaxf(sqrtf(ss), 1e-12f);
            const size_t o = (size_t)m * DR + c;
            *(unsigned*)(RS + o) = pk2(s[0][0], s[0][1]); *(unsigned*)(KS + o) = pk2(s[1][0], s[1][1]);
            *(unsigned*)(VS + o) = pk2(s[2][0], s[2][1]); *(unsigned*)(KK + o) = pk2(kr0 * inv, kr1 * inv);
            if ((lane & 31) == 0) BONUS[m * 16 + hh * 2 + hp2] = bs;
        }
#pragma unroll
        for (int p = 0; p < 7; ++p) { const int j = p * 64 + lane;
            if (j < 416) { const int col = ZM_L + j, og = 3072 + j;
                const float x0 = lo2f(z0[col]); const float xp = hp ? lo2f(zp[col]) : 0.f; const float xn = hn ? lo2f(zn[col]) : 0.f;
                const float sv = x0 + mup[og] * (xp - x0) + mun[og] * (xn - x0);
                if (j < 128) XL[(size_t)m * 256 + j] = (bf16)f2bf(ftanh(sv));
                else if (j < 256) XL[(size_t)m * 256 + j] = (bf16)f2bf(sv);
                else XG[(size_t)m * 160 + (j - 256)] = (bf16)f2bf(fsigmoid(sv)); } }
    }
}

#define TR_STAGE(D_, N_) { const bool up_ = (lane & (D_)) != 0; _Pragma("unroll") for (int i_ = 0; i_ < (N_) / 2; ++i_) { \
    const float keep_ = up_ ? vals[i_ + (N_) / 2] : vals[i_]; const float send_ = up_ ? vals[i_] : vals[i_ + (N_) / 2]; vals[i_] = keep_ + __shfl_xor(send_, (D_)); } }
__device__ __forceinline__ void conv_phase(const Args& a, unsigned char* lds, int tid, int wave, int lane, int u0, int ustride) {
    unsigned char* ws = a.ws;
    const bf16* Z = (const bf16*)(ws + WS_ZC); bf16* MIXIN = (bf16*)(ws + WS_H);
    h2* utile = (h2*)lds;
    float* part = (float*)(lds + 126976);
    f32x2* stats = (f32x2*)(lds + 126976 + 2048);
    const float* dw_w = a.in[20]; const float* dw_b = a.in[21]; const float* cln_w = a.in[22]; const float* cln_b = a.in[23];
    const int cp = tid;
    for (int unit = u0; unit < NTOK / 32; unit += ustride) {
        const int m0 = unit * 32, t0 = m0 & (SEQ - 1);
        for (int idx = tid; idx < 62 * 512; idx += 512) { const int row = idx >> 9, c2 = idx & 511; const int t = t0 - 15 + row;
            h2 u = {(_Float16)0.f, (_Float16)0.f};
            if (t >= 0 && t < SEQ) { const bf16* zr = Z + (size_t)(m0 - 15 + row) * ZCLD; const unsigned za = *(const unsigned*)(zr + 2 * c2), zb = *(const unsigned*)(zr + 1024 + 2 * c2);
                u.x = (_Float16)(lo2f(za) * fsigmoid(lo2f(zb))); u.y = (_Float16)(hi2f(za) * fsigmoid(hi2f(zb))); }
            utile[idx] = u; }
        __syncthreads();
        f32x2 w[31];
#pragma unroll
        for (int j = 0; j < 31; ++j) w[j] = *(const f32x2*)(dw_w + j * 1024 + 2 * cp);
        const f32x2 bias = *(const f32x2*)(dw_b + 2 * cp);
        f32x2 out[32];
#pragma unroll
        for (int tb = 0; tb < 4; ++tb) {
            f32x2 acc[8];
#pragma unroll
            for (int o = 0; o < 8; ++o) acc[o] = bias;
#pragma unroll
            for (int jj = 0; jj < 38; ++jj) { const h2 uh = utile[(tb * 8 + jj) * 512 + cp]; const f32x2 u = {(float)uh.x, (float)uh.y};
#pragma unroll
                for (int o = 0; o < 8; ++o) { const int j = jj - o; if (j >= 0 && j < 31) acc[o] = u * w[j] + acc[o]; } }
#pragma unroll
            for (int o = 0; o < 8; ++o) out[tb * 8 + o] = acc[o];
            asm volatile("" ::: "memory");
        }
        float vals[64];
#pragma unroll
        for (int t = 0; t < 32; ++t) { vals[2 * t] = out[t].x + out[t].y; vals[2 * t + 1] = out[t].x * out[t].x + out[t].y * out[t].y; }
        TR_STAGE(32, 64) TR_STAGE(16, 32) TR_STAGE(8, 16) TR_STAGE(4, 8) TR_STAGE(2, 4) TR_STAGE(1, 2)
        part[wave * 64 + lane] = vals[0];
        __syncthreads();
        if (tid < 32) { float s = 0.f, q = 0.f;
#pragma unroll
            for (int wv = 0; wv < 8; ++wv) { s += part[wv * 64 + 2 * tid]; q += part[wv * 64 + 2 * tid + 1]; }
            const float mean = s * (1.f / 1024.f); const float var = q * (1.f / 1024.f) - mean * mean;
            stats[tid] = (f32x2){mean, 1.f / sqrtf(var + 1e-5f)}; }
        __syncthreads();
        const f32x2 lw = *(const f32x2*)(cln_w + 2 * cp), lb = *(const f32x2*)(cln_b + 2 * cp);
#pragma unroll
        for (int t = 0; t < 32; ++t) { const f32x2 st = stats[t];
            const float y0 = (out[t].x - st.x) * st.y * lw.x + lb.x, y1 = (out[t].y - st.x) * st.y * lw.y + lb.y;
            *(unsigned*)(MIXIN + (size_t)(m0 + t) * DM + DR + 2 * cp) = pk2(y0 * fsigmoid(y0), y1 * fsigmoid(y1)); }
        __syncthreads();
    }
}

constexpr int CK_LDK = 72, CK_LDI = 40, CK_LDF = 36;
constexpr int PB_Q = 0, PB_R = PB_Q + 32 * CK_LDK * 2, PB_A = PB_R + 32 * CK_LDK * 2, PB_M = PB_A + 32 * CK_LDK * 2;
constexpr int PB_AT = PB_M + 32 * CK_LDK * 2, PB_MT = PB_AT + 64 * CK_LDI * 2, PB_VT = PB_MT + 64 * CK_LDI * 2;
constexpr int PB_PEND = PB_VT + 64 * CK_LDI * 2, PB_AQT = PB_PEND + 256;
constexpr int PB_MQT = PB_AQT + 32 * CK_LDF * 4, PB_ART = PB_MQT + 32 * CK_LDI * 2, PB_MRT = PB_ART + 32 * CK_LDI * 2;
constexpr int PB_BYTES = PB_MRT + 32 * CK_LDI * 2;
constexpr int SB_S0 = 2 * PB_BYTES, SB_RHS = SB_S0 + 64 * CK_LDK * 2, SB_SA = SB_RHS + 64 * CK_LDF * 4, SB_END = SB_SA + 64 * CK_LDI * 2;
static_assert(SB_END <= 131072 && (PB_BYTES % 16) == 0, "scan LDS map");
struct PrepRegs { bf16x8 At0, At1, Aa0, Aa1; v2u r4, k4, v4, q4; };
template <int TB> __device__ __forceinline__ void solve_block(float (&sac)[8], const float (&rh)[32], const float* cq, f32x4 (&cur)[16], f32x4 (&nxt)[16], int q) {
    constexpr bool HI = TB >= 2;
    if (TB + 1 < 4) {
#pragma unroll
        for (int u = 0; u < 8; ++u) { nxt[2 * u] = *(const f32x4*)(cq + ((TB + 1) * 8 + u) * CK_LDF); if (TB + 1 >= 2) nxt[2 * u + 1] = *(const f32x4*)(cq + ((TB + 1) * 8 + u) * CK_LDF + 4); }
    }
#pragma unroll
    for (int u = 0; u < 8; ++u) {
        const int t = TB * 8 + u; const int nj = (t + 3) / 4;
        const f32x4 c0 = cur[2 * u]; const f32x4 c1 = HI ? cur[2 * u + 1] : c0;
        float p0 = 0.f, p1 = 0.f;
        if (nj > 0) p0 = sac[0] * c0.x; if (nj > 1) p1 = sac[1] * c0.y; if (nj > 2) p0 += sac[2] * c0.z; if (nj > 3) p1 += sac[3] * c0.w;
        if (nj > 4) p0 += sac[4] * c1.x; if (nj > 5) p1 += sac[5] * c1.y; if (nj > 6) p0 += sac[6] * c1.z; if (nj > 7) p1 += sac[7] * c1.w;
        float p = p0 + p1; p += dppf<0xB1>(p); p += dppf<0x4E>(p);
        const float x = rh[t] - p;
        sac[t >> 2] = ((t & 3) == q) ? x : sac[t >> 2];
    }
#pragma unroll
    for (int u = 0; u < 8; ++u) asm volatile("" : "+v"(sac[u]));
    if (TB + 1 < 4) {
#pragma unroll
        for (int u = 0; u < 8; ++u) { asm volatile("" : "+v"(nxt[2 * u])); if (TB + 1 >= 2) asm volatile("" : "+v"(nxt[2 * u + 1])); }
    }
}
__device__ __forceinline__ f32x4 mma_nt(f32x4 acc, const bf16* A, int lda, const bf16* B, int ldb, int nk32, int fr, int fq) {
    for (int ks = 0; ks < nk32; ++ks) { const bf16x8 av = *(const bf16x8*)(A + fr * lda + ks * 32 + fq * 8); const bf16x8 bv = *(const bf16x8*)(B + fr * ldb + ks * 32 + fq * 8);
        acc = __builtin_amdgcn_mfma_f32_16x16x32_bf16(av, bv, acc, 0, 0, 0); }
    return acc;
}
#define LBAR() do { asm volatile("s_waitcnt lgkmcnt(0)" ::: "memory"); __builtin_amdgcn_s_barrier(); asm volatile("" ::: "memory"); } while (0)
__device__ __forceinline__ void scan_phase(const Args& a, unsigned char* lds, int wave, int lane) {
    if (blockIdx.x >= 96) {
        const int wi = blockIdx.x - 96, nw = gridDim.x - 96;
        conv_phase(a, lds, threadIdx.x, wave, lane, wi, nw);
        p0_mlp_weights(a, (LAS unsigned char*)lds, wi * NWAVES + wave, nw * NWAVES, wave, lane);
        return;
    }
    unsigned char* ws = a.ws;
    const int scan = blockIdx.x, dir = scan & 1, sh = scan >> 1, seq = sh >> 4, h = sh & 15;
    const size_t row0 = (size_t)seq * SEQ;
    const bf16* RS = (const bf16*)((unsigned char*)a.out + OUT_RS); const bf16* KS = (const bf16*)((unsigned char*)a.out + OUT_KS);
    const bf16* VS = (const bf16*)((unsigned char*)a.out + OUT_VS); const bf16* KK = (const bf16*)((unsigned char*)a.out + OUT_KK);
    const bf16* XL = (const bf16*)(ws + WS_XL);
    float* Y = (float*)(ws + (dir ? WS_YB : WS_YF));
    constexpr int NCH = SEQ / 32;
    const int tid = threadIdx.x, fr = lane & 15, fq = lane >> 4;
    bf16* S0b = (bf16*)(lds + SB_S0); float* RHS = (float*)(lds + SB_RHS); bf16* SAb = (bf16*)(lds + SB_SA);
    for (int i = tid; i < SB_END / 4; i += NWAVES * 64) ((unsigned*)lds)[i] = 0u;
    const int pw = wave & 3, cl = pw * 16 + fq * 4, gcol = h * 64 + cl;
    bf16x8 Bw0, Bw1, Ba0, Ba1; f32x4 w0v, a0v, kav;
    {
        const bf16* W2T = (const bf16*)(ws + WS_SMALL + (dir ? SM_W2TB : SM_W2TF)); const bf16* A2T = (const bf16*)(ws + WS_SMALL + (dir ? SM_A2TB : SM_A2TF));
        const size_t bo = (size_t)(h * 64 + pw * 16 + fr) * 64 + fq * 8;
        Bw0 = *(const bf16x8*)(W2T + bo); Bw1 = *(const bf16x8*)(W2T + bo + 32); Ba0 = *(const bf16x8*)(A2T + bo); Ba1 = *(const bf16x8*)(A2T + bo + 32);
        w0v = *(const f32x4*)((dir ? a.in[8] : a.in[6]) + gcol); a0v = *(const f32x4*)((dir ? a.in[12] : a.in[10]) + gcol); kav = *(const f32x4*)(a.in[16] + gcol);
    }
    const int rt = wave >> 1, tt = wave & 1;
    f32x4 Sacc0 = {0.f, 0.f, 0.f, 0.f}, Sacc1 = Sacc0;
#define PREP_LOAD(P, C, MT) do { const int st_ = (C) * 32 + (MT) * 16 + fr, t_ = dir ? (SEQ - 1 - st_) : st_; const size_t m_ = row0 + t_; \
        const bf16* xl_ = XL + m_ * 256 + dir * 64 + fq * 8; P.At0 = *(const bf16x8*)(xl_); P.At1 = *(const bf16x8*)(xl_ + 32); P.Aa0 = *(const bf16x8*)(xl_ + 128); P.Aa1 = *(const bf16x8*)(xl_ + 160); \
        const size_t go_ = m_ * DR + gcol; P.r4 = *(const v2u*)(RS + go_); P.k4 = *(const v2u*)(KS + go_); P.v4 = *(const v2u*)(VS + go_); P.q4 = *(const v2u*)(KK + go_); } while (0)
#define PREP_A1(C, PBB) do { \
        bf16* Qb_ = (bf16*)((PBB) + PB_Q); bf16* Rb_ = (bf16*)((PBB) + PB_R); bf16* Ab_ = (bf16*)((PBB) + PB_A); bf16* Mb_ = (bf16*)((PBB) + PB_M); \
        bf16* Atb_ = (bf16*)((PBB) + PB_AT); bf16* Mtb_ = (bf16*)((PBB) + PB_MT); bf16* Vtb_ = (bf16*)((PBB) + PB_VT); float* PEND_ = (float*)((PBB) + PB_PEND); \
        f32x4 off = {0.f, 0.f, 0.f, 0.f}; \
        _Pragma("unroll") for (int mt = 0; mt < 2; ++mt) { \
            const int i = mt * 16 + fr; PrepRegs& P = pc[mt]; \
            f32x4 aw = {0.f, 0.f, 0.f, 0.f}, aa = aw; \
            aw = __builtin_amdgcn_mfma_f32_16x16x32_bf16(Bw0, P.At0, aw, 0, 0, 0); aw = __builtin_amdgcn_mfma_f32_16x16x32_bf16(Bw1, P.At1, aw, 0, 0, 0); \
            aa = __builtin_amdgcn_mfma_f32_16x16x32_bf16(Ba0, P.Aa0, aa, 0, 0, 0); aa = __builtin_amdgcn_mfma_f32_16x16x32_bf16(Ba1, P.Aa1, aa, 0, 0, 0); \
            const v2u r4 = P.r4, k4 = P.k4, v4 = P.v4, q4 = P.q4; \
            if ((C) + 1 < NCH) PREP_LOAD(P, (C) + 1, mt); \
            const f32x4 rv = {lo2f(r4.x), hi2f(r4.x), lo2f(r4.y), hi2f(r4.y)}, kv = {lo2f(k4.x), hi2f(k4.x), lo2f(k4.y), hi2f(k4.y)}; \
            const f32x4 qv = {lo2f(q4.x), hi2f(q4.x), lo2f(q4.y), hi2f(q4.y)}; \
            f32x4 lw, cum, av, pm1, pin, pp; \
            _Pragma("unroll") for (int j = 0; j < 4; ++j) { \
                lw[j] = -0.87500596f * fsigmoid(w0v[j] + aw[j]); av[j] = fsigmoid(a0v[j] + aa[j]); \
                float x = lw[j]; x += dppf<0x111>(x); x += dppf<0x112>(x); x += dppf<0x114>(x); x += dppf<0x118>(x); \
                cum[j] = x + off[j]; \
                pm1[j] = __builtin_amdgcn_exp2f(cum[j] - lw[j]); pin[j] = __builtin_amdgcn_exp2f(-cum[j]); pp[j] = __builtin_amdgcn_exp2f(cum[j]); } \
            if (mt == 0) { _Pragma("unroll") for (int j = 0; j < 4; ++j) off[j] = __shfl(cum[j], (lane & 48) | 15); } \
            const f32x4 qt = qv * pm1, at = qv * av * pin, mtv = kv * (1.f + (av - 1.f) * kav) * pin, rtv = rv * pp; \
            v2u o; \
            o.x = pk2(qt[0], qt[1]); o.y = pk2(qt[2], qt[3]); *(v2u*)(Qb_ + i * CK_LDK + cl) = o; \
            o.x = pk2(rtv[0], rtv[1]); o.y = pk2(rtv[2], rtv[3]); *(v2u*)(Rb_ + i * CK_LDK + cl) = o; \
            o.x = pk2(at[0], at[1]); o.y = pk2(at[2], at[3]); *(v2u*)(Ab_ + i * CK_LDK + cl) = o; \
            o.x = pk2(mtv[0], mtv[1]); o.y = pk2(mtv[2], mtv[3]); *(v2u*)(Mb_ + i * CK_LDK + cl) = o; \
            _Pragma("unroll") for (int j = 0; j < 4; ++j) { Atb_[(cl + j) * CK_LDI + i] = (bf16)f2bf(-at[j]); Mtb_[(cl + j) * CK_LDI + i] = (bf16)f2bf(mtv[j]); } \
            Vtb_[(cl + 0) * CK_LDI + i] = (bf16)(v4.x & 0xffffu); Vtb_[(cl + 1) * CK_LDI + i] = (bf16)(v4.x >> 16); Vtb_[(cl + 2) * CK_LDI + i] = (bf16)(v4.y & 0xffffu); Vtb_[(cl + 3) * CK_LDI + i] = (bf16)(v4.y >> 16); \
            if (i == 31) *(f32x4*)(PEND_ + cl) = pp; } } while (0)
#define PREP_A2(PBB) do { \
        const bf16* Qb_ = (const bf16*)((PBB) + PB_Q); const bf16* Rb_ = (const bf16*)((PBB) + PB_R); const bf16* Ab_ = (const bf16*)((PBB) + PB_A); const bf16* Mb_ = (const bf16*)((PBB) + PB_M); \
        const int mtx = wave & 3; const bf16* At_ = (mtx < 2 ? Qb_ : Rb_); const bf16* Bt_ = ((mtx & 1) ? Mb_ : Ab_); \
        const bool incl = mtx >= 2; const float sgn = (mtx == 2) ? -1.f : 1.f; \
        float* Aqt_ = (float*)((PBB) + PB_AQT); bf16* Ob_ = (bf16*)((PBB) + (mtx == 1 ? PB_MQT : (mtx == 2 ? PB_ART : PB_MRT))); \
        _Pragma("unroll") for (int pass = 0; pass < 2; ++pass) { \
            if (wave >= 4 && pass == 1) break; \
            const int tj = wave >= 4 ? 1 : pass, ij = wave >= 4 ? 0 : pass; \
            const f32x4 d = mma_nt((f32x4){0.f, 0.f, 0.f, 0.f}, At_ + tj * 16 * CK_LDK, CK_LDK, Bt_ + ij * 16 * CK_LDK, CK_LDK, 2, fr, fq); \
            const int ii = ij * 16 + fr; \
            if (mtx == 0) { _Pragma("unroll") for (int rg = 0; rg < 4; ++rg) { const int t = tj * 16 + fq * 4 + rg; Aqt_[t * CK_LDF + (ii & 3) * 8 + (ii >> 2)] = (ii < t) ? d[rg] : 0.f; } } \
            else { _Pragma("unroll") for (int rg = 0; rg < 4; ++rg) { const int t = tj * 16 + fq * 4 + rg; const bool keep = incl ? (ii <= t) : (ii < t); Ob_[t * CK_LDI + ii] = (bf16)f2bf(keep ? sgn * d[rg] : 0.f); } } } } while (0)
    PrepRegs pc[2];
    if (wave >= 4) { PREP_LOAD(pc[0], 0, 0); PREP_LOAD(pc[1], 0, 1); }
    __syncthreads();
    if (wave >= 4) PREP_A1(0, lds);
    LBAR();
    PREP_A2(lds);
    LBAR();
    for (int c = 0; c < NCH; ++c) {
        unsigned char* pb = lds + (c & 1) * PB_BYTES; unsigned char* pbn = lds + ((c + 1) & 1) * PB_BYTES;
        const bf16* Qb = (const bf16*)(pb + PB_Q); const bf16* Rb = (const bf16*)(pb + PB_R);
        const bf16* Atb = (const bf16*)(pb + PB_AT); const bf16* Mtb = (const bf16*)(pb + PB_MT); const bf16* Vtb = (const bf16*)(pb + PB_VT);
        const float* PEND = (const float*)(pb + PB_PEND); const float* Aqt = (const float*)(pb + PB_AQT);
        const bf16* Mqtb = (const bf16*)(pb + PB_MQT); const bf16* Artb = (const bf16*)(pb + PB_ART); const bf16* Mrtb = (const bf16*)(pb + PB_MRT);
        f32x4 yacc;
        {
            const bf16* S0r = S0b + rt * 16 * CK_LDK; const bf16* Vtr = Vtb + rt * 16 * CK_LDI;
            f32x4 racc = mma_nt((f32x4){0.f, 0.f, 0.f, 0.f}, S0r, CK_LDK, Qb + tt * 16 * CK_LDK, CK_LDK, 2, fr, fq);
            racc = mma_nt(racc, Vtr, CK_LDI, Mqtb + tt * 16 * CK_LDI, CK_LDI, 1, fr, fq);
            yacc = mma_nt((f32x4){0.f, 0.f, 0.f, 0.f}, S0r, CK_LDK, Rb + tt * 16 * CK_LDK, CK_LDK, 2, fr, fq);
            yacc = mma_nt(yacc, Vtr, CK_LDI, Mrtb + tt * 16 * CK_LDI, CK_LDI, 1, fr, fq);
#pragma unroll
            for (int rg = 0; rg < 4; ++rg) RHS[(rt * 16 + fq * 4 + rg) * CK_LDF + tt * 16 + fr] = racc[rg];
        }
        LBAR();
        if (wave < 4) {
            const int srow = wave * 16 + (lane >> 2), q = lane & 3;
            float sac[8], rh[32];
#pragma unroll
            for (int u = 0; u < 8; ++u) { const f32x4 v = *(const f32x4*)(RHS + srow * CK_LDF + u * 4); rh[4 * u] = v.x; rh[4 * u + 1] = v.y; rh[4 * u + 2] = v.z; rh[4 * u + 3] = v.w; sac[u] = 0.f; }
            const float* cq = Aqt + q * 8;
            f32x4 ca[16], cb[16];
#pragma unroll
            for (int u = 0; u < 8; ++u) ca[2 * u] = *(const f32x4*)(cq + u * CK_LDF);
            solve_block<0>(sac, rh, cq, ca, cb, q); solve_block<1>(sac, rh, cq, cb, ca, q); solve_block<2>(sac, rh, cq, ca, cb, q); solve_block<3>(sac, rh, cq, cb, ca, q);
#pragma unroll
            for (int j = 0; j < 8; ++j) SAb[srow * CK_LDI + 4 * j + q] = (bf16)f2bf(sac[j]);
        } else if (wave >= 4) {
            if (c + 1 < NCH) PREP_A1(c + 1, pbn);
        }
        LBAR();
        {
            const bf16* SAr = SAb + rt * 16 * CK_LDI; const bf16* Vtr = Vtb + rt * 16 * CK_LDI;
            yacc = mma_nt(yacc, SAr, CK_LDI, Artb + tt * 16 * CK_LDI, CK_LDI, 1, fr, fq);
            const int step = c * 32 + tt * 16 + fr, t = dir ? (SEQ - 1 - step) : step;
            *(f32x4*)(Y + (row0 + t) * DR + h * 64 + rt * 16 + fq * 4) = yacc;
            Sacc0 = mma_nt(Sacc0, Vtr, CK_LDI, Mtb + (2 * tt) * 16 * CK_LDI, CK_LDI, 1, fr, fq); Sacc0 = mma_nt(Sacc0, SAr, CK_LDI, Atb + (2 * tt) * 16 * CK_LDI, CK_LDI, 1, fr, fq);
            Sacc1 = mma_nt(Sacc1, Vtr, CK_LDI, Mtb + (2 * tt + 1) * 16 * CK_LDI, CK_LDI, 1, fr, fq); Sacc1 = mma_nt(Sacc1, SAr, CK_LDI, Atb + (2 * tt + 1) * 16 * CK_LDI, CK_LDI, 1, fr, fq);
            const float pe0 = PEND[(2 * tt) * 16 + fr], pe1 = PEND[(2 * tt + 1) * 16 + fr];
            Sacc0 = Sacc0 * pe0; Sacc1 = Sacc1 * pe1;
#pragma unroll
            for (int rg = 0; rg < 4; ++rg) { S0b[(rt * 16 + fq * 4 + rg) * CK_LDK + (2 * tt) * 16 + fr] = (bf16)f2bf(Sacc0[rg]); S0b[(rt * 16 + fq * 4 + rg) * CK_LDK + (2 * tt + 1) * 16 + fr] = (bf16)f2bf(Sacc1[rg]); }
            if (c + 1 < NCH) PREP_A2(pbn);
        }
        LBAR();
    }
#undef PREP_LOAD
#undef PREP_A1
#undef PREP_A2
}

__device__ __forceinline__ void post_phase(const Args& a, int wave, int lane) {
    unsigned char* ws = a.ws;
    const bf16* XG = (const bf16*)(ws + WS_XG); const bf16* G2T = (const bf16*)(ws + WS_SMALL + SM_G2T);
    const float* YF = (const float*)(ws + WS_YF); const float* YB = (const float*)(ws + WS_YB); const float* BONUS = (const float*)(ws + WS_BONUS);
    const bf16* VS = (const bf16*)((unsigned char*)a.out + OUT_VS); bf16* MIXIN = (bf16*)(ws + WS_H);
    const float* gn_w = a.in[18]; const float* gn_b = a.in[19];
    const int fr = lane & 15, fq = lane >> 4, n0 = wave * 128;
    for (int unit = blockIdx.x; unit < NTOK / 32; unit += gridDim.x) {
        const int m0 = unit * 32;
        f32x4 acc[2][8];
#pragma unroll
        for (int mt = 0; mt < 2; ++mt)
#pragma unroll
            for (int nt = 0; nt < 8; ++nt) acc[mt][nt] = (f32x4){0.f, 0.f, 0.f, 0.f};
#pragma unroll
        for (int kq = 0; kq < 5; ++kq) {
            bf16x8 A[2];
#pragma unroll
            for (int mt = 0; mt < 2; ++mt) A[mt] = *(const bf16x8*)(XG + (size_t)(m0 + mt * 16 + fr) * 160 + kq * 32 + fq * 8);
#pragma unroll
            for (int nt = 0; nt < 8; ++nt) { const bf16x8 B = *(const bf16x8*)(G2T + (size_t)(n0 + nt * 16 + fr) * 160 + kq * 32 + fq * 8);
#pragma unroll
                for (int mt = 0; mt < 2; ++mt) acc[mt][nt] = __builtin_amdgcn_mfma_f32_16x16x32_bf16(B, A[mt], acc[mt][nt], 0, 0, 0); }
        }
#pragma unroll
        for (int mt = 0; mt < 2; ++mt) { const size_t m = (size_t)(m0 + mt * 16 + fr);
#pragma unroll
            for (int hh = 0; hh < 2; ++hh) { const int hd = wave * 2 + hh;
                f32x4 y[4]; float s = 0.f;
#pragma unroll
                for (int q = 0; q < 4; ++q) { const size_t o = m * DR + n0 + (hh * 4 + q) * 16 + fq * 4; y[q] = *(const f32x4*)(YF + o) + *(const f32x4*)(YB + o); s += (y[q].x + y[q].y) + (y[q].z + y[q].w); }
                s += __shfl_xor(s, 16); s += __shfl_xor(s, 32);
                const float mean = s * (1.f / 64.f); float ss = 0.f;
#pragma unroll
                for (int q = 0; q < 4; ++q) { y[q] = y[q] - mean; ss += (y[q].x * y[q].x + y[q].y * y[q].y) + (y[q].z * y[q].z + y[q].w * y[q].w); }
                ss += __shfl_xor(ss, 16); ss += __shfl_xor(ss, 32);
                const float rstd = 1.f / sqrtf(ss * (1.f / 64.f) + 64e-5f); const float bs = BONUS[m * 16 + hd];
#pragma unroll
                for (int q = 0; q < 4; ++q) { const int c = n0 + (hh * 4 + q) * 16 + fq * 4; const f32x4 gw4 = *(const f32x4*)(gn_w + c), gb4 = *(const f32x4*)(gn_b + c);
                    const v2u v4 = *(const v2u*)(VS + m * DR + c); const f32x4 vv = {lo2f(v4.x), hi2f(v4.x), lo2f(v4.y), hi2f(v4.y)};
                    const f32x4 o = (y[q] * rstd * gw4 + gb4 + bs * vv) * acc[mt][hh * 4 + q];
                    v2u ov; ov.x = pk2(o.x, o.y); ov.y = pk2(o.z, o.w); *(v2u*)(MIXIN + m * DM + c) = ov; }
            }
        }
    }
}

__device__ __forceinline__ void mid_rows(const Args& a, int gw, int NGW, int lane) {
    unsigned char* ws = a.ws; const bf16* MIX = (const bf16*)(ws + WS_MIX); bf16* H = (bf16*)(ws + WS_H);
    const f32x4* g1 = (const f32x4*)a.in[25] + lane; const f32x4* g2 = (const f32x4*)a.in[26] + lane;
    for (int m = gw; m < NTOK; m += NGW) {
        const v2u* mr = (const v2u*)(MIX + (size_t)m * DM) + lane; const f32x4* xr = (const f32x4*)xrow(a, m) + lane;
        f32x4 v[8], xv[8]; float s = 0.f;
#pragma unroll
        for (int j = 0; j < 8; ++j) xv[j] = __builtin_nontemporal_load(xr + 64 * j);
#pragma unroll
        for (int j = 0; j < 8; ++j) { const v2u u = __builtin_nontemporal_load(mr + 64 * j); v[j] = (f32x4){lo2f(u.x), hi2f(u.x), lo2f(u.y), hi2f(u.y)}; s += (v[j].x * v[j].x + v[j].y * v[j].y) + (v[j].z * v[j].z + v[j].w * v[j].w); }
        const float rstd = 1.f / sqrtf(wave_sum(s) * (1.f / DM) + 1e-6f); float s1 = 0.f;
        f32x4* orow = (f32x4*)(a.out + (size_t)m * DM) + lane;
#pragma unroll
        for (int j = 0; j < 8; ++j) { v[j] = xv[j] + v[j] * rstd * g1[64 * j]; orow[64 * j] = v[j]; s1 += (v[j].x * v[j].x + v[j].y * v[j].y) + (v[j].z * v[j].z + v[j].w * v[j].w); }
        const float rstd1 = 1.f / sqrtf(wave_sum(s1) * (1.f / DM) + 1e-6f);
        v2u* hr = (v2u*)(H + (size_t)m * DM) + lane;
#pragma unroll
        for (int j = 0; j < 8; ++j) { const f32x4 gg = g2[64 * j]; v2u o; o.x = pk2(v[j].x * rstd1 * gg.x, v[j].y * rstd1 * gg.y); o.y = pk2(v[j].z * rstd1 * gg.z, v[j].w * rstd1 * gg.w); hr[64 * j] = o; }
    }
}
__device__ __forceinline__ void final_rows(const Args& a, int gw, int NGW, int lane) {
    unsigned char* ws = a.ws; const bf16* FF = (const bf16*)(ws + WS_FF);
    const f32x4* g1 = (const f32x4*)a.in[29] + lane;
    for (int m = gw; m < NTOK; m += NGW) {
        const v2u* mr = (const v2u*)(FF + (size_t)m * DM) + lane;
        f32x4* orow = (f32x4*)(a.out + (size_t)m * DM) + lane;
        f32x4 v[8], xv[8]; float s = 0.f;
#pragma unroll
        for (int j = 0; j < 8; ++j) xv[j] = orow[64 * j];
#pragma unroll
        for (int j = 0; j < 8; ++j) { const v2u u = __builtin_nontemporal_load(mr + 64 * j); v[j] = (f32x4){lo2f(u.x), hi2f(u.x), lo2f(u.y), hi2f(u.y)}; s += (v[j].x * v[j].x + v[j].y * v[j].y) + (v[j].z * v[j].z + v[j].w * v[j].w); }
        const float rstd = 1.f / sqrtf(wave_sum(s) * (1.f / DM) + 1e-6f);
#pragma unroll
        for (int j = 0; j < 8; ++j) __builtin_nontemporal_store(xv[j] + v[j] * rstd * g1[64 * j], orow + 64 * j);
    }
}

typedef GAS unsigned gu32;
#define XB_TMO      128
#define XB_XCNT(j)  (256  + 64 * (j))
#define XB_XSUB(j)  (1280 + 64 * (j))
#define XB_XGEN(j)  (2304 + 64 * (j))
#define XB_TOP      3328
#define XB_TOPGEN   3392
#define XCD_BAR_WORDS 3456
#define XB_SPIN_CAP (1u << 18)

__device__ __forceinline__ unsigned xb_ld(unsigned* p)              { return __hip_atomic_load(p, __ATOMIC_RELAXED, __HIP_MEMORY_SCOPE_AGENT); }
__device__ __forceinline__ unsigned xb_add(unsigned* p, unsigned v) { return __hip_atomic_fetch_add(p, v, __ATOMIC_RELAXED, __HIP_MEMORY_SCOPE_AGENT); }
__device__ __forceinline__ unsigned xb_xcc_id() { return (unsigned)__builtin_amdgcn_s_getreg((3 << 11) | 20) & 0xFu; }
#define XB_SPIN(cond, bar) do { unsigned _sp = 0; while (cond) { __builtin_amdgcn_s_sleep(1); \
    if ((++_sp & 255u) == 0u) { if (xb_ld(&(bar)[XB_TMO])) break; if (_sp > XB_SPIN_CAP) { atomicAdd(&(bar)[XB_TMO], 1u); break; } } } } while (0)

struct XcdBarrier {
    unsigned* bar; unsigned x;
    volatile LAS unsigned* st;
};

__device__ __forceinline__ XcdBarrier xcd_barrier_post(unsigned* bar, volatile LAS unsigned* st) {
    XcdBarrier b; b.bar = bar; b.x = xb_xcc_id(); b.st = st;
    if (threadIdx.x == 0) (void)xb_add(&bar[XB_XCNT(b.x)], 1u);
    return b;
}
__device__ __forceinline__ void xcd_barrier_complete(unsigned* bar, unsigned x, unsigned& nloc, unsigned& nx) {
    const unsigned G = gridDim.x * gridDim.y * gridDim.z;
    unsigned sum, cnt, mine, sp = 0u;
    for (;;) {
        sum = 0u; cnt = 0u; mine = 0u;
#pragma unroll
        for (unsigned j = 0; j < 16; ++j) { const unsigned c = xb_ld(&bar[XB_XCNT(j)]); sum += c; cnt += (c > 0u) ? 1u : 0u; mine = (j == x) ? c : mine; }
        if (sum == G) break;
        __builtin_amdgcn_s_sleep(1);
        if ((++sp & 255u) == 0u) { if (xb_ld(&bar[XB_TMO])) break; if (sp > XB_SPIN_CAP) { atomicAdd(&bar[XB_TMO], 1u); break; } }
    }
    nloc = mine > 0u ? mine : 1u; nx = cnt > 0u ? cnt : 1u;
}

__device__ __forceinline__ void xcd_barrier(const XcdBarrier& b) {
    asm volatile("s_waitcnt vmcnt(0)" ::: "memory");
    __syncthreads();
    if (threadIdx.x == 0) {
        unsigned* bar = b.bar;
        __builtin_amdgcn_s_waitcnt(0);
        unsigned nloc = b.st[0], nx = b.st[1];
        if (nloc == 0u) { xcd_barrier_complete(bar, b.x, nloc, nx); b.st[0] = nloc; b.st[1] = nx; }
        const unsigned old = xb_add(&bar[XB_XSUB(b.x)], 1u);
        const unsigned gen = old / nloc;
        if (old + 1u == (gen + 1u) * nloc) {
            __builtin_amdgcn_fence(__ATOMIC_RELEASE, "agent");
            asm volatile("s_waitcnt vmcnt(0)" ::: "memory");
            const unsigned og = xb_add(&bar[XB_TOP], 1u);
            const unsigned tg = og / nx;
            if (og + 1u == (tg + 1u) * nx) xb_add(&bar[XB_TOPGEN], 1u);
            else XB_SPIN(xb_ld(&bar[XB_TOPGEN]) == tg, bar);
            __builtin_amdgcn_fence(__ATOMIC_ACQUIRE, "agent");
            xb_add(&bar[XB_XGEN(b.x)], 1u);
            asm volatile("s_waitcnt vmcnt(0)" ::: "memory");
        } else {
            XB_SPIN(xb_ld(&bar[XB_XGEN(b.x)]) == gen, bar);
            __builtin_amdgcn_fence(__ATOMIC_ACQUIRE, "agent");
            asm volatile("s_waitcnt vmcnt(0)" ::: "memory");
        }
    }
    __syncthreads();
}

__global__ void __launch_bounds__(NWAVES * 64, 2) hymba_fwd(Args args) {
    extern __shared__ __attribute__((aligned(16))) unsigned char lds[];
    cg::grid_group grid = cg::this_grid();
    LAS unsigned char* ldsl = (LAS unsigned char*)lds;
    const int tid = threadIdx.x, lane = tid & 63, wave = __builtin_amdgcn_readfirstlane(tid >> 6);
    const int G = gridDim.x, gw = blockIdx.x * NWAVES + wave, NGW = G * NWAVES;
    unsigned char* ws = args.ws;
    const int lo = args.ph_lo, hi = args.ph_hi;
    if (tid < 32) ((volatile LAS unsigned*)(ldsl + MISC_OFF))[tid] = 0u;
    __syncthreads();
    const XcdBarrier xbar = xcd_barrier_post((unsigned*)(ws + WS_CTL), (volatile LAS unsigned*)(ldsl + MISC_OFF) + 8);
#define IN(k) (lo <= (k) && (k) < hi)
#define SEAM(k) do { if (IN(k) && IN((k) + 1)) { if ((k) == 0) grid.sync(); else xcd_barrier(xbar); } } while (0)
    typedef pg8::EpiBf16<0> E0; typedef pg8::EpiBf16<2> E2;
    if (IN(0)) { p0_prologue(args, ldsl, gw, NGW, wave, lane); }
    SEAM(0);
#ifndef NO_G1
    if (IN(1)) { pg8::Gemm g{(const bf16*)(ws + WS_H), (const bf16*)(ws + WS_WIN), NTOK, ZLD, DM}; pg8::StaticOrder S; S.init(NTOK, ZLD, G, (int)blockIdx.x);
        pg8::EpiZ E{(bf16*)(ws + WS_ZM), (bf16*)(ws + WS_ZC)}; pg8::gemm_phase<pg8::EpiZ, pg8::StaticOrder, true, true>(ldsl, g, S, E); }
#endif
    SEAM(1);
    if (IN(2)) {
#ifndef NO_SHIFT
 shift_phase(args, gw, NGW, lane);
#endif
 }
    SEAM(2);
    if (IN(3)) {
#ifndef NO_SCAN
 scan_phase(args, lds, wave, lane);
#ifdef PROBE_SCAN2
 __syncthreads(); scan_phase(args, lds, wave, lane);
#endif
#endif
 }
    SEAM(3);
    if (IN(4)) {
#ifndef NO_POST
 post_phase(args, wave, lane);
#endif
 }
    SEAM(4);
#ifndef NO_G5
    if (IN(5)) { pg8::Gemm g{(const bf16*)(ws + WS_H), (const bf16*)(ws + WS_WOUT), NTOK, DM, DM}; pg8::StaticOrder S; S.init(NTOK, DM, G, (int)blockIdx.x);
        E0 E{(bf16*)(ws + WS_MIX), DM}; pg8::gemm_phase<E0, pg8::StaticOrder, true, true>(ldsl, g, S, E); }
#endif
    SEAM(5);
    if (IN(6)) { mid_rows(args, gw, NGW, lane); }
    SEAM(6);
#ifndef NO_G7
    if (IN(7)) {
#pragma unroll
        for (int s = 0; s < 3; ++s) {
            { pg8::Gemm g{(const bf16*)(ws + WS_H) + (size_t)s * SEQ * DM, (const bf16*)(ws + WS_WUP), SEQ, DFF, DM}; pg8::StaticOrder S; S.init(SEQ, DFF, G, (int)blockIdx.x);
              E2 E{(bf16*)(ws + WS_U), DFF}; pg8::gemm_phase<E2, pg8::StaticOrder, true, true>(ldsl, g, S, E); }
            xcd_barrier(xbar);
            { pg8::Gemm g{(const bf16*)(ws + WS_U), (const bf16*)(ws + WS_WDN), SEQ, DM, DFF}; pg8::StaticOrder S; S.init(SEQ, DM, G, (int)blockIdx.x);
              E0 E{(bf16*)(ws + WS_FF) + (size_t)s * SEQ * DM, DM}; pg8::gemm_phase<E0, pg8::StaticOrder, true, true>(ldsl, g, S, E); }
            if (s < 2) xcd_barrier(xbar);
        }
    }
#endif
    SEAM(7);
    if (IN(8)) { final_rows(args, gw, NGW, lane); }
#undef IN
#undef SEAM
}

extern "C" void kernel_launch(void* const* d_in, const int* in_sizes, int n_in, void* d_out, int out_size, void* d_ws, size_t ws_size, hipStream_t stream) {
    static int grid = 0;
    if (grid == 0) {
        if (n_in != 30 || ws_size < WS_END) { fprintf(stderr, "kernel_launch: unexpected n_in %d / ws %zu\n", n_in, ws_size); grid = -1; return; }
        int dev = 0, cus = 0, per_cu = 0;
        hipGetDevice(&dev); hipDeviceGetAttribute(&cus, hipDeviceAttributeMultiprocessorCount, dev);
        if (hipFuncSetAttribute((const void*)hymba_fwd, hipFuncAttributeMaxDynamicSharedMemorySize, LDS_BYTES) != hipSuccess) { fprintf(stderr, "kernel_launch: hipFuncSetAttribute failed\n"); grid = -1; return; }
        hipOccupancyMaxActiveBlocksPerMultiprocessor(&per_cu, (const void*)hymba_fwd, NWAVES * 64, LDS_BYTES);
        (void)hipGetLastError();
        if (per_cu < 1) per_cu = 1;
        grid = cus * 1;
        if (grid < 192) { fprintf(stderr, "kernel_launch: grid %d too small\n", grid); grid = -1; return; }
    }
    if (grid < 0) return;
    if (hipMemsetAsync((char*)d_ws + WS_CTL, 0, CTL_BYTES, stream) != hipSuccess) { fprintf(stderr, "kernel_launch: memset failed\n"); return; }
    Args a{};
    for (int i = 0; i < 30; ++i) a.in[i] = (const float*)d_in[i];
    a.out = (float*)d_out; a.ws = (unsigned char*)d_ws;
#ifndef N_LAUNCH_SPLIT
    a.ph_lo = 0; a.ph_hi = 9;
    void* kargs[] = {&a};
    hipError_t e = hipLaunchCooperativeKernel((const void*)hymba_fwd, dim3(grid), dim3(NWAVES * 64), kargs, LDS_BYTES, stream);
    if (e != hipSuccess) fprintf(stderr, "cooperative launch failed: %s (grid %d)\n", hipGetErrorString(e), grid);
#else
    for (int p = 0; p < 9; ++p) { a.ph_lo = p; a.ph_hi = p + 1; void* kargs[] = {&a};
        hipError_t e = hipLaunchCooperativeKernel((const void*)hymba_fwd, dim3(grid), dim3(NWAVES * 64), kargs, LDS_BYTES, stream);
        if (e != hipSuccess) fprintf(stderr, "cooperative launch %d failed: %s (grid %d)\n", p, hipGetErrorString(e), grid); }
#endif
}
```
